# Optimizing an MI355X kernel written in HIP

```python
import jax, jax.numpy as jnp
from jax import lax
import numpy as np

D_MODEL = 1024
BATCH = 8
SEQ = 2048
DEPTH = 2
DEC_BATCH = 128
DEC_SEQ = 8
PAST_LEN = 16384
PAGE_SIZE = 128

D_PLE = 256
D_FF = 2816
GROUP_W = D_MODEL // 4
N_HEADS_PER_GROUP = 4
HEAD_DIM = GROUP_W // N_HEADS_PER_GROUP
MIX_IN_W = 8 * GROUP_W
CONV_A_WIDTH = 31
POOL_WINDOWS = (2, 4, 8, 16)
POOL_STATE = max(POOL_WINDOWS) - 1
CHUNK = 128
SHORT_CONV_WIDTH = 3
EPS = 1e-6

kernel_name = "hybrid_conv_pool_sgu_shortconv_decoder_step"


def _rms_norm(x, g):
    xf = x.astype(jnp.float32)
    y = xf * lax.rsqrt(jnp.mean(xf * xf, axis=-1, keepdims=True) + EPS)
    return (y * g.astype(jnp.float32)).astype(x.dtype)


def _head_layer_norm(x, g, b):
    shp = x.shape
    xf = x.astype(jnp.float32).reshape(shp[:-1] + (N_HEADS_PER_GROUP, HEAD_DIM))
    mu = jnp.mean(xf, axis=-1, keepdims=True)
    xc = xf - mu
    var = jnp.mean(xc * xc, axis=-1, keepdims=True)
    y = (xc * lax.rsqrt(var + EPS)).reshape(shp)
    return (y * g.astype(jnp.float32) + b.astype(jnp.float32)).astype(x.dtype)


def _swiglu(x, w_gate, w_up, w_down):
    return (jax.nn.silu(x @ w_gate) * (x @ w_up)) @ w_down


def _causal_depthwise_conv(x, prev, w):
    xp = jnp.concatenate([prev.astype(x.dtype), x], axis=1)
    y = lax.conv_general_dilated(xp, w[:, None, :].astype(x.dtype), window_strides=(1,),
                                 padding='VALID', dimension_numbers=('NWC', 'WIO', 'NWC'),
                                 feature_group_count=x.shape[-1])
    return y, xp[:, -(w.shape[0] - 1):]


def _conv_module(a_val, a_gate, prev, w, b, ng, nb):
    h = a_val * jax.nn.sigmoid(a_gate)
    c, new_state = _causal_depthwise_conv(h, prev, w)
    c = _head_layer_norm(c + b, ng, nb)
    return jax.nn.silu(c), new_state


def _multiscale_pool(z, prev, start, w_pool, scale):
    B_, L, _ = z.shape
    zp = jnp.concatenate([prev.astype(z.dtype), z], axis=1)
    cs = jnp.pad(jnp.cumsum(zp.astype(jnp.float32), axis=1), ((0, 0), (1, 0), (0, 0)))
    pos = start + jnp.arange(L)
    means = []
    for g, win in enumerate(POOL_WINDOWS):
        sl = slice(g * HEAD_DIM, (g + 1) * HEAD_DIM)
        hi = cs[:, POOL_STATE + 1:POOL_STATE + 1 + L, sl]
        lo = cs[:, POOL_STATE + 1 - win:POOL_STATE + 1 - win + L, sl]
        cnt = jnp.minimum(pos + 1, win).astype(jnp.float32)[None, :, None]
        means.append((hi - lo) / cnt)
    mean = jnp.stack(means, axis=2)
    d = (mean - z.astype(jnp.float32).reshape(B_, L, N_HEADS_PER_GROUP, HEAD_DIM)).astype(z.dtype)
    y = jnp.einsum('blgc,gcd->blgd', d, w_pool).reshape(B_, L, GROUP_W)
    return y * scale, zp[:, -POOL_STATE:]


def _spatial_gating(u, v, ng, nb, w_s, b_s):
    v = _head_layer_norm(v, ng, nb)
    B_, L, C = v.shape
    cs = min(L, CHUNK)
    Lp = -(-L // cs) * cs
    vb = jnp.pad(v, ((0, 0), (0, Lp - L), (0, 0))).reshape(B_, Lp // cs, cs, N_HEADS_PER_GROUP, HEAD_DIM)
    w = jnp.tril(w_s[:, :cs, :cs])
    s = jnp.einsum('hts,bnshc->bnthc', w, vb) + b_s[:, :cs].T[None, None, :, :, None]
    s = s.reshape(B_, Lp, C)[:, :L]
    return u * s, v


def _short_gated_conv(b_gate, c_gate, h, prev, w):
    q = c_gate * h
    y, new_state = _causal_depthwise_conv(q, prev, w)
    return b_gate * y, new_state


def _trunk(x, p, st_a, st_pool, st_sc, start, wt):
    B_ = x.shape[0]
    new_a, new_pool, new_sc, new_v = [], [], [], []
    for i in range(DEPTH):
        h = _rms_norm(x, wt['norm_ffn1'][i])
        x = x + 0.5 * _swiglu(h, wt['w_ffn1_gate'][i], wt['w_ffn1_up'][i], wt['w_ffn1_down'][i])

        h = _rms_norm(x, wt['norm_mix'][i])
        z = h @ wt['w_mix_in'][i]
        a_val, a_gate, zb, u, v, b_gate, c_gate, d_in = jnp.split(z, 8, axis=-1)
        prev_a = jnp.zeros((B_, CONV_A_WIDTH - 1, GROUP_W), x.dtype) if st_a is None else st_a[i]
        prev_p = jnp.zeros((B_, POOL_STATE, GROUP_W), x.dtype) if st_pool is None else st_pool[i]
        prev_s = jnp.zeros((B_, SHORT_CONV_WIDTH - 1, GROUP_W), x.dtype) if st_sc is None else st_sc[i]

        y_a, s_a = _conv_module(a_val, a_gate, prev_a, wt['conv_a_w'][i], wt['conv_a_b'][i],
                                wt['norm_a_g'][i], wt['norm_a_b'][i])
        y_b, s_p = _multiscale_pool(zb, prev_p, start, wt['pool_w'][i], wt['pool_scale'][i])
        y_c, v_n = _spatial_gating(jax.nn.gelu(u), jax.nn.gelu(v), wt['sgu_norm_g'][i],
                                   wt['sgu_norm_b'][i], wt['sgu_w'][i], wt['sgu_b'][i])
        y_d, s_s = _short_gated_conv(b_gate, c_gate, d_in, prev_s, wt['short_conv_w'][i])
        x = x + jnp.concatenate([y_a, y_b, y_c, y_d], axis=-1) @ wt['w_mix_out'][i]

        h = _rms_norm(x, wt['norm_ffn2'][i])
        x = x + 0.5 * _swiglu(h, wt['w_ffn2_gate'][i], wt['w_ffn2_up'][i], wt['w_ffn2_down'][i])

        gate = jax.nn.sigmoid(_rms_norm(x, wt['norm_ple'][i]) @ wt['w_ple_gate'][i])
        x = x + gate * (p[i] @ wt['w_ple_proj'][i])

        new_a.append(s_a); new_pool.append(s_p); new_sc.append(s_s); new_v.append(v_n)
    y = _rms_norm(x, wt['norm_final'])
    return y, jnp.stack(new_a), jnp.stack(new_pool), jnp.stack(new_sc), jnp.stack(new_v)


def setup_inputs(seed: int = 0) -> dict:
    key = jax.random.key(seed)
    ks = iter(jax.random.split(key, 40))

    def nrm(shape, scale):
        return scale * jax.random.normal(next(ks), shape, jnp.float32)

    def gain(shape):
        return 1.0 + nrm(shape, 0.01)

    L = DEPTH
    return {
        'x_prompt': nrm((BATCH, SEQ, D_MODEL), 1.0),
        'x_sample': nrm((DEC_BATCH, DEC_SEQ, D_MODEL), 1.0),
        'p_prompt': nrm((DEPTH, BATCH, SEQ, D_PLE), 1.0),
        'p_sample': nrm((DEPTH, DEC_BATCH, DEC_SEQ, D_PLE), 1.0),
        'state_conv_a': nrm((DEPTH, DEC_BATCH, CONV_A_WIDTH - 1, GROUP_W), 0.5),
        'state_pool': nrm((DEPTH, DEC_BATCH, POOL_STATE, GROUP_W), 1.0),
        'state_short_conv': nrm((DEPTH, DEC_BATCH, SHORT_CONV_WIDTH - 1, GROUP_W), 0.5),
        'norm_ffn1': gain((L, D_MODEL)),
        'w_ffn1_gate': nrm((L, D_MODEL, D_FF), D_MODEL ** -0.5),
        'w_ffn1_up': nrm((L, D_MODEL, D_FF), D_MODEL ** -0.5),
        'w_ffn1_down': nrm((L, D_FF, D_MODEL), D_FF ** -0.5),
        'norm_mix': gain((L, D_MODEL)),
        'w_mix_in': nrm((L, D_MODEL, MIX_IN_W), D_MODEL ** -0.5),
        'conv_a_w': nrm((L, CONV_A_WIDTH, GROUP_W), CONV_A_WIDTH ** -0.5),
        'conv_a_b': nrm((L, GROUP_W), 0.02),
        'norm_a_g': gain((L, GROUP_W)),
        'norm_a_b': nrm((L, GROUP_W), 0.02),
        'pool_w': nrm((L, N_HEADS_PER_GROUP, HEAD_DIM, HEAD_DIM), HEAD_DIM ** -0.5),
        'pool_scale': 1.0 + nrm((L, GROUP_W), 0.1),
        'sgu_norm_g': gain((L, GROUP_W)),
        'sgu_norm_b': nrm((L, GROUP_W), 0.02),
        'sgu_w': nrm((L, N_HEADS_PER_GROUP, CHUNK, CHUNK), CHUNK ** -0.5),
        'sgu_b': 1.0 + nrm((L, N_HEADS_PER_GROUP, CHUNK), 0.02),
        'short_conv_w': nrm((L, SHORT_CONV_WIDTH, GROUP_W), SHORT_CONV_WIDTH ** -0.5),
        'w_mix_out': nrm((L, D_MODEL, D_MODEL), D_MODEL ** -0.5),
        'norm_ffn2': gain((L, D_MODEL)),
        'w_ffn2_gate': nrm((L, D_MODEL, D_FF), D_MODEL ** -0.5),
        'w_ffn2_up': nrm((L, D_MODEL, D_FF), D_MODEL ** -0.5),
        'w_ffn2_down': nrm((L, D_FF, D_MODEL), D_FF ** -0.5),
        'norm_ple': gain((L, D_MODEL)),
        'w_ple_gate': nrm((L, D_MODEL, D_MODEL), D_MODEL ** -0.5),
        'w_ple_proj': nrm((L, D_PLE, D_MODEL), D_PLE ** -0.5),
        'norm_final': gain((D_MODEL,)),
    }


def reference(x_prompt, x_sample, p_prompt, p_sample, state_conv_a, state_pool, state_short_conv,
              norm_ffn1, w_ffn1_gate, w_ffn1_up, w_ffn1_down, norm_mix, w_mix_in,
              conv_a_w, conv_a_b, norm_a_g, norm_a_b, pool_w, pool_scale,
              sgu_norm_g, sgu_norm_b, sgu_w, sgu_b, short_conv_w, w_mix_out,
              norm_ffn2, w_ffn2_gate, w_ffn2_up, w_ffn2_down,
              norm_ple, w_ple_gate, w_ple_proj, norm_final):
    wt = dict(norm_ffn1=norm_ffn1, w_ffn1_gate=w_ffn1_gate, w_ffn1_up=w_ffn1_up, w_ffn1_down=w_ffn1_down,
              norm_mix=norm_mix, w_mix_in=w_mix_in, conv_a_w=conv_a_w, conv_a_b=conv_a_b,
              norm_a_g=norm_a_g, norm_a_b=norm_a_b, pool_w=pool_w, pool_scale=pool_scale,
              sgu_norm_g=sgu_norm_g, sgu_norm_b=sgu_norm_b, sgu_w=sgu_w, sgu_b=sgu_b,
              short_conv_w=short_conv_w, w_mix_out=w_mix_out, norm_ffn2=norm_ffn2,
              w_ffn2_gate=w_ffn2_gate, w_ffn2_up=w_ffn2_up, w_ffn2_down=w_ffn2_down,
              norm_ple=norm_ple, w_ple_gate=w_ple_gate, w_ple_proj=w_ple_proj, norm_final=norm_final)
    y_prompt, conv_a_prompt, pool_prompt, short_conv_prompt, _ = _trunk(
        x_prompt, p_prompt, None, None, None, 0, wt)
    y_sample, conv_a_sample, pool_sample, short_conv_sample, chunk_v_sample = _trunk(
        x_sample, p_sample, state_conv_a, state_pool, state_short_conv, PAST_LEN, wt)
    return (y_prompt, y_sample, conv_a_prompt, conv_a_sample, pool_prompt, pool_sample,
            short_conv_prompt, short_conv_sample, chunk_v_sample)
```

```cpp
#include <hip/hip_runtime.h>
#include <hip/hip_cooperative_groups.h>
#include <cstdio>
#include <cstdint>
namespace cg = cooperative_groups;
namespace pg8 {
#define PG8_LAS __attribute__((address_space(3)))
typedef unsigned short bf16_t;
typedef short bf16x8 __attribute__((ext_vector_type(8)));
typedef float f32x4 __attribute__((ext_vector_type(4)));
typedef unsigned u32x4 __attribute__((ext_vector_type(4)));
constexpr int BM = 256, BK = 64, HALF = 128, HTB = HALF * BK * 2  , STAGE_BYTES = 8 * HTB, NXCD = 8, WGM = 8;

__host__ __device__ __forceinline__ int lds_byte(int r, int c) { const int st = (r >> 4) * 2 + (c >> 5), rr = r & 15, cc = c & 31, ob = rr * 64 + cc * 2; return st * 1024 + (ob ^ (((ob >> 9) & 1) << 5)); }
__host__ __device__ __forceinline__ void stage_rc(int b, int& R, int& C) { const int st = b / 1024, sb = b % 1024, swz = sb ^ (((sb >> 9) & 1) << 5); R = (st >> 1) * 16 + swz / 64; C = (st & 1) * 32 + (swz % 64) / 2; }
__host__ __device__ __forceinline__ int perm32(int rho) { const int n = rho >> 4, i = rho & 15; return 8 * (i >> 2) + 4 * n + (i & 3); }

struct Unit { int pm, pn; };
struct Gemm { const bf16_t* A; const bf16_t* Bt; int M, N, K; };

struct StaticOrder {
    int nM, nN, nwg, G, c;
    __host__ __device__ void init(int M, int N, int G_, int c_) { nM = M / BM; nN = N / BM; nwg = nM * nN; G = G_; c = c_; }
    __host__ __device__ bool next(int i, Unit& u) const {
        const long L = (long)i * G + c; if (L >= nwg) return false;
        int wgid = (int)L; { const int q = nwg / NXCD, r = nwg % NXCD, xcd = wgid % NXCD, off = wgid / NXCD; wgid = (xcd < r ? xcd * (q + 1) : r * (q + 1) + (xcd - r) * q) + off; }
        const int nig = WGM * nN, gid = wgid / nig, fm = gid * WGM, gsz = (nM - fm) < WGM ? (nM - fm) : WGM;
        u.pm = fm + ((wgid % nig) % gsz); u.pn = (wgid % nig) / gsz; return true;
    }
    __device__ __forceinline__ void a_ready(const Unit&) const {}
    __device__ __forceinline__ void done(const Unit&) const {}
};

__device__ __forceinline__ unsigned cvt_pk_bf16(float lo, float hi) { unsigned r; asm volatile("v_cvt_pk_bf16_f32 %0, %1, %2" : "=v"(r) : "v"(lo), "v"(hi)); return r; }
typedef float f32x2 __attribute__((ext_vector_type(2)));
typedef float f32x2 __attribute__((ext_vector_type(2)));
typedef __bf16 bf2_t __attribute__((ext_vector_type(2)));
typedef __bf16 bf8_t __attribute__((ext_vector_type(8)));
constexpr float RMS_EPS = 1e-6f;
__device__ __forceinline__ float ssq8(bf16x8 v, float s) {
    const bf8_t b = __builtin_bit_cast(bf8_t, v);
#pragma unroll
    for (int i = 0; i < 4; ++i) { const bf2_t p = {b[2 * i], b[2 * i + 1]}; s = __builtin_amdgcn_fdot2_f32_bf16(p, p, s, false); }
    return s;
}
__device__ __forceinline__ float sigmoid_f(float v) { return __builtin_amdgcn_rcpf(1.0f + __builtin_amdgcn_exp2f(v * -1.4426950408889634f)); }
__device__ __forceinline__ float silu_f(float v) { return v * sigmoid_f(v); }

struct EpiSwiGLU {
    static constexpr bool PERM = true, AFTER_DRAIN = false, NEED_RS = true;
    bf16_t* O; int ldc;
    __device__ __forceinline__ void operator()(const f32x4 (&acc)[2][2][4][2], const float (&rsv)[2][4], const Unit& u, int wr, int wc, int fr, int fq) const {
        const int row0 = u.pm * BM + wr * 64 + fr, col0 = u.pn * HALF + wc * 32 + 8 * fq;
#pragma unroll
        for (int ai = 0; ai < 2; ++ai)
#pragma unroll
            for (int m = 0; m < 4; ++m) { const int row = row0 + ai * HALF + m * 16; const float rs = rsv[ai][m];
                float h[8];
#pragma unroll
                for (int n = 0; n < 2; ++n)
#pragma unroll
                    for (int j = 0; j < 4; ++j) { const float g = acc[ai][0][m][n][j] * rs, up = acc[ai][1][m][n][j] * rs; h[4 * n + j] = silu_f(g) * up; }
                u32x4 w; w.x = cvt_pk_bf16(h[0], h[1]); w.y = cvt_pk_bf16(h[2], h[3]); w.z = cvt_pk_bf16(h[4], h[5]); w.w = cvt_pk_bf16(h[6], h[7]);
                *(u32x4*)(O + (size_t)row * ldc + col0) = w; }
    }
};
template <bool RS> struct EpiScaleBf16 {
    static constexpr bool PERM = true, AFTER_DRAIN = false, NEED_RS = RS;
    bf16_t* O; int ldc;
    __device__ __forceinline__ void operator()(const f32x4 (&acc)[2][2][4][2], const float (&rsv)[2][4], const Unit& u, int wr, int wc, int fr, int fq) const {
        const int row0 = u.pm * BM + wr * 64 + fr, col0 = u.pn * BM + wc * 32 + 8 * fq;
#pragma unroll
        for (int ai = 0; ai < 2; ++ai)
#pragma unroll
            for (int m = 0; m < 4; ++m) { const int row = row0 + ai * HALF + m * 16; const float rs = RS ? rsv[ai][m] : 1.0f;
#pragma unroll
                for (int bj = 0; bj < 2; ++bj) { const f32x4 v0 = acc[ai][bj][m][0] * rs, v1 = acc[ai][bj][m][1] * rs;
                    u32x4 w; w.x = cvt_pk_bf16(v0[0], v0[1]); w.y = cvt_pk_bf16(v0[2], v0[3]); w.z = cvt_pk_bf16(v1[0], v1[1]); w.w = cvt_pk_bf16(v1[2], v1[3]);
                    *(u32x4*)(O + (size_t)row * ldc + col0 + bj * HALF) = w; } }
    }
};
template <int MODE> struct EpiResid {
    static constexpr bool PERM = true, AFTER_DRAIN = false, NEED_RS = (MODE == 1);
    float* X; bf16_t* XB; float scale; const bf16_t* proj;
    __device__ __forceinline__ void operator()(const f32x4 (&acc)[2][2][4][2], const float (&rsv)[2][4], const Unit& u, int wr, int wc, int fr, int fq) const {
        const int row0 = u.pm * BM + wr * 64 + fr, col0 = u.pn * BM + wc * 32 + 8 * fq;
#pragma unroll
        for (int ai = 0; ai < 2; ++ai)
#pragma unroll
            for (int m = 0; m < 4; ++m) { const int row = row0 + ai * HALF + m * 16; const float rs = (MODE == 1) ? rsv[ai][m] : 1.0f;
#pragma unroll
                for (int bj = 0; bj < 2; ++bj) { const size_t off = (size_t)row * 1024 + col0 + bj * HALF;
                    f32x4 x0 = *(const f32x4*)(X + off), x1 = *(const f32x4*)(X + off + 4);
                    if (MODE == 0) { x0 += acc[ai][bj][m][0] * scale; x1 += acc[ai][bj][m][1] * scale; }
                    else { const u32x4 pw = *(const u32x4*)(proj + off);
                        const f32x4 a0 = acc[ai][bj][m][0] * rs, a1 = acc[ai][bj][m][1] * rs;
                        x0[0] += sigmoid_f(a0[0]) * __uint_as_float(pw.x << 16); x0[1] += sigmoid_f(a0[1]) * __uint_as_float(pw.x & 0xffff0000u);
                        x0[2] += sigmoid_f(a0[2]) * __uint_as_float(pw.y << 16); x0[3] += sigmoid_f(a0[3]) * __uint_as_float(pw.y & 0xffff0000u);
                        x1[0] += sigmoid_f(a1[0]) * __uint_as_float(pw.z << 16); x1[1] += sigmoid_f(a1[1]) * __uint_as_float(pw.z & 0xffff0000u);
                        x1[2] += sigmoid_f(a1[2]) * __uint_as_float(pw.w << 16); x1[3] += sigmoid_f(a1[3]) * __uint_as_float(pw.w & 0xffff0000u); }
                    *(f32x4*)(X + off) = x0; *(f32x4*)(X + off + 4) = x1;
                    u32x4 w; w.x = cvt_pk_bf16(x0[0], x0[1]); w.y = cvt_pk_bf16(x0[2], x0[3]); w.z = cvt_pk_bf16(x1[0], x1[1]); w.w = cvt_pk_bf16(x1[2], x1[3]);
                    *(u32x4*)(XB + off) = w; }
                if ((m & 1) == 1) asm volatile("" ::: "memory"); }
    }
};
template <class Epi, class Sched, bool ALIGN_EPI = false, bool SP2 = false>
__device__ __forceinline__ void gemm_phase(PG8_LAS unsigned char* lds, const Gemm g, const Sched& S, const Epi& E) {
    int tid_ = threadIdx.x; asm volatile("" : "+v"(tid_));
    const int tid = tid_, wid = __builtin_amdgcn_readfirstlane(tid >> 6), lane = tid & 63, wr = wid >> 2, wc = wid & 3, fr = lane & 15, fq = lane >> 4;
    int K_ = g.K; asm volatile("" : "+s"(K_));
    const int K = K_, nt = K / BK;
    unsigned voffA[2], voffB[2];
#pragma unroll
    for (int i = 0; i < 2; ++i) { int R, C; stage_rc(tid * 16 + i * 8192, R, C); const int Rb = Epi::PERM ? ((R & ~31) + perm32(R & 31)) : R;
        voffA[i] = (unsigned)(R * K + C) * 2u; voffB[i] = (unsigned)(Rb * K + C) * 2u; }
    const size_t kstep = (size_t)(BK * 2);
    const size_t hstep = (size_t)HALF * K * 2;
    const size_t tstep = 2 * hstep;
    const unsigned ldsw = (unsigned)wid * 1024u;
    const int aoff = lds_byte(wr * 64 + fr, fq * 8), boff = lds_byte(wc * 32 + fr, fq * 8);
#define PG8_SA(b, h) (((b) * 2 + (h)) * HTB)
#define PG8_SB(b, h) ((4 + (b) * 2 + (h)) * HTB)
#define PG8_STAGE(bufoff, gbase, voff) do { _Pragma("unroll") for (int _i = 0; _i < 2; ++_i) \
        __builtin_amdgcn_global_load_lds((const unsigned*)((const char*)(gbase) + (voff)[_i]), (PG8_LAS unsigned*)(lds + (bufoff) + ldsw + _i * 8192), 16, 0, 0); } while (0)
#define PG8_LDA(dst, b, h) do { _Pragma("unroll") for (int m = 0; m < 4; ++m) _Pragma("unroll") for (int k = 0; k < 2; ++k) dst[m][k] = *(const PG8_LAS bf16x8*)(lds + PG8_SA(b, h) + aoff + m * 2048 + k * 1024); } while (0)
#define PG8_LDB(dst, b, h) do { _Pragma("unroll") for (int n = 0; n < 2; ++n) _Pragma("unroll") for (int k = 0; k < 2; ++k) dst[n][k] = *(const PG8_LAS bf16x8*)(lds + PG8_SB(b, h) + boff + n * 2048 + k * 1024); } while (0)
#define PG8_MMA(ai, bj, At, Bt) do { __builtin_amdgcn_s_setprio(1); _Pragma("unroll") for (int m = 0; m < 4; ++m) _Pragma("unroll") for (int n = 0; n < 2; ++n) _Pragma("unroll") for (int k = 0; k < 2; ++k) \
        acc[ai][bj][m][n] = __builtin_amdgcn_mfma_f32_16x16x32_bf16(Bt[n][k], At[m][k], acc[ai][bj][m][n], 0, 0, 0); __builtin_amdgcn_s_setprio(0); } while (0)
#define PG8_SSQ(ai) do { if constexpr (Epi::NEED_RS) { _Pragma("unroll") for (int m = 0; m < 4; ++m) { ssq[ai][m] = ssq8(At[m][0], ssq[ai][m]); ssq[ai][m] = ssq8(At[m][1], ssq[ai][m]); } } } while (0)
#define PG8_WAIT_V(n) asm volatile("s_waitcnt vmcnt(" #n ")" ::: "memory")
#define PG8_WAIT_L(n) asm volatile("s_waitcnt lgkmcnt(" #n ")" ::: "memory")
#define PG8_BAR __builtin_amdgcn_s_barrier()
#define PG8_SCHED __builtin_amdgcn_sched_barrier(0)
    Unit cur, nxt; int ui = 0;
    if (!S.next(0, cur)) return;
    f32x4 acc[2][2][4][2];
#pragma unroll
    for (int a = 0; a < 2; ++a)
#pragma unroll
        for (int b = 0; b < 2; ++b)
#pragma unroll
            for (int m = 0; m < 4; ++m)
#pragma unroll
                for (int n = 0; n < 2; ++n) acc[a][b][m][n] = (f32x4){0.f, 0.f, 0.f, 0.f};
    bf16x8 At[4][2], B0[2][2], B1[2][2];
    float ssq[2][4] = {{0.f, 0.f, 0.f, 0.f}, {0.f, 0.f, 0.f, 0.f}};
    static_assert(SP2 || !Epi::NEED_RS, "row statistics are gathered in the SP2 loop only");
    const char* cA = (const char*)g.A + (size_t)cur.pm * tstep; const char* cB = (const char*)g.Bt + (size_t)cur.pn * tstep;
    S.a_ready(cur);
    if constexpr (SP2) {
        PG8_STAGE(PG8_SB(0, 0), cB, voffB); PG8_STAGE(PG8_SB(0, 1), cB + hstep, voffB); PG8_STAGE(PG8_SA(0, 0), cA, voffA); PG8_STAGE(PG8_SA(0, 1), cA + hstep, voffA);
        if (wr == 1) PG8_BAR;
        PG8_WAIT_V(2); PG8_BAR;
        PG8_STAGE(PG8_SB(1, 0), cB + kstep, voffB); PG8_STAGE(PG8_SA(1, 0), cA + kstep, voffA); PG8_STAGE(PG8_SB(1, 1), cB + hstep + kstep, voffB);
        PG8_WAIT_V(6); PG8_BAR;
    } else {
        PG8_STAGE(PG8_SB(0, 0), cB, voffB); PG8_STAGE(PG8_SA(0, 0), cA, voffA); PG8_STAGE(PG8_SB(0, 1), cB + hstep, voffB); PG8_STAGE(PG8_SA(0, 1), cA + hstep, voffA);
        if (wr == 1) PG8_BAR;
        PG8_WAIT_V(4); PG8_BAR;
        PG8_STAGE(PG8_SB(1, 0), cB + kstep, voffB); PG8_STAGE(PG8_SA(1, 0), cA + kstep, voffA); PG8_STAGE(PG8_SB(1, 1), cB + hstep + kstep, voffB);
        PG8_WAIT_V(6); PG8_BAR;
    }
    for (;;) {
        const bool has_next = S.next(ui + 1, nxt);
        const char* nA = has_next ? (const char*)g.A + (size_t)nxt.pm * tstep : cA; const char* nB = has_next ? (const char*)g.Bt + (size_t)nxt.pn * tstep : cB;
        for (int t = 0; t < nt; t += 2) {
            const bool last = (t == nt - 2);
            const char* a1 = cA + (size_t)(t + 1) * kstep;
            const char* a2 = last ? nA : cA + (size_t)(t + 2) * kstep; const char* b2 = last ? nB : cB + (size_t)(t + 2) * kstep;
            const char* a3 = a2 + kstep; const char* b3 = b2 + kstep;
            if (last && has_next) S.a_ready(nxt);
            if constexpr (SP2) {
            PG8_LDB(B0, 0, 0); PG8_LDB(B1, 0, 1); PG8_SCHED; PG8_LDA(At, 0, 0); PG8_STAGE(PG8_SA(1, 1), a1 + hstep, voffA);
            PG8_WAIT_V(8); PG8_WAIT_L(0); PG8_BAR; PG8_MMA(0, 0, At, B0); PG8_SSQ(0); PG8_MMA(0, 1, At, B1); PG8_BAR; PG8_SCHED;
            PG8_LDA(At, 0, 1); PG8_STAGE(PG8_SB(0, 0), b2, voffB); PG8_STAGE(PG8_SB(0, 1), b2 + hstep, voffB); PG8_STAGE(PG8_SA(0, 0), a2, voffA);
            PG8_WAIT_V(8); PG8_WAIT_L(0); PG8_BAR; PG8_MMA(1, 0, At, B0); PG8_SSQ(1); PG8_MMA(1, 1, At, B1); PG8_BAR; PG8_SCHED;
            PG8_LDB(B0, 1, 0); PG8_LDB(B1, 1, 1); PG8_SCHED; PG8_LDA(At, 1, 0); PG8_STAGE(PG8_SA(0, 1), a2 + hstep, voffA);
            PG8_WAIT_V(8); PG8_WAIT_L(0); PG8_BAR; PG8_MMA(0, 0, At, B0); PG8_SSQ(0); PG8_MMA(0, 1, At, B1); PG8_BAR; PG8_SCHED;
            PG8_LDA(At, 1, 1); PG8_STAGE(PG8_SB(1, 0), b3, voffB); PG8_STAGE(PG8_SB(1, 1), b3 + hstep, voffB); PG8_STAGE(PG8_SA(1, 0), a3, voffA);
            PG8_WAIT_V(8); PG8_WAIT_L(0); PG8_BAR; PG8_MMA(1, 0, At, B0); PG8_SSQ(1); PG8_MMA(1, 1, At, B1); PG8_BAR; PG8_SCHED;
            } else {
            PG8_LDB(B0, 0, 0); PG8_SCHED; PG8_LDA(At, 0, 0); PG8_STAGE(PG8_SA(1, 1), a1 + hstep, voffA);
            PG8_WAIT_L(8); PG8_BAR; PG8_WAIT_L(0); PG8_MMA(0, 0, At, B0); PG8_BAR; PG8_SCHED;
            PG8_LDB(B1, 0, 1); PG8_STAGE(PG8_SB(0, 0), b2, voffB);
            PG8_BAR; PG8_WAIT_L(0); PG8_MMA(0, 1, At, B1); PG8_BAR;
            PG8_LDA(At, 0, 1); PG8_STAGE(PG8_SA(0, 0), a2, voffA);
            PG8_BAR; PG8_WAIT_L(0); PG8_MMA(1, 0, At, B0); PG8_BAR; PG8_SCHED;
            PG8_STAGE(PG8_SB(0, 1), b2 + hstep, voffB);
            PG8_WAIT_V(6); PG8_BAR; PG8_MMA(1, 1, At, B1); PG8_BAR;
            PG8_LDB(B0, 1, 0); PG8_SCHED; PG8_LDA(At, 1, 0); PG8_STAGE(PG8_SA(0, 1), a2 + hstep, voffA);
            PG8_WAIT_L(8); PG8_BAR; PG8_WAIT_L(0); PG8_MMA(0, 0, At, B0); PG8_BAR; PG8_SCHED;
            PG8_LDB(B1, 1, 1); PG8_STAGE(PG8_SB(1, 0), b3, voffB);
            PG8_BAR; PG8_WAIT_L(0); PG8_MMA(0, 1, At, B1); PG8_BAR;
            PG8_LDA(At, 1, 1); PG8_STAGE(PG8_SA(1, 0), a3, voffA);
            PG8_BAR; PG8_WAIT_L(0); PG8_MMA(1, 0, At, B0); PG8_BAR; PG8_SCHED;
            PG8_STAGE(PG8_SB(1, 1), b3 + hstep, voffB);
            PG8_WAIT_V(6); PG8_BAR; PG8_MMA(1, 1, At, B1); PG8_BAR;
            }
        }
        if constexpr (ALIGN_EPI) { if (wr == 0) PG8_BAR; }
        { float rsv[2][4];
#pragma unroll
            for (int a = 0; a < 2; ++a)
#pragma unroll
                for (int m = 0; m < 4; ++m) { float q = ssq[a][m]; if constexpr (Epi::NEED_RS) { q += __shfl_xor(q, 16); q += __shfl_xor(q, 32); } rsv[a][m] = __builtin_amdgcn_rsqf(q * (1.0f / 1024.0f) + RMS_EPS); ssq[a][m] = 0.f; }
            E(acc, rsv, cur, wr, wc, fr, fq); S.done(cur); }
        if (!has_next) break;
#pragma unroll
        for (int a = 0; a < 2; ++a)
#pragma unroll
            for (int b = 0; b < 2; ++b)
#pragma unroll
                for (int m = 0; m < 4; ++m)
#pragma unroll
                    for (int n = 0; n < 2; ++n) acc[a][b][m][n] = (f32x4){0.f, 0.f, 0.f, 0.f};
        cur = nxt; cA = nA; cB = nB; ++ui;
        if constexpr (ALIGN_EPI) { if (wr == 1) PG8_BAR; }
    }
    PG8_WAIT_V(0);
    if constexpr (!ALIGN_EPI) { if (wr == 0) PG8_BAR; }
    PG8_BAR;
#undef PG8_SA
#undef PG8_SB
#undef PG8_STAGE
#undef PG8_LDA
#undef PG8_LDB
#undef PG8_MMA
#undef PG8_SSQ
#undef PG8_WAIT_V
#undef PG8_WAIT_L
#undef PG8_BAR
#undef PG8_SCHED
}
}
constexpr int NWAVES = 8;
constexpr int D = 1024, FF = 2816, NGU = 2 * FF, MIXW = 2048, DPLE = 256, DEPTH = 2;
constexpr int BATCH = 8, SEQ = 2048, DECB = 128, DECS = 8;
constexpr int MP = BATCH * SEQ, MS = DECB * DECS, M = MP + MS;
constexpr int NIN = 33;
constexpr size_t MiB = 1u << 20;
constexpr size_t WS_CTL = 0, CTL_ZERO_BYTES = 64 * 1024;
constexpr size_t WS_W = 1 * MiB;
constexpr size_t W_GU = (size_t)NGU * D * 2, W_DN = (size_t)D * FF * 2, W_MI = (size_t)MIXW * D * 2, W_MO = (size_t)D * D * 2, W_PG = (size_t)D * D * 2, W_PP = (size_t)D * DPLE * 2;
constexpr size_t WO_GU1 = 0, WO_D1 = WO_GU1 + W_GU, WO_MI = WO_D1 + W_DN, WO_MO = WO_MI + W_MI, WO_GU2 = WO_MO + W_MO, WO_D2 = WO_GU2 + W_GU, WO_PG = WO_D2 + W_DN, WO_PP = WO_PG + W_PG, W_LAYER = WO_PP + W_PP;
constexpr size_t WS_BUFA = WS_W + DEPTH * W_LAYER;
constexpr size_t BUF_BYTES = (size_t)M * D * 2;
constexpr size_t WS_BUFB = WS_BUFA + BUF_BYTES;
constexpr size_t WS_PB = WS_BUFB + BUF_BYTES;
constexpr size_t WS_ACT = WS_PB + (size_t)DEPTH * M * DPLE * 2;
constexpr size_t WS_END = WS_ACT + (size_t)M * FF * 2;
static_assert(WS_W % 256 == 0 && W_LAYER % 256 == 0 && WS_BUFA % 256 == 0 && WS_PB % 256 == 0 && WS_ACT % 256 == 0, "alignment");
constexpr int CW_BAR = 1024;
constexpr int RING_OFF = 0, RING_BYTES = 131072;
constexpr int LDSCTL_OFF = RING_BYTES, MISC_OFF = LDSCTL_OFF + 320;
constexpr int LDS_BYTES = 147456;
#define GAS __attribute__((address_space(1)))
#define LAS __attribute__((address_space(3)))
typedef unsigned short bf16;
typedef unsigned v4u __attribute__((ext_vector_type(4)));
typedef float f32x4 __attribute__((ext_vector_type(4)));
typedef short bf16x8 __attribute__((ext_vector_type(8)));
typedef GAS unsigned gu32;
typedef GAS unsigned long long gu64;
#define RLX_AGENT __ATOMIC_RELAXED, __HIP_MEMORY_SCOPE_AGENT
#define LDS_WAIT() asm volatile("s_waitcnt lgkmcnt(0)" ::: "memory")
#define VM_WAIT() asm volatile("s_waitcnt vmcnt(0)" ::: "memory")
__device__ __forceinline__ unsigned long long rt() { return __builtin_amdgcn_s_memrealtime(); }
__device__ __forceinline__ unsigned f2bf(float f) { unsigned u = __builtin_bit_cast(unsigned, f); return (u + 0x7fffu + ((u >> 16) & 1u)) >> 16; }
__device__ __forceinline__ unsigned pk2(float lo, float hi) { return f2bf(lo) | (f2bf(hi) << 16); }
#define XB_TMO      128
#define XB_XCNT(j)  (256  + 64 * (j))
#define XB_XSUB(j)  (1280 + 64 * (j))
#define XB_XGEN(j)  (2304 + 64 * (j))
#define XB_TOP      3328
#define XB_TOPGEN   3392
#define XCD_BAR_WORDS 3456
#define XB_SPIN_CAP (1u << 18)

__device__ __forceinline__ unsigned xb_ld(unsigned* p)              { return __hip_atomic_load(p, __ATOMIC_RELAXED, __HIP_MEMORY_SCOPE_AGENT); }
__device__ __forceinline__ unsigned xb_add(unsigned* p, unsigned v) { return __hip_atomic_fetch_add(p, v, __ATOMIC_RELAXED, __HIP_MEMORY_SCOPE_AGENT); }
__device__ __forceinline__ unsigned xb_xcc_id() { return (unsigned)__builtin_amdgcn_s_getreg((3 << 11) | 20) & 0xFu; }
#define XB_SPIN(cond, bar) do { unsigned _sp = 0; while (cond) { __builtin_amdgcn_s_sleep(1); \
    if ((++_sp & 255u) == 0u) { if (xb_ld(&(bar)[XB_TMO])) break; if (_sp > XB_SPIN_CAP) { atomicAdd(&(bar)[XB_TMO], 1u); break; } } } } while (0)

struct XcdBarrier {
    unsigned* bar; unsigned x;
    volatile LAS unsigned* st;
};

__device__ __forceinline__ XcdBarrier xcd_barrier_post(unsigned* bar, volatile LAS unsigned* st) {
    XcdBarrier b; b.bar = bar; b.x = xb_xcc_id(); b.st = st;
    if (threadIdx.x == 0) (void)xb_add(&bar[XB_XCNT(b.x)], 1u);
    return b;
}
__device__ __forceinline__ void xcd_barrier_complete(unsigned* bar, unsigned x, unsigned& nloc, unsigned& nx) {
    const unsigned G = gridDim.x * gridDim.y * gridDim.z;
    unsigned sum, cnt, mine, sp = 0u;
    for (;;) {
        sum = 0u; cnt = 0u; mine = 0u;
#pragma nounroll
        for (unsigned j = 0; j < 16; ++j) { const unsigned c = xb_ld(&bar[XB_XCNT(j)]); sum += c; cnt += (c > 0u) ? 1u : 0u; mine = (j == x) ? c : mine; }
        if (sum == G) break;
        __builtin_amdgcn_s_sleep(1);
        if ((++sp & 255u) == 0u) { if (xb_ld(&bar[XB_TMO])) break; if (sp > XB_SPIN_CAP) { atomicAdd(&bar[XB_TMO], 1u); break; } }
    }
    nloc = mine > 0u ? mine : 1u; nx = cnt > 0u ? cnt : 1u;
}

__device__ __forceinline__ void xcd_barrier(const XcdBarrier& b) {
    asm volatile("s_waitcnt vmcnt(0)" ::: "memory");
    __syncthreads();
    if (threadIdx.x == 0) {
        unsigned* bar = b.bar;
        __builtin_amdgcn_s_waitcnt(0);
        unsigned nloc = b.st[0], nx = b.st[1];
        if (nloc == 0u) { xcd_barrier_complete(bar, b.x, nloc, nx); b.st[0] = nloc; b.st[1] = nx; }
        const unsigned old = xb_add(&bar[XB_XSUB(b.x)], 1u);
        const unsigned gen = old / nloc;
        if (old + 1u == (gen + 1u) * nloc) {
            __builtin_amdgcn_fence(__ATOMIC_RELEASE, "agent");
            asm volatile("s_waitcnt vmcnt(0)" ::: "memory");
            const unsigned og = xb_add(&bar[XB_TOP], 1u);
            const unsigned tg = og / nx;
            if (og + 1u == (tg + 1u) * nx) xb_add(&bar[XB_TOPGEN], 1u);
            else XB_SPIN(xb_ld(&bar[XB_TOPGEN]) == tg, bar);
            __builtin_amdgcn_fence(__ATOMIC_ACQUIRE, "agent");
            xb_add(&bar[XB_XGEN(b.x)], 1u);
            asm volatile("s_waitcnt vmcnt(0)" ::: "memory");
        } else {
            XB_SPIN(xb_ld(&bar[XB_XGEN(b.x)]) == gen, bar);
            __builtin_amdgcn_fence(__ATOMIC_ACQUIRE, "agent");
            asm volatile("s_waitcnt vmcnt(0)" ::: "memory");
        }
    }
    __syncthreads();
}

__device__ __forceinline__ int opaque_s(int v) { asm volatile("" : "+s"(v)); return v; }
struct Args { const float* in[NIN]; float* out; unsigned char* ws; };
struct Frame {
    LAS unsigned char* lds;
    int tid, lane, wave, vcu, G;
};
__device__ __forceinline__ float wave_sum(float v) {
#pragma unroll
    for (int o = 1; o < 64; o <<= 1) v += __shfl_xor(v, o);
    return v;
}
__device__ __forceinline__ float bf2f(bf16 v) { return __uint_as_float((unsigned)v << 16); }
__device__ __forceinline__ float gelu_tanh(float v) {
    const float t = 1.5957691216057308f * (v + 0.044715f * v * v * v);
    return v * __builtin_amdgcn_rcpf(1.0f + __builtin_amdgcn_exp2f(t * -1.4426950408889634f));
}
__device__ __forceinline__ void p0_transpose_item(const float* W, int K, int N, bf16* WT, const float* gain, int mode, LAS float* scr, int item, int lane) {
    const int nblk = N / 32, kb = item / nblk, nb = item % nblk, k0 = 64 * kb, n0 = 32 * nb;
#pragma unroll 8
    for (int i = 0; i < 32; ++i) { const int kk = 2 * i + (lane >> 5); float w = W[(size_t)(k0 + kk) * N + n0 + (lane & 31)]; if (gain) w *= gain[k0 + kk]; scr[kk * 33 + (lane & 31)] = w; }
    LDS_WAIT(); asm volatile("" ::: "memory");
    const int c = lane & 7;
    const int rbase = (mode == 0) ? n0 : (256 * (n0 >> 7) + (n0 & 127) + (mode == 2 ? 128 : 0));
#pragma unroll
    for (int j = 0; j < 4; ++j) { const int n = (lane >> 3) + 8 * j; const LAS float* s = scr + (8 * c) * 33 + n;
        v4u o; o.x = pk2(s[0 * 33], s[1 * 33]); o.y = pk2(s[2 * 33], s[3 * 33]); o.z = pk2(s[4 * 33], s[5 * 33]); o.w = pk2(s[6 * 33], s[7 * 33]);
        *(GAS v4u*)(WT + (size_t)(rbase + n) * K + k0 + 8 * c) = o; }
    LDS_WAIT(); asm volatile("" ::: "memory");
}
__device__ __forceinline__ void p0_prologue(Frame& F, const Args& args) {
    LAS float* scr = (LAS float*)(F.lds + RING_OFF + F.wave * 16384);
    const int gw = F.vcu * NWAVES + F.wave, NGW = F.G * NWAVES;
    unsigned char* ws = args.ws;
    constexpr int I_GU = (D / 64) * (FF / 32), I_DN = (FF / 64) * (D / 32), I_MI = (D / 64) * (MIXW / 32), I_SQ = (D / 64) * (D / 32), I_PP = (DPLE / 64) * (D / 32);
    constexpr int I_LAYER = 6 * I_GU + I_MI + 2 * I_SQ + I_PP;
    static_assert(I_DN == I_GU, "item counts");
    for (int it = gw; it < DEPTH * I_LAYER; it += NGW) {
        const int li = it / I_LAYER; int r = it % I_LAYER;
        unsigned char* wl = ws + WS_W + (size_t)li * W_LAYER;
        if (r < I_GU) { p0_transpose_item(args.in[opaque_s(8)] + (size_t)li * D * FF, D, FF, (bf16*)(wl + WO_GU1), args.in[opaque_s(7)] + li * D, 1, scr, r, F.lane); continue; } r -= I_GU;
        if (r < I_GU) { p0_transpose_item(args.in[opaque_s(9)] + (size_t)li * D * FF, D, FF, (bf16*)(wl + WO_GU1), args.in[opaque_s(7)] + li * D, 2, scr, r, F.lane); continue; } r -= I_GU;
        if (r < I_GU) { p0_transpose_item(args.in[opaque_s(10)] + (size_t)li * D * FF, FF, D, (bf16*)(wl + WO_D1), nullptr, 0, scr, r, F.lane); continue; } r -= I_GU;
        if (r < I_GU) { p0_transpose_item(args.in[opaque_s(26)] + (size_t)li * D * FF, D, FF, (bf16*)(wl + WO_GU2), args.in[opaque_s(25)] + li * D, 1, scr, r, F.lane); continue; } r -= I_GU;
        if (r < I_GU) { p0_transpose_item(args.in[opaque_s(27)] + (size_t)li * D * FF, D, FF, (bf16*)(wl + WO_GU2), args.in[opaque_s(25)] + li * D, 2, scr, r, F.lane); continue; } r -= I_GU;
        if (r < I_GU) { p0_transpose_item(args.in[opaque_s(28)] + (size_t)li * D * FF, FF, D, (bf16*)(wl + WO_D2), nullptr, 0, scr, r, F.lane); continue; } r -= I_GU;
        if (r < I_MI) { p0_transpose_item(args.in[opaque_s(12)] + (size_t)li * D * MIXW, D, MIXW, (bf16*)(wl + WO_MI), args.in[opaque_s(11)] + li * D, 0, scr, r, F.lane); continue; } r -= I_MI;
        if (r < I_SQ) { p0_transpose_item(args.in[opaque_s(24)] + (size_t)li * D * D, D, D, (bf16*)(wl + WO_MO), nullptr, 0, scr, r, F.lane); continue; } r -= I_SQ;
        if (r < I_SQ) { p0_transpose_item(args.in[opaque_s(30)] + (size_t)li * D * D, D, D, (bf16*)(wl + WO_PG), args.in[opaque_s(29)] + li * D, 0, scr, r, F.lane); continue; } r -= I_SQ;
        p0_transpose_item(args.in[opaque_s(31)] + (size_t)li * DPLE * D, DPLE, D, (bf16*)(wl + WO_PP), nullptr, 0, scr, r, F.lane);
    }
    float* X = args.out; bf16* XB = (bf16*)(ws + WS_BUFA);
    for (int m = gw; m < M; m += NGW) {
        const float* src = (m < MP) ? args.in[opaque_s(0)] + (size_t)m * D : args.in[opaque_s(1)] + (size_t)(m - MP) * D;
        const GAS f32x4* xr = (const GAS f32x4*)src + F.lane; GAS f32x4* xo = (GAS f32x4*)(X + (size_t)m * D) + F.lane;
        GAS unsigned long long* o8 = (GAS unsigned long long*)(XB + (size_t)m * D) + F.lane;
#pragma unroll
        for (int j = 0; j < 4; ++j) { const f32x4 v = xr[64 * j]; xo[64 * j] = v;
            o8[64 * j] = (unsigned long long)pk2(v.x, v.y) | ((unsigned long long)pk2(v.z, v.w) << 32); }
    }
    bf16* PB = (bf16*)(ws + WS_PB);
    for (int q = gw; q < DEPTH * M; q += NGW) {
        const int li = q / M, m = q % M;
        const float* src = (m < MP) ? args.in[opaque_s(2)] + ((size_t)li * MP + m) * DPLE : args.in[opaque_s(3)] + ((size_t)li * MS + (m - MP)) * DPLE;
        const f32x4 v = ((const GAS f32x4*)src)[F.lane];
        ((GAS unsigned long long*)(PB + (size_t)q * DPLE))[F.lane] = (unsigned long long)pk2(v.x, v.y) | ((unsigned long long)pk2(v.z, v.w) << 32);
    }
}
__device__ __forceinline__ void final_norm(Frame& F, const Args& args) {
    const int gw = F.vcu * NWAVES + F.wave, NGW = F.G * NWAVES;
    float* X = args.out; const float* g = args.in[opaque_s(32)];
    f32x4 gv[4];
#pragma unroll
    for (int j = 0; j < 4; ++j) gv[j] = ((const GAS f32x4*)g)[F.lane + 64 * j];
    for (int m = gw; m < M; m += NGW) {
        GAS f32x4* xo = (GAS f32x4*)(X + (size_t)m * D) + F.lane;
        f32x4 v[4]; float s = 0.f;
#pragma unroll
        for (int j = 0; j < 4; ++j) { v[j] = xo[64 * j]; s += (v[j].x * v[j].x + v[j].y * v[j].y) + (v[j].z * v[j].z + v[j].w * v[j].w); }
        const float rs = __builtin_amdgcn_rsqf(wave_sum(s) * (1.0f / D) + pg8::RMS_EPS);
#pragma unroll
        for (int j = 0; j < 4; ++j) xo[64 * j] = v[j] * rs * gv[j];
    }
}
constexpr size_t O_Y = 0, O_CA_P = (size_t)M * D, O_CA_S = O_CA_P + (size_t)DEPTH * BATCH * 30 * 256, O_PL_P = O_CA_S + (size_t)DEPTH * DECB * 30 * 256,
                 O_PL_S = O_PL_P + (size_t)DEPTH * BATCH * 15 * 256, O_SC_P = O_PL_S + (size_t)DEPTH * DECB * 15 * 256, O_SC_S = O_SC_P + (size_t)DEPTH * BATCH * 2 * 256,
                 O_CV_S = O_SC_S + (size_t)DEPTH * DECB * 2 * 256, O_END = O_CV_S + (size_t)DEPTH * DECB * DECS * 256;
constexpr float LN_EPS = 1e-6f;
constexpr int VNT_OFF = 0, VNT_PITCH = 272, WPT_OFF = 64 * VNT_PITCH, WPT_PITCH = 144, DT_OFF = WPT_OFF + 64 * WPT_PITCH, DT_PITCH = 144;
struct MixP { const bf16* Z; bf16* MIX; const float *caw, *cab, *nag, *nab, *pw, *ps, *sng, *snb, *sw, *sb, *scw; float* out; int li; const float *st_a, *st_p, *st_s; };
#define OPAQUE_S(p) asm volatile("" : "+s"(p))
template <class T> __device__ __forceinline__ T* uni_ptr(T* p) {
    const unsigned long long v = (unsigned long long)p; const unsigned lo = __builtin_amdgcn_readfirstlane((unsigned)v), hi = __builtin_amdgcn_readfirstlane((unsigned)(v >> 32));
    return (T*)(((unsigned long long)hi << 32) | lo); }
__device__ __forceinline__ bf16 f2bf16(float f) { return (bf16)f2bf(f); }
__device__ __forceinline__ float pool_sel(int h, float s2, float s4, float s8, float s16) { return h == 0 ? s2 : (h == 1 ? s4 : (h == 2 ? s8 : s16)); }

__device__ __forceinline__ void mix_prompt_unit(Frame& F, const MixP& P, int b, int c, int h) {
    const int w = F.wave, lane = F.lane, ch = h * 64 + lane, fr = lane & 15, fq = lane >> 4;
    const int tb = __builtin_amdgcn_readfirstlane(128 * c + 16 * w);
    const bf16* Zs = uni_ptr(P.Z + (size_t)b * SEQ * MIXW);
    bf16* Ms = uni_ptr(P.MIX + (size_t)b * SEQ * D);
    const int li = P.li;
    { const int n = F.tid & 63, kg = F.tid >> 6; const float* src = P.pw + (size_t)h * 4096 + (size_t)(8 * kg) * 64 + n;
      v4u o; o.x = pk2(src[0], src[64]); o.y = pk2(src[128], src[192]); o.z = pk2(src[256], src[320]); o.w = pk2(src[384], src[448]);
      *(LAS v4u*)(F.lds + WPT_OFF + n * WPT_PITCH + kg * 16) = o; }
    {
        float wA[31];
        { const float* wp = P.caw;
#pragma unroll
        for (int k = 0; k < 31; ++k) { wA[k] = wp[ch]; wp += 256; OPAQUE_S(wp); } }
        float ext[46];
        { const bf16* zp = uni_ptr(Zs + ((ptrdiff_t)(tb - 30) * MIXW));
#pragma unroll
        for (int j = 0; j < 46; ++j) { const bool ok = (tb - 30 + j) >= 0; const bf16* zq = ok ? zp : Zs; const float msk = ok ? 1.f : 0.f;
            const float av = bf2f(zq[ch]), ag = bf2f(zq[256 + ch]); ext[j] = av * pg8::sigmoid_f(ag) * msk; zp += MIXW; OPAQUE_S(zp); } }
        const float bias = P.cab[ch], g = P.nag[ch], nb = P.nab[ch];
        bf16* mp = uni_ptr(Ms + (size_t)tb * D);
        float* sp = uni_ptr(P.out + O_CA_P + ((ptrdiff_t)(li * BATCH + b) * 30 + (tb - (SEQ - 30))) * 256);
#pragma unroll
        for (int r = 0; r < 16; ++r) { float cv = bias;
#pragma unroll
            for (int k = 0; k < 31; ++k) cv += wA[k] * ext[r + k];
            const float mean = wave_sum(cv) * (1.f / 64.f), dv = cv - mean, var = wave_sum(dv * dv) * (1.f / 64.f);
            const float y = dv * __builtin_amdgcn_rsqf(var + LN_EPS) * g + nb;
            mp[ch] = f2bf16(pg8::silu_f(y)); mp += D; OPAQUE_S(mp);
            if (c == 15 && tb + r >= SEQ - 30) sp[ch] = ext[r + 30];
            sp += 256; OPAQUE_S(sp); }
    }
    {
        float ze[31];
        { const bf16* zp = uni_ptr(Zs + ((ptrdiff_t)(tb - 15) * MIXW));
#pragma unroll
        for (int j = 0; j < 31; ++j) { const bool ok = (tb - 15 + j) >= 0; const bf16* zq = ok ? zp : Zs; ze[j] = bf2f(zq[512 + ch]) * (ok ? 1.f : 0.f); zp += MIXW; OPAQUE_S(zp); } }
        float* sp = uni_ptr(P.out + O_PL_P + ((ptrdiff_t)(li * BATCH + b) * 15 + (tb - (SEQ - 15))) * 256);
        LAS unsigned char* dT = F.lds + DT_OFF + w * 16 * DT_PITCH;
        const int win = 2 << h;
#pragma unroll
        for (int r = 0; r < 16; ++r) { const float zc = ze[r + 15];
            const float s2 = zc + ze[r + 14], s4 = s2 + (ze[r + 13] + ze[r + 12]), s8 = s4 + ((ze[r + 11] + ze[r + 10]) + (ze[r + 9] + ze[r + 8]));
            const float s16 = s8 + (((ze[r + 7] + ze[r + 6]) + (ze[r + 5] + ze[r + 4])) + ((ze[r + 3] + ze[r + 2]) + (ze[r + 1] + ze[r])));
            const int t = tb + r; const float cnt = (float)((t + 1 < win) ? t + 1 : win);
            const float d = pool_sel(h, s2, s4, s8, s16) / cnt - zc;
            *(LAS bf16*)(dT + r * DT_PITCH + lane * 2) = f2bf16(d);
            if (c == 15 && t >= SEQ - 15) sp[ch] = zc;
            sp += 256; OPAQUE_S(sp); }
    }
    __syncthreads();
    {
        const LAS unsigned char* dT = F.lds + DT_OFF + w * 16 * DT_PITCH;
        const bf16x8 b0 = *(const LAS bf16x8*)(dT + fr * DT_PITCH + (fq * 8) * 2), b1 = *(const LAS bf16x8*)(dT + fr * DT_PITCH + (32 + fq * 8) * 2);
#pragma unroll
        for (int nt = 0; nt < 4; ++nt) {
            const LAS unsigned char* wp = F.lds + WPT_OFF + (16 * nt + fr) * WPT_PITCH;
            const bf16x8 a0 = *(const LAS bf16x8*)(wp + (fq * 8) * 2), a1 = *(const LAS bf16x8*)(wp + (32 + fq * 8) * 2);
            f32x4 acc = {0.f, 0.f, 0.f, 0.f};
            acc = __builtin_amdgcn_mfma_f32_16x16x32_bf16(a0, b0, acc, 0, 0, 0);
            acc = __builtin_amdgcn_mfma_f32_16x16x32_bf16(a1, b1, acc, 0, 0, 0);
            const int n = 16 * nt + 4 * fq; const f32x4 sc = *(const f32x4*)(P.ps + h * 64 + n);
            const unsigned lo = pk2(acc[0] * sc[0], acc[1] * sc[1]), hi = pk2(acc[2] * sc[2], acc[3] * sc[3]);
            *(GAS unsigned long long*)(Ms + (size_t)(tb + fr) * D + 256 + h * 64 + n) = (unsigned long long)lo | ((unsigned long long)hi << 32);
        }
    }
    {
        const float g = P.sng[ch], nb = P.snb[ch];
        unsigned pk[8];
        const bf16* zp = uni_ptr(Zs + (size_t)tb * MIXW);
#pragma unroll
        for (int r = 0; r < 16; r += 2) { float vn[2];
#pragma unroll
            for (int q = 0; q < 2; ++q) { const float v = gelu_tanh(bf2f(zp[1024 + ch])); zp += MIXW; OPAQUE_S(zp);
                const float mean = wave_sum(v) * (1.f / 64.f), dv = v - mean, var = wave_sum(dv * dv) * (1.f / 64.f);
                vn[q] = dv * __builtin_amdgcn_rsqf(var + LN_EPS) * g + nb; }
            pk[r >> 1] = pk2(vn[0], vn[1]); }
        LAS unsigned char* vt = F.lds + VNT_OFF + lane * VNT_PITCH + (16 * w) * 2;
        *(LAS v4u*)(vt) = (v4u){pk[0], pk[1], pk[2], pk[3]}; *(LAS v4u*)(vt + 16) = (v4u){pk[4], pk[5], pk[6], pk[7]};
    }
    __syncthreads();
    {
        const int nks = (w >> 1) + 1, tl = 16 * w + fr;
        const float* wrow = P.sw + ((size_t)h * 128 + tl) * 128;
        bf16x8 bw[4];
#pragma unroll
        for (int ks = 0; ks < 4; ++ks) { bf16x8 t = {0, 0, 0, 0, 0, 0, 0, 0};
            if (ks < nks) { const int s0 = 32 * ks + 8 * fq; const f32x4 a = *(const f32x4*)(wrow + s0), bq = *(const f32x4*)(wrow + s0 + 4);
                float e[8] = {a[0], a[1], a[2], a[3], bq[0], bq[1], bq[2], bq[3]};
#pragma unroll
                for (int j = 0; j < 8; ++j) t[j] = (short)f2bf((s0 + j <= tl) ? e[j] : 0.f); }
            bw[ks] = t; }
        const float bsv = P.sb[h * 128 + tl];
#pragma unroll
        for (int ct = 0; ct < 4; ++ct) {
            const LAS unsigned char* vp = F.lds + VNT_OFF + (16 * ct + fr) * VNT_PITCH + (8 * fq) * 2;
            f32x4 acc = {0.f, 0.f, 0.f, 0.f};
#pragma unroll
            for (int ks = 0; ks < 4; ++ks) if (ks < nks) acc = __builtin_amdgcn_mfma_f32_16x16x32_bf16(*(const LAS bf16x8*)(vp + 64 * ks), bw[ks], acc, 0, 0, 0);
            const int cc = h * 64 + 16 * ct + 4 * fq; const size_t ro = (size_t)(tb + fr);
            const unsigned long long uw = *(const GAS unsigned long long*)(Zs + ro * MIXW + 768 + cc);
            const float u0 = gelu_tanh(__uint_as_float((unsigned)uw << 16)), u1 = gelu_tanh(__uint_as_float((unsigned)uw & 0xffff0000u));
            const float u2 = gelu_tanh(__uint_as_float((unsigned)(uw >> 32) << 16)), u3 = gelu_tanh(__uint_as_float((unsigned)(uw >> 32) & 0xffff0000u));
            const unsigned lo = pk2(u0 * (acc[0] + bsv), u1 * (acc[1] + bsv)), hi = pk2(u2 * (acc[2] + bsv), u3 * (acc[3] + bsv));
            *(GAS unsigned long long*)(Ms + ro * D + 512 + cc) = (unsigned long long)lo | ((unsigned long long)hi << 32);
        }
    }
    {
        float q[18], bg[16];
        { const bf16* zp = uni_ptr(Zs + ((ptrdiff_t)(tb - 2) * MIXW));
#pragma unroll
        for (int j = 0; j < 18; ++j) { const bool ok = (tb - 2 + j) >= 0; const bf16* zq = ok ? zp : Zs; q[j] = bf2f(zq[1536 + ch]) * bf2f(zq[1792 + ch]) * (ok ? 1.f : 0.f);
            if (j >= 2) bg[j - 2] = bf2f(zq[1280 + ch]);
            zp += MIXW; OPAQUE_S(zp); } }
        const float w0 = P.scw[ch], w1 = P.scw[256 + ch], w2 = P.scw[512 + ch];
        bf16* mp = uni_ptr(Ms + (size_t)tb * D);
        float* sp = uni_ptr(P.out + O_SC_P + ((ptrdiff_t)(li * BATCH + b) * 2 + (tb - (SEQ - 2))) * 256);
#pragma unroll
        for (int r = 0; r < 16; ++r) { const int t = tb + r; const float y = w0 * q[r] + w1 * q[r + 1] + w2 * q[r + 2];
            mp[768 + ch] = f2bf16(bg[r] * y); mp += D; OPAQUE_S(mp);
            if (c == 15 && t >= SEQ - 2) sp[ch] = q[r + 2];
            sp += 256; OPAQUE_S(sp); }
    }
    __syncthreads();
}
__device__ __forceinline__ void mix_sample_wave(Frame& F, const MixP& P, int b, int h) {
    const int lane = F.lane, ch = h * 64 + lane, li = P.li;
    b = __builtin_amdgcn_readfirstlane(b); h = __builtin_amdgcn_readfirstlane(h);
    const bf16* Zr = uni_ptr(P.Z + (size_t)(MP + b * DECS) * MIXW); bf16* Mr = uni_ptr(P.MIX + (size_t)(MP + b * DECS) * D);
    const size_t sb_ = (size_t)li * DECB + b;
    {
        float wA[31];
        { const float* wp = P.caw;
#pragma unroll
        for (int k = 0; k < 31; ++k) { wA[k] = wp[ch]; wp += 256; OPAQUE_S(wp); } }
        float ext[38];
        { const float* sp = P.st_a + sb_ * 30 * 256; float* so = P.out + O_CA_S + sb_ * 30 * 256;
#pragma unroll
        for (int j = 0; j < 30; ++j) { ext[j] = sp[ch]; sp += 256; OPAQUE_S(sp); }
        const bf16* zp = Zr;
#pragma unroll
        for (int t = 0; t < 8; ++t) { ext[30 + t] = bf2f(zp[ch]) * pg8::sigmoid_f(bf2f(zp[256 + ch])); zp += MIXW; OPAQUE_S(zp); }
#pragma unroll
        for (int j = 0; j < 30; ++j) { so[ch] = ext[j + 8]; so += 256; OPAQUE_S(so); } }
        const float bias = P.cab[ch], g = P.nag[ch], nb = P.nab[ch];
        bf16* mp = Mr;
#pragma unroll
        for (int t = 0; t < 8; ++t) { float cv = bias;
#pragma unroll
            for (int k = 0; k < 31; ++k) cv += wA[k] * ext[t + k];
            const float mean = wave_sum(cv) * (1.f / 64.f), dv = cv - mean, var = wave_sum(dv * dv) * (1.f / 64.f);
            mp[ch] = f2bf16(pg8::silu_f(dv * __builtin_amdgcn_rsqf(var + LN_EPS) * g + nb)); mp += D; OPAQUE_S(mp); }
    }
    {
        float ze[23];
        { const float* sp = P.st_p + sb_ * 15 * 256; float* so = P.out + O_PL_S + sb_ * 15 * 256;
#pragma unroll
        for (int j = 0; j < 15; ++j) { ze[j] = sp[ch]; sp += 256; OPAQUE_S(sp); }
        const bf16* zp = Zr;
#pragma unroll
        for (int t = 0; t < 8; ++t) { ze[15 + t] = bf2f(zp[512 + ch]); zp += MIXW; OPAQUE_S(zp); }
#pragma unroll
        for (int j = 0; j < 15; ++j) { so[ch] = ze[j + 8]; so += 256; OPAQUE_S(so); } }
        float d[8], y[8];
        const float inv = 1.0f / (float)(2 << h);
#pragma unroll
        for (int r = 0; r < 8; ++r) { const float zc = ze[r + 15];
            const float s2 = zc + ze[r + 14], s4 = s2 + (ze[r + 13] + ze[r + 12]), s8 = s4 + ((ze[r + 11] + ze[r + 10]) + (ze[r + 9] + ze[r + 8]));
            const float s16 = s8 + (((ze[r + 7] + ze[r + 6]) + (ze[r + 5] + ze[r + 4])) + ((ze[r + 3] + ze[r + 2]) + (ze[r + 1] + ze[r])));
            d[r] = pool_sel(h, s2, s4, s8, s16) * inv - zc; y[r] = 0.f; }
        const float* pwh = P.pw + (size_t)h * 4096;
#pragma unroll 8
        for (int k = 0; k < 64; ++k) { const float wv = pwh[lane]; pwh += 64;
#pragma unroll
            for (int r = 0; r < 8; ++r) y[r] += __shfl(d[r], k) * wv; }
        const float sc = P.ps[ch];
        bf16* mp = Mr;
#pragma unroll
        for (int r = 0; r < 8; ++r) { mp[256 + ch] = f2bf16(y[r] * sc); mp += D; OPAQUE_S(mp); }
    }
    {
        const float g = P.sng[ch], nb = P.snb[ch];
        float vn[8], ug[8];
        { const bf16* zp = Zr; float* so = P.out + O_CV_S + sb_ * DECS * 256;
#pragma unroll
        for (int t = 0; t < 8; ++t) { const float v = gelu_tanh(bf2f(zp[1024 + ch])); ug[t] = gelu_tanh(bf2f(zp[768 + ch])); zp += MIXW; OPAQUE_S(zp);
            const float mean = wave_sum(v) * (1.f / 64.f), dv = v - mean, var = wave_sum(dv * dv) * (1.f / 64.f);
            vn[t] = dv * __builtin_amdgcn_rsqf(var + LN_EPS) * g + nb;
            so[ch] = vn[t]; so += 256; OPAQUE_S(so); } }
        bf16* mp = Mr; const float* swp = P.sw + (size_t)h * 128 * 128; const float* sbp = P.sb + h * 128;
#pragma unroll
        for (int t = 0; t < 8; ++t) { float s = sbp[t];
#pragma unroll
            for (int q = 0; q <= t; ++q) s += swp[q] * vn[q];
            swp += 128; OPAQUE_S(swp);
            mp[512 + ch] = f2bf16(ug[t] * s); mp += D; OPAQUE_S(mp); }
    }
    {
        float q[10], bg[8];
        q[0] = P.st_s[(sb_ * 2 + 0) * 256 + ch]; q[1] = P.st_s[(sb_ * 2 + 1) * 256 + ch];
        { const bf16* zp = Zr;
#pragma unroll
        for (int t = 0; t < 8; ++t) { q[2 + t] = bf2f(zp[1536 + ch]) * bf2f(zp[1792 + ch]); bg[t] = bf2f(zp[1280 + ch]); zp += MIXW; OPAQUE_S(zp); } }
        const float w0 = P.scw[ch], w1 = P.scw[256 + ch], w2 = P.scw[512 + ch];
        bf16* mp = Mr;
#pragma unroll
        for (int t = 0; t < 8; ++t) { mp[768 + ch] = f2bf16(bg[t] * (w0 * q[t] + w1 * q[t + 1] + w2 * q[t + 2])); mp += D; OPAQUE_S(mp); }
        P.out[O_SC_S + (sb_ * 2 + 0) * 256 + ch] = q[8]; P.out[O_SC_S + (sb_ * 2 + 1) * 256 + ch] = q[9];
    }
}
constexpr int MIX_PUNITS = BATCH * 16 * 4, MIX_SUNITS = DECB * 4 / NWAVES;
__device__ __forceinline__ void mix_phase(Frame& F, const MixP& P) {
    for (int u = blockIdx.x; u < MIX_PUNITS + MIX_SUNITS; u += F.G) {
        asm volatile("" : "+v"(F.tid), "+v"(F.lane), "+s"(F.wave) :: "memory");
        if (u < MIX_PUNITS) mix_prompt_unit(F, P, u >> 6, (u >> 2) & 15, u & 3);
        else { const int wu = (u - MIX_PUNITS) * NWAVES + F.wave; mix_sample_wave(F, P, wu >> 2, wu & 3); }
    }
}
__global__ void __launch_bounds__(NWAVES * 64, 2) fwd_megakernel(Args args) {
    extern __shared__ __attribute__((aligned(16))) unsigned char lds[];
    Frame F;
    F.lds = (LAS unsigned char*)lds;
    F.tid = threadIdx.x; F.lane = F.tid & 63; F.wave = __builtin_amdgcn_readfirstlane(F.tid >> 6);
    F.G = gridDim.x; { const int bx = blockIdx.x; F.vcu = (F.G % 8 == 0) ? (bx % 8) * (F.G / 8) + bx / 8 : bx; }
    unsigned char* ws = args.ws;
    for (int u = F.tid; u < (LDS_BYTES - LDSCTL_OFF) / 4; u += NWAVES * 64) ((LAS unsigned*)(F.lds + LDSCTL_OFF))[u] = 0u;
    __syncthreads();
    XcdBarrier bar = xcd_barrier_post((unsigned*)(ws + WS_CTL) + CW_BAR, (volatile LAS unsigned*)(F.lds + MISC_OFF) + 8);
#define GRID_BAR() do { asm volatile("" : "+s"(bar.bar)); xcd_barrier(bar); asm volatile("" : "+v"(F.tid), "+v"(F.lane), "+s"(F.wave) :: "memory"); } while (0)
#if defined(NO_GEMM) || (defined(ONLY) && ONLY != 1)
#define RUN_GEMM1(...)
#else
#define RUN_GEMM1(...) __VA_ARGS__
#endif
#if defined(NO_GEMM) || (defined(ONLY) && ONLY != 2)
#define RUN_GEMM2(...)
#else
#define RUN_GEMM2(...) __VA_ARGS__
#endif
#if defined(NO_GEMM) || (defined(ONLY) && ONLY != 3)
#define RUN_GEMM3(...)
#else
#define RUN_GEMM3(...) __VA_ARGS__
#endif
#if defined(NO_GEMM) || (defined(ONLY) && ONLY != 4)
#define RUN_GEMM4(...)
#else
#define RUN_GEMM4(...) __VA_ARGS__
#endif
#if defined(NO_GEMM) || (defined(ONLY) && ONLY != 5)
#define RUN_GEMM5(...)
#else
#define RUN_GEMM5(...) __VA_ARGS__
#endif
#if defined(NO_GEMM) || (defined(ONLY) && ONLY != 6)
#define RUN_GEMM6(...)
#else
#define RUN_GEMM6(...) __VA_ARGS__
#endif
#if defined(NO_GEMM) || (defined(ONLY) && ONLY != 7)
#define RUN_GEMM7(...)
#else
#define RUN_GEMM7(...) __VA_ARGS__
#endif
#if defined(NO_GEMM) || (defined(ONLY) && ONLY != 8)
#define RUN_GEMM8(...)
#else
#define RUN_GEMM8(...) __VA_ARGS__
#endif

#ifndef NO_PRO
    p0_prologue(F, args);
#endif
    cg::this_grid().sync();
    GRID_BAR();

    float* X = args.out;
    pg8::bf16_t* ACT = (pg8::bf16_t*)(ws + WS_ACT);
    const int G = F.G, cu = (int)blockIdx.x;
    for (int li = 0; li < DEPTH; ++li) {
        pg8::bf16_t* XB = (pg8::bf16_t*)(ws + ((li & 1) ? WS_BUFB : WS_BUFA));
        pg8::bf16_t* MX = (pg8::bf16_t*)(ws + ((li & 1) ? WS_BUFA : WS_BUFB));
        const unsigned char* wl = ws + WS_W + (size_t)li * W_LAYER;
        { pg8::Gemm g{XB, (const pg8::bf16_t*)(wl + WO_GU1), M, NGU, D}; pg8::StaticOrder S; S.init(M, NGU, G, opaque_s(cu));
          pg8::EpiSwiGLU E{ACT, FF}; RUN_GEMM1(pg8::gemm_phase<pg8::EpiSwiGLU, pg8::StaticOrder, true, true>(F.lds + RING_OFF, g, S, E);) }
        GRID_BAR();
        { pg8::Gemm g{ACT, (const pg8::bf16_t*)(wl + WO_D1), M, D, FF}; pg8::StaticOrder S; S.init(M, D, G, opaque_s(cu));
          pg8::EpiResid<0> E{X, XB, 0.5f, nullptr}; RUN_GEMM2(pg8::gemm_phase<pg8::EpiResid<0>, pg8::StaticOrder, true, true>(F.lds + RING_OFF, g, S, E);) }
        GRID_BAR();
        { pg8::Gemm g{XB, (const pg8::bf16_t*)(wl + WO_MI), M, MIXW, D}; pg8::StaticOrder S; S.init(M, MIXW, G, opaque_s(cu));
          pg8::EpiScaleBf16<true> E{ACT, MIXW}; RUN_GEMM3(pg8::gemm_phase<pg8::EpiScaleBf16<true>, pg8::StaticOrder, true, true>(F.lds + RING_OFF, g, S, E);) }
        GRID_BAR();
        { MixP P; P.Z = (const bf16*)ACT; P.MIX = (bf16*)MX; P.caw = args.in[opaque_s(13)] + (size_t)li * 31 * 256; P.cab = args.in[opaque_s(14)] + li * 256; P.nag = args.in[opaque_s(15)] + li * 256; P.nab = args.in[opaque_s(16)] + li * 256;
          P.pw = args.in[opaque_s(17)] + (size_t)li * 4 * 4096; P.ps = args.in[opaque_s(18)] + li * 256; P.sng = args.in[opaque_s(19)] + li * 256; P.snb = args.in[opaque_s(20)] + li * 256;
          P.sw = args.in[opaque_s(21)] + (size_t)li * 4 * 128 * 128; P.sb = args.in[opaque_s(22)] + li * 4 * 128; P.scw = args.in[opaque_s(23)] + li * 3 * 256; P.out = args.out; P.li = li;
          P.st_a = args.in[opaque_s(4)]; P.st_p = args.in[opaque_s(5)]; P.st_s = args.in[opaque_s(6)];
#ifndef NO_MIX
          mix_phase(F, P);
#endif
        }
        GRID_BAR();
        { pg8::Gemm g{MX, (const pg8::bf16_t*)(wl + WO_MO), M, D, D}; pg8::StaticOrder S; S.init(M, D, G, opaque_s(cu));
          pg8::EpiResid<0> E{X, XB, 1.0f, nullptr}; RUN_GEMM4(pg8::gemm_phase<pg8::EpiResid<0>, pg8::StaticOrder, true, true>(F.lds + RING_OFF, g, S, E);) }
        GRID_BAR();
        { pg8::Gemm g{XB, (const pg8::bf16_t*)(wl + WO_GU2), M, NGU, D}; pg8::StaticOrder S; S.init(M, NGU, G, opaque_s(cu));
          pg8::EpiSwiGLU E{ACT, FF}; RUN_GEMM5(pg8::gemm_phase<pg8::EpiSwiGLU, pg8::StaticOrder, true, true>(F.lds + RING_OFF, g, S, E);) }
        GRID_BAR();
        { pg8::Gemm g{ACT, (const pg8::bf16_t*)(wl + WO_D2), M, D, FF}; pg8::StaticOrder S; S.init(M, D, G, opaque_s(cu));
          pg8::EpiResid<0> E{X, XB, 0.5f, nullptr}; RUN_GEMM6(pg8::gemm_phase<pg8::EpiResid<0>, pg8::StaticOrder, true, true>(F.lds + RING_OFF, g, S, E);) }
        { pg8::Gemm g{(const pg8::bf16_t*)(ws + WS_PB) + (size_t)li * M * DPLE, (const pg8::bf16_t*)(wl + WO_PP), M, D, DPLE}; pg8::StaticOrder S; S.init(M, D, G, opaque_s((cu + 128) % G));
          pg8::EpiScaleBf16<false> E{MX, D}; RUN_GEMM7(pg8::gemm_phase<pg8::EpiScaleBf16<false>, pg8::StaticOrder, true, true>(F.lds + RING_OFF, g, S, E);) }
        GRID_BAR();
        { pg8::Gemm g{XB, (const pg8::bf16_t*)(wl + WO_PG), M, D, D}; pg8::StaticOrder S; S.init(M, D, G, opaque_s(cu));
          pg8::EpiResid<1> E{X, MX, 0.f, MX}; RUN_GEMM8(pg8::gemm_phase<pg8::EpiResid<1>, pg8::StaticOrder, true, true>(F.lds + RING_OFF, g, S, E);) }
        GRID_BAR();
    }
#ifndef NO_FIN
    final_norm(F, args);
#endif
}

extern "C" void kernel_launch(void* const* d_in, const int* in_sizes, int n_in, void* d_out, int out_size, void* d_ws, size_t ws_size, hipStream_t stream) {
    static int grid = 0;
    if (grid == 0) {
        if (n_in != NIN || in_sizes[0] != MP * D || (size_t)out_size != O_END || ws_size < WS_END) {
            fprintf(stderr, "kernel_launch: unexpected shapes: n_in %d in0 %d out %d (want %zu) ws %zu (need %zu); nothing launched\n", n_in, n_in > 0 ? in_sizes[0] : -1, out_size, (size_t)O_END, ws_size, (size_t)WS_END); grid = -1; return; }
        int dev = 0, cus = 0, per_cu = 0;
        if (hipGetDevice(&dev) != hipSuccess || hipDeviceGetAttribute(&cus, hipDeviceAttributeMultiprocessorCount, dev) != hipSuccess) { grid = -1; return; }
        if (hipFuncSetAttribute((const void*)fwd_megakernel, hipFuncAttributeMaxDynamicSharedMemorySize, LDS_BYTES) != hipSuccess) { fprintf(stderr, "kernel_launch: hipFuncSetAttribute failed\n"); grid = -1; return; }
        if (hipOccupancyMaxActiveBlocksPerMultiprocessor(&per_cu, (const void*)fwd_megakernel, NWAVES * 64, LDS_BYTES) != hipSuccess || per_cu < 1) { fprintf(stderr, "kernel_launch: occupancy query says %d\n", per_cu); per_cu = 1; }
        (void)hipGetLastError();
        grid = cus;
    }
    if (grid < 0) return;
    if (hipMemsetAsync((char*)d_ws + WS_CTL, 0, CTL_ZERO_BYTES, stream) != hipSuccess) { fprintf(stderr, "kernel_launch: memset failed\n"); return; }
    Args a{};
    for (int i = 0; i < NIN; ++i) a.in[i] = (const float*)d_in[i];
    a.out = (float*)d_out; a.ws = (unsigned char*)d_ws;
    void* kargs[] = {&a};
    hipError_t e = hipLaunchCooperativeKernel((const void*)fwd_megakernel, dim3(grid), dim3(NWAVES * 64), kargs, LDS_BYTES, stream);
    if (e != hipSuccess) fprintf(stderr, "kernel_launch: cooperative launch failed: %s (grid %d)\n", hipGetErrorString(e), grid);
}
```

```cpp
#include <hip/hip_runtime.h>
#include <hip/hip_cooperative_groups.h>
#include <cstdio>
#include <cstdint>
namespace cg = cooperative_groups;

namespace pg8 {
#define PG8_LAS __attribute__((address_space(3)))
typedef unsigned short bf16_t;
typedef short bf16x8 __attribute__((ext_vector_type(8)));
typedef float f32x4 __attribute__((ext_vector_type(4)));
typedef unsigned u32x4 __attribute__((ext_vector_type(4)));
constexpr int BM = 256, BK = 64, HALF = 128, HTB = HALF * BK * 2  , STAGE_BYTES = 8 * HTB, NXCD = 8, WGM = 8;

__host__ __device__ __forceinline__ int lds_byte(int r, int c) { const int st = (r >> 4) * 2 + (c >> 5), rr = r & 15, cc = c & 31, ob = rr * 64 + cc * 2; return st * 1024 + (ob ^ (((ob >> 9) & 1) << 5)); }
__host__ __device__ __forceinline__ void stage_rc(int b, int& R, int& C) { const int st = b / 1024, sb = b % 1024, swz = sb ^ (((sb >> 9) & 1) << 5); R = (st >> 1) * 16 + swz / 64; C = (st & 1) * 32 + (swz % 64) / 2; }
__host__ __device__ __forceinline__ int perm32(int rho) { const int n = rho >> 4, i = rho & 15; return 8 * (i >> 2) + 4 * n + (i & 3); }

struct Unit { int pm, pn, sub; };
struct Gemm { const bf16_t* A; const bf16_t* Bt; int M, N, K; };

struct StaticOrder {
    int nM, nN, nwg, G, c;
    __host__ __device__ void init(int M, int N, int G_, int c_) { nM = M / BM; nN = N / BM; nwg = nM * nN; G = G_; c = c_; }
    __host__ __device__ bool next(int i, Unit& u) const {
        const long L = (long)i * G + c; if (L >= nwg) return false;
        int wgid = (int)L; { const int q = nwg / NXCD, r = nwg % NXCD, xcd = wgid % NXCD, off = wgid / NXCD; wgid = (xcd < r ? xcd * (q + 1) : r * (q + 1) + (xcd - r) * q) + off; }
        const int nig = WGM * nN, gid = wgid / nig, fm = gid * WGM, gsz = (nM - fm) < WGM ? (nM - fm) : WGM;
        u.pm = fm + ((wgid % nig) % gsz); u.pn = (wgid % nig) / gsz; u.sub = 15; return true;
    }
    __device__ __forceinline__ void a_ready(const Unit&) const {}
    __device__ __forceinline__ void done(const Unit&) const {}
};

__device__ __forceinline__ unsigned cvt_pk_bf16(float lo, float hi) { unsigned r; asm("v_cvt_pk_bf16_f32 %0, %1, %2" : "=v"(r) : "v"(lo), "v"(hi)); return r; }
typedef float f32x2 __attribute__((ext_vector_type(2)));
struct MixedOrder {
    StaticOrder so; int nP, nQ, nNq, nMf, G, c;
    __device__ __forceinline__ void init(int Mfull, int Mquad, int N, int G_, int c_) { so.init(Mfull, N, G_, c_); nMf = Mfull / BM; nNq = N / BM; nP = nMf * nNq; nQ = (Mquad / BM) * nNq * 4; G = G_; c = c_; }
    __device__ __forceinline__ bool next(int i, Unit& u) const {
        const long L = (long)i * G + c; if (L < nP) return so.next(i, u);
        const int q = (int)(L - nP); if (q >= nQ) return false;
        const int t = q >> 2; u.sub = 1 << (q & 3); u.pn = t % nNq; u.pm = nMf + t / nNq; return true;
    }
    __device__ __forceinline__ void a_ready(const Unit&) const {}
    __device__ __forceinline__ void done(const Unit&) const {}
};
typedef float f32x2 __attribute__((ext_vector_type(2)));
typedef __bf16 bf2_t __attribute__((ext_vector_type(2)));
typedef __bf16 bf8_t __attribute__((ext_vector_type(8)));
constexpr float RMS_EPS = 1e-6f;
__device__ __forceinline__ float ssq8(bf16x8 v, float s) {
    const bf8_t b = __builtin_bit_cast(bf8_t, v);
#pragma unroll
    for (int i = 0; i < 4; ++i) { const bf2_t p = {b[2 * i], b[2 * i + 1]}; s = __builtin_amdgcn_fdot2_f32_bf16(p, p, s, false); }
    return s;
}
__device__ __forceinline__ float ssq2(bf16x8 v, int i, float s) {
    const bf8_t b = __builtin_bit_cast(bf8_t, v); const bf2_t p = {b[2 * i], b[2 * i + 1]}; return __builtin_amdgcn_fdot2_f32_bf16(p, p, s, false);
}
__device__ __forceinline__ float sigmoid_f(float v) { return __builtin_amdgcn_rcpf(1.0f + __builtin_amdgcn_exp2f(v * -1.4426950408889634f)); }
__device__ __forceinline__ float silu_f(float v) { return v * sigmoid_f(v); }

struct EpiSwiGLU {
    static constexpr bool PERM = true, AFTER_DRAIN = false, NEED_RS = true;
    bf16_t* O; int ldc;
    __device__ __forceinline__ void operator()(const f32x4 (&acc)[2][2][4][2], const float (&rsv)[2][4], const Unit& u, int wr, int wc, int fr, int fq) const {
        const int row0 = u.pm * BM + wr * 64 + fr, col0 = u.pn * HALF + wc * 32 + 8 * fq;
#pragma unroll
        for (int ai = 0; ai < 2; ++ai)
#pragma unroll
            for (int m = 0; m < 4; ++m) { const int row = row0 + ai * HALF + m * 16; const float rs = rsv[ai][m], c1 = rs * -1.4426950408889634f, rs2 = rs * rs;
                unsigned wv[4];
#pragma unroll
                for (int n = 0; n < 2; ++n)
#pragma unroll
                    for (int j = 0; j < 4; j += 2) { const f32x2 g = {acc[ai][0][m][n][j], acc[ai][0][m][n][j + 1]}, up = {acc[ai][1][m][n][j], acc[ai][1][m][n][j + 1]};
                        const f32x2 t = g * c1; f32x2 e; e.x = __builtin_amdgcn_exp2f(t.x); e.y = __builtin_amdgcn_exp2f(t.y);
                        const f32x2 d = e + 1.0f; f32x2 r; r.x = __builtin_amdgcn_rcpf(d.x); r.y = __builtin_amdgcn_rcpf(d.y);
                        const f32x2 o = ((g * up) * rs2) * r;
                        wv[2 * n + (j >> 1)] = cvt_pk_bf16(o.x, o.y); }
                u32x4 w; w.x = wv[0]; w.y = wv[1]; w.z = wv[2]; w.w = wv[3];
                *(u32x4*)(O + (size_t)row * ldc + col0) = w; }
    }
};
template <bool RS> struct EpiScaleBf16 {
    static constexpr bool PERM = true, AFTER_DRAIN = false, NEED_RS = RS;
    bf16_t* O; int ldc;
    __device__ __forceinline__ void operator()(const f32x4 (&acc)[2][2][4][2], const float (&rsv)[2][4], const Unit& u, int wr, int wc, int fr, int fq) const {
        const int row0 = u.pm * BM + wr * 64 + fr, col0 = u.pn * BM + wc * 32 + 8 * fq;
#pragma unroll
        for (int ai = 0; ai < 2; ++ai)
#pragma unroll
            for (int m = 0; m < 4; ++m) { const int row = row0 + ai * HALF + m * 16; const float rs = RS ? rsv[ai][m] : 1.0f;
#pragma unroll
                for (int bj = 0; bj < 2; ++bj) if ((u.sub >> (2 * ai + bj)) & 1) { const f32x4 v0 = acc[ai][bj][m][0] * rs, v1 = acc[ai][bj][m][1] * rs;
                    u32x4 w; w.x = cvt_pk_bf16(v0[0], v0[1]); w.y = cvt_pk_bf16(v0[2], v0[3]); w.z = cvt_pk_bf16(v1[0], v1[1]); w.w = cvt_pk_bf16(v1[2], v1[3]);
                    *(u32x4*)(O + (size_t)row * ldc + col0 + bj * HALF) = w; } }
    }
};
template <int MODE> struct EpiResid {
    static constexpr bool PERM = true, AFTER_DRAIN = false, NEED_RS = (MODE == 1);
    bf16_t* XB; const bf16_t* XR; float scale; const bf16_t* proj;
    __device__ __forceinline__ void operator()(const f32x4 (&acc)[2][2][4][2], const float (&rsv)[2][4], const Unit& u, int wr, int wc, int fr, int fq) const {
        const int row0 = u.pm * BM + wr * 64 + fr, col0 = u.pn * BM + wc * 32 + 8 * fq;
#pragma unroll
        for (int ai = 0; ai < 2; ++ai)
#pragma unroll
            for (int m = 0; m < 4; ++m) { const int row = row0 + ai * HALF + m * 16; const float rs = (MODE == 1) ? rsv[ai][m] : 1.0f;
#pragma unroll
                for (int bj = 0; bj < 2; ++bj) if ((u.sub >> (2 * ai + bj)) & 1) { const size_t off = (size_t)row * 1024 + col0 + bj * HALF;
                    const u32x4 rw = *(const u32x4*)(XR + off);
                    f32x4 x0 = {__uint_as_float(rw.x << 16), __uint_as_float(rw.x & 0xffff0000u), __uint_as_float(rw.y << 16), __uint_as_float(rw.y & 0xffff0000u)};
                    f32x4 x1 = {__uint_as_float(rw.z << 16), __uint_as_float(rw.z & 0xffff0000u), __uint_as_float(rw.w << 16), __uint_as_float(rw.w & 0xffff0000u)};
                    if (MODE == 0) { x0 += acc[ai][bj][m][0] * scale; x1 += acc[ai][bj][m][1] * scale; }
                    else { const u32x4 pw = *(const u32x4*)(proj + off);
                        const f32x4 a0 = acc[ai][bj][m][0] * rs, a1 = acc[ai][bj][m][1] * rs;
                        x0[0] += sigmoid_f(a0[0]) * __uint_as_float(pw.x << 16); x0[1] += sigmoid_f(a0[1]) * __uint_as_float(pw.x & 0xffff0000u);
                        x0[2] += sigmoid_f(a0[2]) * __uint_as_float(pw.y << 16); x0[3] += sigmoid_f(a0[3]) * __uint_as_float(pw.y & 0xffff0000u);
                        x1[0] += sigmoid_f(a1[0]) * __uint_as_float(pw.z << 16); x1[1] += sigmoid_f(a1[1]) * __uint_as_float(pw.z & 0xffff0000u);
                        x1[2] += sigmoid_f(a1[2]) * __uint_as_float(pw.w << 16); x1[3] += sigmoid_f(a1[3]) * __uint_as_float(pw.w & 0xffff0000u); }
                    u32x4 w; w.x = cvt_pk_bf16(x0[0], x0[1]); w.y = cvt_pk_bf16(x0[2], x0[3]); w.z = cvt_pk_bf16(x1[0], x1[1]); w.w = cvt_pk_bf16(x1[2], x1[3]);
                    *(u32x4*)(XB + off) = w; }
                if ((m & 1) == 1) asm volatile("" ::: "memory"); }
    }
};

struct EpiNull { static constexpr bool PERM = true, AFTER_DRAIN = false, NEED_RS = false;
    __device__ __forceinline__ void operator()(const f32x4 (&acc)[2][2][4][2], const float (&rsv)[2][4], const Unit& u, int wr, int wc, int fr, int fq) const {
        float s = 0.f;
#pragma unroll
        for (int a = 0; a < 2; ++a) for (int b = 0; b < 2; ++b) for (int m = 0; m < 4; ++m) for (int n = 0; n < 2; ++n) s += acc[a][b][m][n][0] + acc[a][b][m][n][1] + acc[a][b][m][n][2] + acc[a][b][m][n][3];
        asm volatile("" :: "v"(s)); } };
template <class Epi, class Sched, bool ALIGN_EPI = false, bool SP2 = false>
__device__ __forceinline__ void gemm_phase(PG8_LAS unsigned char* lds, const Gemm g, const Sched& S, const Epi& E) {
    int tid_ = threadIdx.x; asm volatile("" : "+v"(tid_));
    const int tid = tid_, wid = __builtin_amdgcn_readfirstlane(tid >> 6), lane = tid & 63, wr = wid >> 2, wc = wid & 3, fr = lane & 15, fq = lane >> 4;
    int K_ = g.K; asm volatile("" : "+s"(K_));
    const int K = K_, nt = K / BK;
    unsigned voffA[2], voffB[2];
#pragma unroll
    for (int i = 0; i < 2; ++i) { int R, C; stage_rc(tid * 16 + i * 8192, R, C); const int Rb = Epi::PERM ? ((R & ~31) + perm32(R & 31)) : R;
        voffA[i] = (unsigned)(R * K + C) * 2u; voffB[i] = (unsigned)(Rb * K + C) * 2u; }
    const size_t kstep = (size_t)(BK * 2);
    const size_t hstep = (size_t)HALF * K * 2;
    const size_t tstep = 2 * hstep;
    const unsigned ldsw = (unsigned)wid * 1024u;
    const int aoff = lds_byte(wr * 64 + fr, fq * 8), boff = lds_byte(wc * 32 + fr, fq * 8);
#define PG8_SA(b, h) (((b) * 2 + (h)) * HTB)
#define PG8_SB(b, h) ((4 + (b) * 2 + (h)) * HTB)
#define PG8_STAGE(bufoff, gbase, voff) do { _Pragma("unroll") for (int _i = 0; _i < 2; ++_i) \
        __builtin_amdgcn_global_load_lds((const unsigned*)((const char*)(gbase) + (voff)[_i]), (PG8_LAS unsigned*)(lds + (bufoff) + ldsw + _i * 8192), 16, 0, 0); } while (0)
#define PG8_LDA(dst, b, h) do { _Pragma("unroll") for (int m = 0; m < 4; ++m) _Pragma("unroll") for (int k = 0; k < 2; ++k) dst[m][k] = *(const PG8_LAS bf16x8*)(lds + PG8_SA(b, h) + aoff + m * 2048 + k * 1024); } while (0)
#define PG8_LDB(dst, b, h) do { _Pragma("unroll") for (int n = 0; n < 2; ++n) _Pragma("unroll") for (int k = 0; k < 2; ++k) dst[n][k] = *(const PG8_LAS bf16x8*)(lds + PG8_SB(b, h) + boff + n * 2048 + k * 1024); } while (0)
#define PG8_MMA(ai, bj, At, Bt) do { __builtin_amdgcn_s_setprio(1); _Pragma("unroll") for (int m = 0; m < 4; ++m) _Pragma("unroll") for (int n = 0; n < 2; ++n) _Pragma("unroll") for (int k = 0; k < 2; ++k) \
        acc[ai][bj][m][n] = __builtin_amdgcn_mfma_f32_16x16x32_bf16(Bt[n][k], At[m][k], acc[ai][bj][m][n], 0, 0, 0); __builtin_amdgcn_s_setprio(0); } while (0)
#define PG8_SSQ(ai, kt) do { if constexpr (Epi::NEED_RS) { if (wc == ((kt) & 3)) { _Pragma("unroll") for (int k = 0; k < 2; ++k) _Pragma("unroll") for (int i_ = 0; i_ < 4; ++i_) _Pragma("unroll") for (int m = 0; m < 4; ++m) ssq[ai][m] = ssq2(At[m][k], i_, ssq[ai][m]); } } } while (0)
#define PG8_WAIT_V(n) asm volatile("s_waitcnt vmcnt(" #n ")" ::: "memory")
#define PG8_WAIT_L(n) asm volatile("s_waitcnt lgkmcnt(" #n ")" ::: "memory")
#define PG8_BAR __builtin_amdgcn_s_barrier()
#define PG8_SCHED __builtin_amdgcn_sched_barrier(0)
    Unit cur, nxt; int ui = 0;
    if (!S.next(0, cur)) return;
    f32x4 acc[2][2][4][2];
#pragma unroll
    for (int a = 0; a < 2; ++a)
#pragma unroll
        for (int b = 0; b < 2; ++b)
#pragma unroll
            for (int m = 0; m < 4; ++m)
#pragma unroll
                for (int n = 0; n < 2; ++n) acc[a][b][m][n] = (f32x4){0.f, 0.f, 0.f, 0.f};
    bf16x8 At[4][2], B0[2][2], B1[2][2];
    float ssq[2][4] = {{0.f, 0.f, 0.f, 0.f}, {0.f, 0.f, 0.f, 0.f}};
    static_assert(SP2 || !Epi::NEED_RS, "row statistics are gathered in the SP2 loop only");
    const char* cA = (const char*)g.A + (size_t)cur.pm * tstep; const char* cB = (const char*)g.Bt + (size_t)cur.pn * tstep;
    S.a_ready(cur);
    if constexpr (SP2) {
        PG8_STAGE(PG8_SB(0, 0), cB, voffB); PG8_STAGE(PG8_SB(0, 1), cB + hstep, voffB); PG8_STAGE(PG8_SA(0, 0), cA, voffA); PG8_STAGE(PG8_SA(0, 1), cA + hstep, voffA);
        if (wr == 1) PG8_BAR;
        PG8_WAIT_V(2); PG8_BAR;
        PG8_STAGE(PG8_SB(1, 0), cB + kstep, voffB); PG8_STAGE(PG8_SA(1, 0), cA + kstep, voffA); PG8_STAGE(PG8_SB(1, 1), cB + hstep + kstep, voffB);
        PG8_WAIT_V(6); PG8_BAR;
    } else {
        PG8_STAGE(PG8_SB(0, 0), cB, voffB); PG8_STAGE(PG8_SA(0, 0), cA, voffA); PG8_STAGE(PG8_SB(0, 1), cB + hstep, voffB); PG8_STAGE(PG8_SA(0, 1), cA + hstep, voffA);
        if (wr == 1) PG8_BAR;
        PG8_WAIT_V(4); PG8_BAR;
        PG8_STAGE(PG8_SB(1, 0), cB + kstep, voffB); PG8_STAGE(PG8_SA(1, 0), cA + kstep, voffA); PG8_STAGE(PG8_SB(1, 1), cB + hstep + kstep, voffB);
        PG8_WAIT_V(6); PG8_BAR;
    }
    for (;;) {
        const int mk = __builtin_amdgcn_readfirstlane(cur.sub);
        const bool has_next = S.next(ui + 1, nxt);
        const char* nA = has_next ? (const char*)g.A + (size_t)nxt.pm * tstep : cA; const char* nB = has_next ? (const char*)g.Bt + (size_t)nxt.pn * tstep : cB;
        for (int t = 0; t < nt; t += 2) {
            const bool last = (t == nt - 2);
            const char* a1 = cA + (size_t)(t + 1) * kstep;
            const char* a2 = last ? nA : cA + (size_t)(t + 2) * kstep; const char* b2 = last ? nB : cB + (size_t)(t + 2) * kstep;
            const char* a3 = a2 + kstep; const char* b3 = b2 + kstep;
            if (last && has_next) S.a_ready(nxt);
            if constexpr (SP2) {
            PG8_LDB(B0, 0, 0); PG8_LDB(B1, 0, 1); PG8_SCHED; PG8_LDA(At, 0, 0); PG8_STAGE(PG8_SA(1, 1), a1 + hstep, voffA);
            PG8_WAIT_V(8); PG8_WAIT_L(0); PG8_BAR; if (mk & 1) PG8_MMA(0, 0, At, B0); PG8_SSQ(0, t); if (mk & 2) PG8_MMA(0, 1, At, B1); PG8_BAR; PG8_SCHED;
            PG8_LDA(At, 0, 1); PG8_STAGE(PG8_SB(0, 0), b2, voffB); PG8_STAGE(PG8_SB(0, 1), b2 + hstep, voffB); PG8_STAGE(PG8_SA(0, 0), a2, voffA);
            PG8_WAIT_V(8); PG8_WAIT_L(0); PG8_BAR; if (mk & 4) PG8_MMA(1, 0, At, B0); PG8_SSQ(1, t); if (mk & 8) PG8_MMA(1, 1, At, B1); PG8_BAR; PG8_SCHED;
            PG8_LDB(B0, 1, 0); PG8_LDB(B1, 1, 1); PG8_SCHED; PG8_LDA(At, 1, 0); PG8_STAGE(PG8_SA(0, 1), a2 + hstep, voffA);
            PG8_WAIT_V(8); PG8_WAIT_L(0); PG8_BAR; if (mk & 1) PG8_MMA(0, 0, At, B0); PG8_SSQ(0, t + 1); if (mk & 2) PG8_MMA(0, 1, At, B1); PG8_BAR; PG8_SCHED;
            PG8_LDA(At, 1, 1); PG8_STAGE(PG8_SB(1, 0), b3, voffB); PG8_STAGE(PG8_SB(1, 1), b3 + hstep, voffB); PG8_STAGE(PG8_SA(1, 0), a3, voffA);
            PG8_WAIT_V(8); PG8_WAIT_L(0); PG8_BAR; if (mk & 4) PG8_MMA(1, 0, At, B0); PG8_SSQ(1, t + 1); if (mk & 8) PG8_MMA(1, 1, At, B1); PG8_BAR; PG8_SCHED;
            } else {
            PG8_LDB(B0, 0, 0); PG8_SCHED; PG8_LDA(At, 0, 0); PG8_STAGE(PG8_SA(1, 1), a1 + hstep, voffA);
            PG8_WAIT_L(8); PG8_BAR; PG8_WAIT_L(0); PG8_MMA(0, 0, At, B0); PG8_BAR; PG8_SCHED;
            PG8_LDB(B1, 0, 1); PG8_STAGE(PG8_SB(0, 0), b2, voffB);
            PG8_BAR; PG8_WAIT_L(0); PG8_MMA(0, 1, At, B1); PG8_BAR;
            PG8_LDA(At, 0, 1); PG8_STAGE(PG8_SA(0, 0), a2, voffA);
            PG8_BAR; PG8_WAIT_L(0); PG8_MMA(1, 0, At, B0); PG8_BAR; PG8_SCHED;
            PG8_STAGE(PG8_SB(0, 1), b2 + hstep, voffB);
            PG8_WAIT_V(6); PG8_BAR; PG8_MMA(1, 1, At, B1); PG8_BAR;
            PG8_LDB(B0, 1, 0); PG8_SCHED; PG8_LDA(At, 1, 0); PG8_STAGE(PG8_SA(0, 1), a2 + hstep, voffA);
            PG8_WAIT_L(8); PG8_BAR; PG8_WAIT_L(0); PG8_MMA(0, 0, At, B0); PG8_BAR; PG8_SCHED;
            PG8_LDB(B1, 1, 1); PG8_STAGE(PG8_SB(1, 0), b3, voffB);
            PG8_BAR; PG8_WAIT_L(0); PG8_MMA(0, 1, At, B1); PG8_BAR;
            PG8_LDA(At, 1, 1); PG8_STAGE(PG8_SA(1, 0), a3, voffA);
            PG8_BAR; PG8_WAIT_L(0); PG8_MMA(1, 0, At, B0); PG8_BAR; PG8_SCHED;
            PG8_STAGE(PG8_SB(1, 1), b3 + hstep, voffB);
            PG8_WAIT_V(6); PG8_BAR; PG8_MMA(1, 1, At, B1); PG8_BAR;
            }
        }
        if constexpr (ALIGN_EPI) { if (wr == 0) PG8_BAR; }
        { float rsv[2][4];
            if constexpr (Epi::NEED_RS) {
                static_assert(ALIGN_EPI, "the row-statistics exchange needs both halves at the same barrier");
                PG8_LAS float* rst = (PG8_LAS float*)(lds + STAGE_BYTES + 1024);
#pragma unroll
                for (int a = 0; a < 2; ++a)
#pragma unroll
                    for (int m = 0; m < 4; ++m) { float q = ssq[a][m]; q += __shfl_xor(q, 16); q += __shfl_xor(q, 32); if (fq == 0) rst[wc * 256 + a * HALF + wr * 64 + m * 16 + fr] = q; ssq[a][m] = 0.f; }
                PG8_WAIT_L(0); PG8_BAR; asm volatile("" ::: "memory");
#pragma unroll
                for (int a = 0; a < 2; ++a)
#pragma unroll
                    for (int m = 0; m < 4; ++m) { const int r_ = a * HALF + wr * 64 + m * 16 + fr; const float q = (rst[r_] + rst[256 + r_]) + (rst[512 + r_] + rst[768 + r_]);
                        rsv[a][m] = __builtin_amdgcn_rsqf(q * (1.0f / 1024.0f) + RMS_EPS); }
            } else {
#pragma unroll
                for (int a = 0; a < 2; ++a)
#pragma unroll
                    for (int m = 0; m < 4; ++m) rsv[a][m] = 1.0f;
            }
            E(acc, rsv, cur, wr, wc, fr, fq); S.done(cur); }
        if (!has_next) break;
#pragma unroll
        for (int a = 0; a < 2; ++a)
#pragma unroll
            for (int b = 0; b < 2; ++b)
#pragma unroll
                for (int m = 0; m < 4; ++m)
#pragma unroll
                    for (int n = 0; n < 2; ++n) acc[a][b][m][n] = (f32x4){0.f, 0.f, 0.f, 0.f};
        cur = nxt; cA = nA; cB = nB; ++ui;
        if constexpr (ALIGN_EPI) { if (wr == 1) PG8_BAR; }
    }
    PG8_WAIT_V(0);
    if constexpr (!ALIGN_EPI) { if (wr == 0) PG8_BAR; }
    PG8_BAR;
#undef PG8_SA
#undef PG8_SB
#undef PG8_STAGE
#undef PG8_LDA
#undef PG8_LDB
#undef PG8_MMA
#undef PG8_SSQ
#undef PG8_WAIT_V
#undef PG8_WAIT_L
#undef PG8_BAR
#undef PG8_SCHED
}
}
constexpr int NWAVES = 8;
constexpr int D = 1024, FF = 2816, NGU = 2 * FF, MIXW = 2048, DPLE = 256, DEPTH = 2;
constexpr int BATCH = 8, SEQ = 2048, DECB = 128, DECS = 8;
constexpr int MP = BATCH * SEQ, MS = DECB * DECS, M = MP + MS;
constexpr int NIN = 33;
constexpr size_t MiB = 1u << 20;
constexpr size_t WS_CTL = 0, CTL_ZERO_BYTES = 64 * 1024;
constexpr size_t WS_W = 1 * MiB;
constexpr size_t W_GU = (size_t)NGU * D * 2, W_DN = (size_t)D * FF * 2, W_MI = (size_t)MIXW * D * 2, W_MO = (size_t)D * D * 2, W_PG = (size_t)D * D * 2, W_PP = (size_t)D * DPLE * 2;
constexpr size_t WO_GU1 = 0, WO_D1 = WO_GU1 + W_GU, WO_MI = WO_D1 + W_DN, WO_MO = WO_MI + W_MI, WO_GU2 = WO_MO + W_MO, WO_D2 = WO_GU2 + W_GU, WO_PG = WO_D2 + W_DN, WO_PP = WO_PG + W_PG, W_LAYER = WO_PP + W_PP;
constexpr size_t WS_BUFA = WS_W + DEPTH * W_LAYER;
constexpr size_t BUF_BYTES = (size_t)M * D * 2;
constexpr size_t WS_BUFB = WS_BUFA + BUF_BYTES;
constexpr size_t WS_PB = WS_BUFB + BUF_BYTES;
constexpr size_t WS_ACT = WS_PB + (size_t)DEPTH * M * DPLE * 2;
constexpr size_t WS_END = WS_ACT + (size_t)M * FF * 2;
static_assert(WS_W % 256 == 0 && W_LAYER % 256 == 0 && WS_BUFA % 256 == 0 && WS_PB % 256 == 0 && WS_ACT % 256 == 0, "alignment");
constexpr int CW_BAR = 1024;
constexpr int RING_OFF = 0, RING_BYTES = 131072;
constexpr int LDSCTL_OFF = RING_BYTES, MISC_OFF = LDSCTL_OFF + 320;
constexpr int LDS_BYTES = 147456;
#define GAS __attribute__((address_space(1)))
#define LAS __attribute__((address_space(3)))
typedef unsigned short bf16;
typedef unsigned v4u __attribute__((ext_vector_type(4)));
typedef float f32x4 __attribute__((ext_vector_type(4)));
typedef short bf16x8 __attribute__((ext_vector_type(8)));
typedef GAS unsigned gu32;
typedef GAS unsigned long long gu64;
#define RLX_AGENT __ATOMIC_RELAXED, __HIP_MEMORY_SCOPE_AGENT
#define LDS_WAIT() asm volatile("s_waitcnt lgkmcnt(0)" ::: "memory")
#define VM_WAIT() asm volatile("s_waitcnt vmcnt(0)" ::: "memory")
__device__ __forceinline__ unsigned long long rt() { return __builtin_amdgcn_s_memrealtime(); }
__device__ __forceinline__ unsigned pk2(float lo, float hi) { unsigned r; asm("v_cvt_pk_bf16_f32 %0, %1, %2" : "=v"(r) : "v"(lo), "v"(hi)); return r; }
__device__ __forceinline__ unsigned f2bf(float f) { return pk2(f, f) & 0xffffu; }
#define XB_TMO      128
#define XB_XCNT(j)  (256  + 64 * (j))
#define XB_XSUB(j)  (1280 + 64 * (j))
#define XB_XGEN(j)  (2304 + 64 * (j))
#define XB_TOP      3328
#define XB_TOPGEN   3392
#define XCD_BAR_WORDS 3456
#define XB_SPIN_CAP (1u << 18)

__device__ __forceinline__ unsigned xb_ld(unsigned* p)              { return __hip_atomic_load(p, __ATOMIC_RELAXED, __HIP_MEMORY_SCOPE_AGENT); }
__device__ __forceinline__ unsigned xb_add(unsigned* p, unsigned v) { return __hip_atomic_fetch_add(p, v, __ATOMIC_RELAXED, __HIP_MEMORY_SCOPE_AGENT); }
__device__ __forceinline__ unsigned xb_xcc_id() { return (unsigned)__builtin_amdgcn_s_getreg((3 << 11) | 20) & 0xFu; }
#define XB_SPIN(cond, bar) do { unsigned _sp = 0; while (cond) { __builtin_amdgcn_s_sleep(1); \
    if ((++_sp & 255u) == 0u) { if (xb_ld(&(bar)[XB_TMO])) break; if (_sp > XB_SPIN_CAP) { atomicAdd(&(bar)[XB_TMO], 1u); break; } } } } while (0)

struct XcdBarrier {
    unsigned* bar; unsigned x;
    volatile LAS unsigned* st;
};

__device__ __forceinline__ XcdBarrier xcd_barrier_post(unsigned* bar, volatile LAS unsigned* st) {
    XcdBarrier b; b.bar = bar; b.x = xb_xcc_id(); b.st = st;
    if (threadIdx.x == 0) st[4] = xb_add(&bar[XB_XCNT(b.x)], 1u);
    return b;
}
__device__ __forceinline__ void xcd_barrier_complete(unsigned* bar, unsigned x, unsigned& nloc, unsigned& nx) {
    const unsigned G = gridDim.x * gridDim.y * gridDim.z;
    unsigned sum, cnt, mine, sp = 0u;
    for (;;) {
        sum = 0u; cnt = 0u; mine = 0u;
#pragma nounroll
        for (unsigned j = 0; j < 16; ++j) { const unsigned c = xb_ld(&bar[XB_XCNT(j)]); sum += c; cnt += (c > 0u) ? 1u : 0u; mine = (j == x) ? c : mine; }
        if (sum == G) break;
        __builtin_amdgcn_s_sleep(1);
        if ((++sp & 255u) == 0u) { if (xb_ld(&bar[XB_TMO])) break; if (sp > XB_SPIN_CAP) { atomicAdd(&bar[XB_TMO], 1u); break; } }
    }
    nloc = mine > 0u ? mine : 1u; nx = cnt > 0u ? cnt : 1u;
}

__device__ __forceinline__ void xcd_barrier(const XcdBarrier& b) {
    asm volatile("s_waitcnt vmcnt(0)" ::: "memory");
    __syncthreads();
    if (threadIdx.x == 0) {
        unsigned* bar = b.bar; const unsigned bx_ = xb_xcc_id();
        __builtin_amdgcn_s_waitcnt(0);
        unsigned nloc = b.st[0], nx = b.st[1];
        if (nloc == 0u) { xcd_barrier_complete(bar, bx_, nloc, nx); b.st[0] = nloc; b.st[1] = nx; }
        asm volatile("buffer_inv sc1" ::: "memory");
        const unsigned old = xb_add(&bar[XB_XSUB(bx_)], 1u);
        const unsigned gen = old / nloc;
        if (old + 1u == (gen + 1u) * nloc) {
            __builtin_amdgcn_fence(__ATOMIC_RELEASE, "agent");
            asm volatile("s_waitcnt vmcnt(0)" ::: "memory");
            const unsigned og = xb_add(&bar[XB_TOP], 1u);
            const unsigned tg = og / nx;
            if (og + 1u == (tg + 1u) * nx) xb_add(&bar[XB_TOPGEN], 1u);
            else XB_SPIN(xb_ld(&bar[XB_TOPGEN]) == tg, bar);
            asm volatile("" ::: "memory");
            xb_add(&bar[XB_XGEN(bx_)], 1u);
            asm volatile("s_waitcnt vmcnt(0)" ::: "memory");
        } else {
            XB_SPIN(xb_ld(&bar[XB_XGEN(bx_)]) == gen, bar);
            asm volatile("" ::: "memory");
            asm volatile("s_waitcnt vmcnt(0)" ::: "memory");
        }
    }
    __syncthreads();
}

__device__ __forceinline__ int opaque_s(int v) { asm volatile("" : "+s"(v)); return v; }
struct Args { const float* in[NIN]; float* out; unsigned char* ws; };
struct Frame {
    LAS unsigned char* lds;
    int tid, lane, wave, vcu, G;
};
template <int CTRL> __device__ __forceinline__ float dpp_add(float v) {
    const int vi = __builtin_bit_cast(int, v);
    return v + __builtin_bit_cast(float, __builtin_amdgcn_update_dpp(vi, vi, CTRL, 0xF, 0xF, false));
}
__device__ __forceinline__ float wave_sum(float v) {
    v = dpp_add<0xB1>(v); v = dpp_add<0x4E>(v); v = dpp_add<0x141>(v); v = dpp_add<0x140>(v);
    v = dpp_add<0x142>(v);
    v = dpp_add<0x143>(v);
    return __builtin_bit_cast(float, __builtin_amdgcn_readlane(__builtin_bit_cast(int, v), 63));
}
#define WS4_STEP(ctl) "v_add_f32_dpp %0, %0, %0 " ctl " row_mask:0xf bank_mask:0xf\n\tv_add_f32_dpp %1, %1, %1 " ctl " row_mask:0xf bank_mask:0xf\n\tv_add_f32_dpp %2, %2, %2 " ctl " row_mask:0xf bank_mask:0xf\n\tv_add_f32_dpp %3, %3, %3 " ctl " row_mask:0xf bank_mask:0xf\n\t"
__device__ __forceinline__ void wave_sum4(float& a, float& b, float& c, float& d) {
    asm volatile("s_nop 1\n\t" WS4_STEP("quad_perm:[1,0,3,2]") WS4_STEP("quad_perm:[2,3,0,1]") WS4_STEP("row_half_mirror") WS4_STEP("row_mirror") WS4_STEP("row_bcast:15") WS4_STEP("row_bcast:31") "s_nop 1"
                 : "+v"(a), "+v"(b), "+v"(c), "+v"(d));
    a = __builtin_bit_cast(float, __builtin_amdgcn_readlane(__builtin_bit_cast(int, a), 63)); b = __builtin_bit_cast(float, __builtin_amdgcn_readlane(__builtin_bit_cast(int, b), 63));
    c = __builtin_bit_cast(float, __builtin_amdgcn_readlane(__builtin_bit_cast(int, c), 63)); d = __builtin_bit_cast(float, __builtin_amdgcn_readlane(__builtin_bit_cast(int, d), 63));
}
__device__ __forceinline__ void ln8_stats(const float (&v)[8], float (&mean)[8], float (&rstd)[8], float eps) {
    float s[8];
#pragma unroll
    for (int r = 0; r < 8; ++r) s[r] = v[r];
    wave_sum4(s[0], s[1], s[2], s[3]); wave_sum4(s[4], s[5], s[6], s[7]);
#pragma unroll
    for (int r = 0; r < 8; ++r) { mean[r] = s[r] * (1.f / 64.f); const float dv = v[r] - mean[r]; s[r] = dv * dv; }
    wave_sum4(s[0], s[1], s[2], s[3]); wave_sum4(s[4], s[5], s[6], s[7]);
#pragma unroll
    for (int r = 0; r < 8; ++r) rstd[r] = __builtin_amdgcn_rsqf(s[r] * (1.f / 64.f) + eps);
}
__device__ __forceinline__ float bf2f(bf16 v) { return __uint_as_float((unsigned)v << 16); }
__device__ __forceinline__ float gelu_tanh(float v) {
    const float t = 1.5957691216057308f * (v + 0.044715f * v * v * v);
    return v * __builtin_amdgcn_rcpf(1.0f + __builtin_amdgcn_exp2f(t * -1.4426950408889634f));
}
__device__ __forceinline__ void p0_transpose_item(const float* W, int K, int N, bf16* WT, const float* gain, int mode, LAS float* scr, int item, int lane) {
    const int nblk = N / 64, kb = item / nblk, nb = item % nblk, k0 = 32 * kb, n0 = 64 * nb;
    const int c4 = (lane & 15) * 4, kq = lane >> 4;
    f32x4 v[8];
#pragma unroll
    for (int i = 0; i < 8; ++i) v[i] = __builtin_nontemporal_load((const f32x4*)(W + (size_t)(k0 + 4 * i + kq) * N + n0 + c4));
#pragma unroll
    for (int i = 0; i < 8; ++i) { const int kk = 4 * i + kq; const float g = gain ? gain[k0 + kk] : 1.0f; LAS float* s = scr + kk * 65 + c4;
        s[0] = v[i].x * g; s[1] = v[i].y * g; s[2] = v[i].z * g; s[3] = v[i].w * g; }
    LDS_WAIT(); asm volatile("" ::: "memory");
    const int c = lane & 3;
    const int rbase = (mode == 0) ? n0 : (256 * (n0 >> 7) + (n0 & 127) + (mode == 2 ? 128 : 0));
#pragma unroll
    for (int j = 0; j < 4; ++j) { const int n = (lane >> 2) + 16 * j; const LAS float* s = scr + (8 * c) * 65 + n;
        v4u o; o.x = pk2(s[0 * 65], s[1 * 65]); o.y = pk2(s[2 * 65], s[3 * 65]); o.z = pk2(s[4 * 65], s[5 * 65]); o.w = pk2(s[6 * 65], s[7 * 65]);
        *(GAS v4u*)(WT + (size_t)(rbase + n) * K + k0 + 8 * c) = o; }
    LDS_WAIT(); asm volatile("" ::: "memory");
}
__device__ __forceinline__ void p0_prologue(Frame& F, const Args& args) {
    LAS float* scr = (LAS float*)(F.lds + RING_OFF + F.wave * 16384);
    const int gw = F.vcu * NWAVES + F.wave, NGW = F.G * NWAVES;
    unsigned char* ws = args.ws;
    constexpr int I_GU = (D / 32) * (FF / 64), I_DN = (FF / 32) * (D / 64), I_MI = (D / 32) * (MIXW / 64), I_SQ = (D / 32) * (D / 64), I_PP = (DPLE / 32) * (D / 64);
    constexpr int I_LAYER = 6 * I_GU + I_MI + 2 * I_SQ + I_PP;
    static_assert(I_DN == I_GU, "item counts");
    for (int it = gw; it < DEPTH * I_LAYER; it += NGW) {
        const int li = it / I_LAYER; int r = it % I_LAYER;
        unsigned char* wl = ws + WS_W + (size_t)li * W_LAYER;
        if (r < I_GU) { p0_transpose_item(args.in[opaque_s(8)] + (size_t)li * D * FF, D, FF, (bf16*)(wl + WO_GU1), args.in[opaque_s(7)] + li * D, 1, scr, r, F.lane); continue; } r -= I_GU;
        if (r < I_GU) { p0_transpose_item(args.in[opaque_s(9)] + (size_t)li * D * FF, D, FF, (bf16*)(wl + WO_GU1), args.in[opaque_s(7)] + li * D, 2, scr, r, F.lane); continue; } r -= I_GU;
        if (r < I_GU) { p0_transpose_item(args.in[opaque_s(10)] + (size_t)li * D * FF, FF, D, (bf16*)(wl + WO_D1), nullptr, 0, scr, r, F.lane); continue; } r -= I_GU;
        if (r < I_GU) { p0_transpose_item(args.in[opaque_s(26)] + (size_t)li * D * FF, D, FF, (bf16*)(wl + WO_GU2), args.in[opaque_s(25)] + li * D, 1, scr, r, F.lane); continue; } r -= I_GU;
        if (r < I_GU) { p0_transpose_item(args.in[opaque_s(27)] + (size_t)li * D * FF, D, FF, (bf16*)(wl + WO_GU2), args.in[opaque_s(25)] + li * D, 2, scr, r, F.lane); continue; } r -= I_GU;
        if (r < I_GU) { p0_transpose_item(args.in[opaque_s(28)] + (size_t)li * D * FF, FF, D, (bf16*)(wl + WO_D2), nullptr, 0, scr, r, F.lane); continue; } r -= I_GU;
        if (r < I_MI) { p0_transpose_item(args.in[opaque_s(12)] + (size_t)li * D * MIXW, D, MIXW, (bf16*)(wl + WO_MI), args.in[opaque_s(11)] + li * D, 0, scr, r, F.lane); continue; } r -= I_MI;
        if (r < I_SQ) { p0_transpose_item(args.in[opaque_s(24)] + (size_t)li * D * D, D, D, (bf16*)(wl + WO_MO), nullptr, 0, scr, r, F.lane); continue; } r -= I_SQ;
        if (r < I_SQ) { p0_transpose_item(args.in[opaque_s(30)] + (size_t)li * D * D, D, D, (bf16*)(wl + WO_PG), args.in[opaque_s(29)] + li * D, 0, scr, r, F.lane); continue; } r -= I_SQ;
        p0_transpose_item(args.in[opaque_s(31)] + (size_t)li * DPLE * D, DPLE, D, (bf16*)(wl + WO_PP), nullptr, 0, scr, r, F.lane);
    }
    float* X = args.out; bf16* XB = (bf16*)(ws + WS_BUFA);
    for (int m = gw; m < M; m += NGW) {
        const float* src = (m < MP) ? args.in[opaque_s(0)] + (size_t)m * D : args.in[opaque_s(1)] + (size_t)(m - MP) * D;
        const GAS f32x4* xr = (const GAS f32x4*)src + F.lane; GAS f32x4* xo = (GAS f32x4*)(X + (size_t)m * D) + F.lane;
        GAS unsigned long long* o8 = (GAS unsigned long long*)(XB + (size_t)m * D) + F.lane;
#pragma unroll
        for (int j = 0; j < 4; ++j) { const f32x4 v = xr[64 * j];
            o8[64 * j] = (unsigned long long)pk2(v.x, v.y) | ((unsigned long long)pk2(v.z, v.w) << 32); }
    }
    bf16* PB = (bf16*)(ws + WS_PB);
    for (int q = gw; q < DEPTH * M; q += NGW) {
        const int li = q / M, m = q % M;
        const float* src = (m < MP) ? args.in[opaque_s(2)] + ((size_t)li * MP + m) * DPLE : args.in[opaque_s(3)] + ((size_t)li * MS + (m - MP)) * DPLE;
        const f32x4 v = ((const GAS f32x4*)src)[F.lane];
        ((GAS unsigned long long*)(PB + (size_t)q * DPLE))[F.lane] = (unsigned long long)pk2(v.x, v.y) | ((unsigned long long)pk2(v.z, v.w) << 32);
    }
}
__device__ __forceinline__ void final_norm(Frame& F, const Args& args, const bf16* XBF) {
    const int gw = F.vcu * NWAVES + F.wave, NGW = F.G * NWAVES;
    float* Y = args.out; const float* g = args.in[opaque_s(32)];
    f32x4 gv[4];
#pragma unroll
    for (int j = 0; j < 4; ++j) gv[j] = ((const GAS f32x4*)g)[4 * F.lane + j];
    for (int m = gw; m < M; m += NGW) {
        const GAS v4u* xr = (const GAS v4u*)(XBF + (size_t)m * D) + 2 * F.lane;
        const v4u r0 = xr[0], r1 = xr[1];
        f32x4 v[4];
        v[0] = (f32x4){__uint_as_float(r0.x << 16), __uint_as_float(r0.x & 0xffff0000u), __uint_as_float(r0.y << 16), __uint_as_float(r0.y & 0xffff0000u)};
        v[1] = (f32x4){__uint_as_float(r0.z << 16), __uint_as_float(r0.z & 0xffff0000u), __uint_as_float(r0.w << 16), __uint_as_float(r0.w & 0xffff0000u)};
        v[2] = (f32x4){__uint_as_float(r1.x << 16), __uint_as_float(r1.x & 0xffff0000u), __uint_as_float(r1.y << 16), __uint_as_float(r1.y & 0xffff0000u)};
        v[3] = (f32x4){__uint_as_float(r1.z << 16), __uint_as_float(r1.z & 0xffff0000u), __uint_as_float(r1.w << 16), __uint_as_float(r1.w & 0xffff0000u)};
        float s_ = 0.f;
#pragma unroll
        for (int j = 0; j < 4; ++j) s_ += (v[j].x * v[j].x + v[j].y * v[j].y) + (v[j].z * v[j].z + v[j].w * v[j].w);
        const float rs = __builtin_amdgcn_rsqf(wave_sum(s_) * (1.0f / D) + pg8::RMS_EPS);
        GAS f32x4* yo = (GAS f32x4*)(Y + (size_t)m * D) + 4 * F.lane;
#pragma unroll
        for (int j = 0; j < 4; ++j) yo[j] = v[j] * rs * gv[j];
    }
}
constexpr size_t O_Y = 0, O_CA_P = (size_t)M * D, O_CA_S = O_CA_P + (size_t)DEPTH * BATCH * 30 * 256, O_PL_P = O_CA_S + (size_t)DEPTH * DECB * 30 * 256,
                 O_PL_S = O_PL_P + (size_t)DEPTH * BATCH * 15 * 256, O_SC_P = O_PL_S + (size_t)DEPTH * DECB * 15 * 256, O_SC_S = O_SC_P + (size_t)DEPTH * BATCH * 2 * 256,
                 O_CV_S = O_SC_S + (size_t)DEPTH * DECB * 2 * 256, O_END = O_CV_S + (size_t)DEPTH * DECB * DECS * 256;
constexpr float LN_EPS = 1e-6f;
constexpr int VNT_OFF = 0, VNT_PITCH = 272, WPT_OFF = 64 * VNT_PITCH, WPT_PITCH = 144, DT_OFF = WPT_OFF + 64 * WPT_PITCH, DT_PITCH = 144;
struct MixP { const bf16* Z; bf16* MIX; const float *caw, *cab, *nag, *nab, *pw, *ps, *sng, *snb, *sw, *sb, *scw; float* out; int li; const float *st_a, *st_p, *st_s; };
#define OPAQUE_S(p) asm volatile("" : "+s"(p))
template <class T> __device__ __forceinline__ T* uni_ptr(T* p) {
    const unsigned long long v = (unsigned long long)p; const unsigned lo = __builtin_amdgcn_readfirstlane((unsigned)v), hi = __builtin_amdgcn_readfirstlane((unsigned)(v >> 32));
    return (T*)(((unsigned long long)hi << 32) | lo); }
__device__ __forceinline__ bf16 f2bf16(float f) { return (bf16)f2bf(f); }
__device__ __forceinline__ float pool_sel(int h, float s2, float s4, float s8, float s16) { return h == 0 ? s2 : (h == 1 ? s4 : (h == 2 ? s8 : s16)); }

__device__ __forceinline__ void mix_prompt_unit(Frame& F, const MixP& P, int b, int c, int h) {
    const int w = F.wave, lane = F.lane, ch = h * 64 + lane, fr = lane & 15, fq = lane >> 4;
    const int tb = __builtin_amdgcn_readfirstlane(128 * c + 16 * w);
    const bf16* Zs = uni_ptr(P.Z + (size_t)b * SEQ * MIXW);
    bf16* Ms = uni_ptr(P.MIX + (size_t)b * SEQ * D);
    const int li = P.li;
    { const int n = F.tid & 63, kg = F.tid >> 6; const float* src = P.pw + (size_t)h * 4096 + (size_t)(8 * kg) * 64 + n;
      v4u o; o.x = pk2(src[0], src[64]); o.y = pk2(src[128], src[192]); o.z = pk2(src[256], src[320]); o.w = pk2(src[384], src[448]);
      *(LAS v4u*)(F.lds + WPT_OFF + n * WPT_PITCH + kg * 16) = o; }
    {
        float wA[31];
        { const float* wp = P.caw;
#pragma unroll
        for (int k = 0; k < 31; ++k) { wA[k] = wp[ch]; wp += 256; OPAQUE_S(wp); } }
        float ext[46];
        { const bf16* zp = uni_ptr(Zs + ((ptrdiff_t)(tb - 30) * MIXW));
#pragma unroll
        for (int j = 0; j < 46; ++j) { const bool ok = (tb - 30 + j) >= 0; const bf16* zq = ok ? zp : Zs; const float msk = ok ? 1.f : 0.f;
            const float av = bf2f(zq[ch]), ag = bf2f(zq[256 + ch]); ext[j] = av * pg8::sigmoid_f(ag) * msk; zp += MIXW; OPAQUE_S(zp); } }
        const float bias = P.cab[ch], g = P.nag[ch], nb = P.nab[ch];
        bf16* mp = uni_ptr(Ms + (size_t)tb * D);
        float* sp = uni_ptr(P.out + O_CA_P + ((ptrdiff_t)(li * BATCH + b) * 30 + (tb - (SEQ - 30))) * 256);
#pragma unroll
        for (int r = 0; r < 16; ++r) { float cv = bias;
#pragma unroll
            for (int k = 0; k < 31; ++k) cv += wA[k] * ext[r + k];
            const float mean = wave_sum(cv) * (1.f / 64.f), dv = cv - mean, var = wave_sum(dv * dv) * (1.f / 64.f);
            const float y = dv * __builtin_amdgcn_rsqf(var + LN_EPS) * g + nb;
            mp[ch] = f2bf16(pg8::silu_f(y)); mp += D; OPAQUE_S(mp);
            if (c == 15 && tb + r >= SEQ - 30) sp[ch] = ext[r + 30];
            sp += 256; OPAQUE_S(sp); }
    }
    {
        float ze[31];
        { const bf16* zp = uni_ptr(Zs + ((ptrdiff_t)(tb - 15) * MIXW));
#pragma unroll
        for (int j = 0; j < 31; ++j) { const bool ok = (tb - 15 + j) >= 0; const bf16* zq = ok ? zp : Zs; ze[j] = bf2f(zq[512 + ch]) * (ok ? 1.f : 0.f); zp += MIXW; OPAQUE_S(zp); } }
        float* sp = uni_ptr(P.out + O_PL_P + ((ptrdiff_t)(li * BATCH + b) * 15 + (tb - (SEQ - 15))) * 256);
        LAS unsigned char* dT = F.lds + DT_OFF + w * 16 * DT_PITCH;
        const int win = 2 << h;
#pragma unroll
        for (int r = 0; r < 16; ++r) { const float zc = ze[r + 15];
            const float s2 = zc + ze[r + 14], s4 = s2 + (ze[r + 13] + ze[r + 12]), s8 = s4 + ((ze[r + 11] + ze[r + 10]) + (ze[r + 9] + ze[r + 8]));
            const float s16 = s8 + (((ze[r + 7] + ze[r + 6]) + (ze[r + 5] + ze[r + 4])) + ((ze[r + 3] + ze[r + 2]) + (ze[r + 1] + ze[r])));
            const int t = tb + r; const float cnt = (float)((t + 1 < win) ? t + 1 : win);
            const float d = pool_sel(h, s2, s4, s8, s16) / cnt - zc;
            *(LAS bf16*)(dT + r * DT_PITCH + lane * 2) = f2bf16(d);
            if (c == 15 && t >= SEQ - 15) sp[ch] = zc;
            sp += 256; OPAQUE_S(sp); }
    }
    __syncthreads();
    {
        const LAS unsigned char* dT = F.lds + DT_OFF + w * 16 * DT_PITCH;
        const bf16x8 b0 = *(const LAS bf16x8*)(dT + fr * DT_PITCH + (fq * 8) * 2), b1 = *(const LAS bf16x8*)(dT + fr * DT_PITCH + (32 + fq * 8) * 2);
#pragma unroll
        for (int nt = 0; nt < 4; ++nt) {
            const LAS unsigned char* wp = F.lds + WPT_OFF + (16 * nt + fr) * WPT_PITCH;
            const bf16x8 a0 = *(const LAS bf16x8*)(wp + (fq * 8) * 2), a1 = *(const LAS bf16x8*)(wp + (32 + fq * 8) * 2);
            f32x4 acc = {0.f, 0.f, 0.f, 0.f};
            acc = __builtin_amdgcn_mfma_f32_16x16x32_bf16(a0, b0, acc, 0, 0, 0);
            acc = __builtin_amdgcn_mfma_f32_16x16x32_bf16(a1, b1, acc, 0, 0, 0);
            const int n = 16 * nt + 4 * fq; const f32x4 sc = *(const f32x4*)(P.ps + h * 64 + n);
            const unsigned lo = pk2(acc[0] * sc[0], acc[1] * sc[1]), hi = pk2(acc[2] * sc[2], acc[3] * sc[3]);
            *(GAS unsigned long long*)(Ms + (size_t)(tb + fr) * D + 256 + h * 64 + n) = (unsigned long long)lo | ((unsigned long long)hi << 32);
        }
    }
    {
        const float g = P.sng[ch], nb = P.snb[ch];
        unsigned pk[8];
        const bf16* zp = uni_ptr(Zs + (size_t)tb * MIXW);
#pragma unroll
        for (int r = 0; r < 16; r += 2) { float vn[2];
#pragma unroll
            for (int q = 0; q < 2; ++q) { const float v = gelu_tanh(bf2f(zp[1024 + ch])); zp += MIXW; OPAQUE_S(zp);
                const float mean = wave_sum(v) * (1.f / 64.f), dv = v - mean, var = wave_sum(dv * dv) * (1.f / 64.f);
                vn[q] = dv * __builtin_amdgcn_rsqf(var + LN_EPS) * g + nb; }
            pk[r >> 1] = pk2(vn[0], vn[1]); }
        LAS unsigned char* vt = F.lds + VNT_OFF + lane * VNT_PITCH + (16 * w) * 2;
        *(LAS v4u*)(vt) = (v4u){pk[0], pk[1], pk[2], pk[3]}; *(LAS v4u*)(vt + 16) = (v4u){pk[4], pk[5], pk[6], pk[7]};
    }
    __syncthreads();
    {
        const int nks = (w >> 1) + 1, tl = 16 * w + fr;
        const float* wrow = P.sw + ((size_t)h * 128 + tl) * 128;
        bf16x8 bw[4];
#pragma unroll
        for (int ks = 0; ks < 4; ++ks) { bf16x8 t = {0, 0, 0, 0, 0, 0, 0, 0};
            if (ks < nks) { const int s0 = 32 * ks + 8 * fq; const f32x4 a = *(const f32x4*)(wrow + s0), bq = *(const f32x4*)(wrow + s0 + 4);
                float e[8] = {a[0], a[1], a[2], a[3], bq[0], bq[1], bq[2], bq[3]};
#pragma unroll
                for (int j = 0; j < 8; ++j) t[j] = (short)f2bf((s0 + j <= tl) ? e[j] : 0.f); }
            bw[ks] = t; }
        const float bsv = P.sb[h * 128 + tl];
#pragma unroll
        for (int ct = 0; ct < 4; ++ct) {
            const LAS unsigned char* vp = F.lds + VNT_OFF + (16 * ct + fr) * VNT_PITCH + (8 * fq) * 2;
            f32x4 acc = {0.f, 0.f, 0.f, 0.f};
#pragma unroll
            for (int ks = 0; ks < 4; ++ks) if (ks < nks) acc = __builtin_amdgcn_mfma_f32_16x16x32_bf16(*(const LAS bf16x8*)(vp + 64 * ks), bw[ks], acc, 0, 0, 0);
            const int cc = h * 64 + 16 * ct + 4 * fq; const size_t ro = (size_t)(tb + fr);
            const unsigned long long uw = *(const GAS unsigned long long*)(Zs + ro * MIXW + 768 + cc);
            const float u0 = gelu_tanh(__uint_as_float((unsigned)uw << 16)), u1 = gelu_tanh(__uint_as_float((unsigned)uw & 0xffff0000u));
            const float u2 = gelu_tanh(__uint_as_float((unsigned)(uw >> 32) << 16)), u3 = gelu_tanh(__uint_as_float((unsigned)(uw >> 32) & 0xffff0000u));
            const unsigned lo = pk2(u0 * (acc[0] + bsv), u1 * (acc[1] + bsv)), hi = pk2(u2 * (acc[2] + bsv), u3 * (acc[3] + bsv));
            *(GAS unsigned long long*)(Ms + ro * D + 512 + cc) = (unsigned long long)lo | ((unsigned long long)hi << 32);
        }
    }
    {
        float q[18], bg[16];
        { const bf16* zp = uni_ptr(Zs + ((ptrdiff_t)(tb - 2) * MIXW));
#pragma unroll
        for (int j = 0; j < 18; ++j) { const bool ok = (tb - 2 + j) >= 0; const bf16* zq = ok ? zp : Zs; q[j] = bf2f(zq[1536 + ch]) * bf2f(zq[1792 + ch]) * (ok ? 1.f : 0.f);
            if (j >= 2) bg[j - 2] = bf2f(zq[1280 + ch]);
            zp += MIXW; OPAQUE_S(zp); } }
        const float w0 = P.scw[ch], w1 = P.scw[256 + ch], w2 = P.scw[512 + ch];
        bf16* mp = uni_ptr(Ms + (size_t)tb * D);
        float* sp = uni_ptr(P.out + O_SC_P + ((ptrdiff_t)(li * BATCH + b) * 2 + (tb - (SEQ - 2))) * 256);
#pragma unroll
        for (int r = 0; r < 16; ++r) { const int t = tb + r; const float y = w0 * q[r] + w1 * q[r + 1] + w2 * q[r + 2];
            mp[768 + ch] = f2bf16(bg[r] * y); mp += D; OPAQUE_S(mp);
            if (c == 15 && t >= SEQ - 2) sp[ch] = q[r + 2];
            sp += 256; OPAQUE_S(sp); }
    }
    __syncthreads();
}
constexpr int SB01_OFF = 0, SB2_OFF = 24064, SB345_OFF = 34176, SB67_OFF = 58752, VNT2_OFF = 75648, WPT2_OFF = 93056, DT2_OFF = 102272;
__device__ __forceinline__ void mix_prompt_unit2(Frame& F, const MixP& P, int b, int c, int h) {
    const int w = F.wave, lane = F.lane, tid = F.tid, ch = h * 64 + lane, fr = lane & 15, fq = lane >> 4, li = P.li;
    const bf16* Zs = uni_ptr(P.Z + (size_t)b * SEQ * MIXW);
    bf16* Ms = uni_ptr(P.MIX + (size_t)b * SEQ * D);
    LAS unsigned char* L = F.lds;
    const v4u zero4 = {0u, 0u, 0u, 0u};
    { const int n = tid & 63, kg = tid >> 6; const float* src = P.pw + (size_t)h * 4096 + (size_t)(8 * kg) * 64 + n;
      v4u o; o.x = pk2(src[0], src[64]); o.y = pk2(src[128], src[192]); o.z = pk2(src[256], src[320]); o.w = pk2(src[384], src[448]);
      *(LAS v4u*)(L + WPT2_OFF + n * WPT_PITCH + kg * 16) = o; }
    float wA[31];
    { const float* wp = P.caw;
#pragma unroll
    for (int k = 0; k < 31; ++k) { wA[k] = wp[ch]; wp += 256; OPAQUE_S(wp); } }
    for (int hh = 0; hh < 2; ++hh) {
        const int tlo = __builtin_amdgcn_readfirstlane(128 * c + 64 * hh);
        {
            const bf16* zc0 = Zs + h * 64;
            v4u va[3], vb[2], vc[3], vd[3];
#pragma unroll
            for (int k = 0; k < 3; ++k) { const int i = tid + 512 * k; const int r = i >> 4, sl = (i >> 3) & 1, kk = i & 7, tt = tlo - 30 + r;
                va[k] = (i < 1504 && tt >= 0) ? *(const GAS v4u*)(zc0 + (size_t)tt * MIXW + sl * 256 + kk * 8) : zero4; }
#pragma unroll
            for (int k = 0; k < 2; ++k) { const int i = tid + 512 * k; const int r = i >> 3, kk = i & 7, tt = tlo - 15 + r;
                vb[k] = (i < 632 && tt >= 0) ? *(const GAS v4u*)(zc0 + (size_t)tt * MIXW + 512 + kk * 8) : zero4; }
#pragma unroll
            for (int k = 0; k < 3; ++k) { const int i = tid + 512 * k; const int r = i / 24, rem = i - r * 24, sl = rem >> 3, kk = rem & 7, tt = tlo + r;
                vc[k] = *(const GAS v4u*)(zc0 + (size_t)tt * MIXW + (3 + sl) * 256 + kk * 8); }
#pragma unroll
            for (int k = 0; k < 3; ++k) { const int i = tid + 512 * k; const int r = i >> 4, sl = (i >> 3) & 1, kk = i & 7, tt = tlo - 2 + r;
                vd[k] = (i < 1056 && tt >= 0) ? *(const GAS v4u*)(zc0 + (size_t)tt * MIXW + (6 + sl) * 256 + kk * 8) : zero4; }
#pragma unroll
            for (int k = 0; k < 3; ++k) { const int i = tid + 512 * k; if (i < 1504) *(LAS v4u*)(L + SB01_OFF + (i >> 4) * 256 + ((i >> 3) & 1) * 128 + (i & 7) * 16) = va[k]; }
#pragma unroll
            for (int k = 0; k < 2; ++k) { const int i = tid + 512 * k; if (i < 632) *(LAS v4u*)(L + SB2_OFF + (i >> 3) * 128 + (i & 7) * 16) = vb[k]; }
#pragma unroll
            for (int k = 0; k < 3; ++k) { const int i = tid + 512 * k; const int r = i / 24, rem = i - r * 24; *(LAS v4u*)(L + SB345_OFF + r * 384 + (rem >> 3) * 128 + (rem & 7) * 16) = vc[k]; }
#pragma unroll
            for (int k = 0; k < 3; ++k) { const int i = tid + 512 * k; if (i < 1056) *(LAS v4u*)(L + SB67_OFF + (i >> 4) * 256 + ((i >> 3) & 1) * 128 + (i & 7) * 16) = vd[k]; }
        }
        __syncthreads();
        {
            float ha[12], qv[9];
#pragma unroll
            for (int k = 0; k < 12; ++k) { const int i = tid + 512 * k; const int r = i >> 6, cc = i & 63; ha[k] = 0.f;
                if (i < 94 * 64) { const LAS bf16* p = (const LAS bf16*)(L + SB01_OFF + r * 256 + cc * 2); ha[k] = bf2f(p[0]) * pg8::sigmoid_f(bf2f(p[64])); } }
#pragma unroll
            for (int k = 0; k < 9; ++k) { const int i = tid + 512 * k; const int r = i >> 6, cc = i & 63; qv[k] = 0.f;
                if (i < 66 * 64) { const LAS bf16* p = (const LAS bf16*)(L + SB67_OFF + r * 256 + cc * 2); qv[k] = bf2f(p[0]) * bf2f(p[64]); } }
            __syncthreads();
#pragma unroll
            for (int k = 0; k < 12; ++k) { const int i = tid + 512 * k; if (i < 94 * 64) *(LAS float*)(L + SB01_OFF + (i >> 6) * 256 + (i & 63) * 4) = ha[k]; }
#pragma unroll
            for (int k = 0; k < 9; ++k) { const int i = tid + 512 * k; if (i < 66 * 64) *(LAS float*)(L + SB67_OFF + (i >> 6) * 256 + (i & 63) * 4) = qv[k]; }
        }
        __syncthreads();
        const int tb = __builtin_amdgcn_readfirstlane(tlo + 8 * w);
        {
            float ext[38];
#pragma unroll
            for (int e = 0; e < 38; ++e) ext[e] = *(const LAS float*)(L + SB01_OFF + (8 * w + e) * 256 + lane * 4);
            const float bias = P.cab[ch], g = P.nag[ch], nb = P.nab[ch];
            bf16* mp = uni_ptr(Ms + (size_t)tb * D);
            float cv[8], mean[8], rstd[8];
#pragma unroll
            for (int r = 0; r < 8; ++r) { float a = bias;
#pragma unroll
                for (int k = 0; k < 31; ++k) a += wA[k] * ext[r + k];
                cv[r] = a; }
            ln8_stats(cv, mean, rstd, LN_EPS);
#pragma unroll
            for (int r = 0; r < 8; ++r) { const float y = (cv[r] - mean[r]) * rstd[r] * g + nb;
                mp[ch] = f2bf16(pg8::silu_f(y)); mp += D; OPAQUE_S(mp); }
            if (c == 15 && hh == 1) {
                float* sp = uni_ptr(P.out + O_CA_P + ((ptrdiff_t)(li * BATCH + b) * 30 + (tb - (SEQ - 30))) * 256);
#pragma unroll
                for (int r = 0; r < 8; ++r) { if (tb + r >= SEQ - 30) sp[ch] = ext[r + 30]; sp += 256; OPAQUE_S(sp); } }
        }
        {
            float ze[23];
#pragma unroll
            for (int e = 0; e < 23; ++e) ze[e] = bf2f(*(const LAS bf16*)(L + SB2_OFF + (8 * w + e) * 128 + lane * 2));
            const int win = 2 << h;
#pragma unroll
            for (int r = 0; r < 8; ++r) { const float zc = ze[r + 15];
                const float s2 = zc + ze[r + 14], s4 = s2 + (ze[r + 13] + ze[r + 12]), s8 = s4 + ((ze[r + 11] + ze[r + 10]) + (ze[r + 9] + ze[r + 8]));
                const float s16 = s8 + (((ze[r + 7] + ze[r + 6]) + (ze[r + 5] + ze[r + 4])) + ((ze[r + 3] + ze[r + 2]) + (ze[r + 1] + ze[r])));
                const int t = tb + r; const float cnt = (float)((t + 1 < win) ? t + 1 : win);
                *(LAS bf16*)(L + DT2_OFF + (8 * w + r) * DT_PITCH + lane * 2) = f2bf16(pool_sel(h, s2, s4, s8, s16) * __builtin_amdgcn_rcpf(cnt) - zc);
                }
            if (c == 15 && hh == 1) {
                float* sp = uni_ptr(P.out + O_PL_P + ((ptrdiff_t)(li * BATCH + b) * 15 + (tb - (SEQ - 15))) * 256);
#pragma unroll
                for (int r = 0; r < 8; ++r) { if (tb + r >= SEQ - 15) sp[ch] = ze[r + 15]; sp += 256; OPAQUE_S(sp); } }
        }
        {
            const float g = P.sng[ch], nb = P.snb[ch];
            unsigned pk[4]; float vv[8], mean[8], rstd[8];
#pragma unroll
            for (int r = 0; r < 8; ++r) vv[r] = gelu_tanh(bf2f(*(const LAS bf16*)(L + SB345_OFF + (8 * w + r) * 384 + 128 + lane * 2)));
            ln8_stats(vv, mean, rstd, LN_EPS);
#pragma unroll
            for (int r = 0; r < 8; r += 2) pk[r >> 1] = pk2((vv[r] - mean[r]) * rstd[r] * g + nb, (vv[r + 1] - mean[r + 1]) * rstd[r + 1] * g + nb);
            *(LAS v4u*)(L + VNT2_OFF + lane * VNT_PITCH + (64 * hh + 8 * w) * 2) = (v4u){pk[0], pk[1], pk[2], pk[3]};
        }
        {
            float q[10];
#pragma unroll
            for (int e = 0; e < 10; ++e) q[e] = *(const LAS float*)(L + SB67_OFF + (8 * w + e) * 256 + lane * 4);
            const float w0 = P.scw[ch], w1 = P.scw[256 + ch], w2 = P.scw[512 + ch];
            bf16* mp = uni_ptr(Ms + (size_t)tb * D);
#pragma unroll
            for (int r = 0; r < 8; ++r) { const float bg = bf2f(*(const LAS bf16*)(L + SB345_OFF + (8 * w + r) * 384 + 256 + lane * 2));
                mp[768 + ch] = f2bf16(bg * (w0 * q[r] + w1 * q[r + 1] + w2 * q[r + 2])); mp += D; OPAQUE_S(mp); }
            if (c == 15 && hh == 1) {
                float* sp = uni_ptr(P.out + O_SC_P + ((ptrdiff_t)(li * BATCH + b) * 2 + (tb - (SEQ - 2))) * 256);
#pragma unroll
                for (int r = 0; r < 8; ++r) { if (tb + r >= SEQ - 2) sp[ch] = q[r + 2]; sp += 256; OPAQUE_S(sp); } }
        }
        __syncthreads();
        const int rt = w >> 1, t0 = 64 * hh + 16 * rt;
        {
            const LAS unsigned char* dT = L + DT2_OFF + (16 * rt + fr) * DT_PITCH;
            const bf16x8 b0 = *(const LAS bf16x8*)(dT + (fq * 8) * 2), b1 = *(const LAS bf16x8*)(dT + (32 + fq * 8) * 2);
#pragma unroll
            for (int nn = 0; nn < 2; ++nn) { const int nt = 2 * (w & 1) + nn;
                const LAS unsigned char* wp = L + WPT2_OFF + (16 * nt + fr) * WPT_PITCH;
                const bf16x8 a0 = *(const LAS bf16x8*)(wp + (fq * 8) * 2), a1 = *(const LAS bf16x8*)(wp + (32 + fq * 8) * 2);
                f32x4 acc = {0.f, 0.f, 0.f, 0.f};
                acc = __builtin_amdgcn_mfma_f32_16x16x32_bf16(a0, b0, acc, 0, 0, 0);
                acc = __builtin_amdgcn_mfma_f32_16x16x32_bf16(a1, b1, acc, 0, 0, 0);
                const int n = 16 * nt + 4 * fq; const f32x4 sc = *(const f32x4*)(P.ps + h * 64 + n);
                const unsigned lo = pk2(acc[0] * sc[0], acc[1] * sc[1]), hi = pk2(acc[2] * sc[2], acc[3] * sc[3]);
                *(GAS unsigned long long*)(Ms + (size_t)(tlo + 16 * rt + fr) * D + 256 + h * 64 + n) = (unsigned long long)lo | ((unsigned long long)hi << 32); }
        }
        {
            const int nks = (t0 >> 5) + 1, tl = t0 + fr;
            const float* wrow = P.sw + ((size_t)h * 128 + tl) * 128;
            bf16x8 bw[4];
#pragma unroll
            for (int ks = 0; ks < 4; ++ks) { bf16x8 t = {0, 0, 0, 0, 0, 0, 0, 0};
                if (ks < nks) { const int s0 = 32 * ks + 8 * fq; const f32x4 a = *(const f32x4*)(wrow + s0), bq = *(const f32x4*)(wrow + s0 + 4);
                    float e[8] = {a[0], a[1], a[2], a[3], bq[0], bq[1], bq[2], bq[3]};
#pragma unroll
                    for (int j = 0; j < 8; ++j) e[j] = (s0 + j <= tl) ? e[j] : 0.f;
                    const v4u tw = {pk2(e[0], e[1]), pk2(e[2], e[3]), pk2(e[4], e[5]), pk2(e[6], e[7])}; t = __builtin_bit_cast(bf16x8, tw); }
                bw[ks] = t; }
            const float bsv = P.sb[h * 128 + tl];
#pragma unroll
            for (int cn = 0; cn < 2; ++cn) { const int ct = 2 * (w & 1) + cn;
                const LAS unsigned char* vp = L + VNT2_OFF + (16 * ct + fr) * VNT_PITCH + (8 * fq) * 2;
                f32x4 acc = {0.f, 0.f, 0.f, 0.f};
#pragma unroll
                for (int ks = 0; ks < 4; ++ks) if (ks < nks) acc = __builtin_amdgcn_mfma_f32_16x16x32_bf16(*(const LAS bf16x8*)(vp + 64 * ks), bw[ks], acc, 0, 0, 0);
                const int cc = 16 * ct + 4 * fq;
                const unsigned long long uw = *(const LAS unsigned long long*)(L + SB345_OFF + (16 * rt + fr) * 384 + cc * 2);
                const float u0 = gelu_tanh(__uint_as_float((unsigned)uw << 16)), u1 = gelu_tanh(__uint_as_float((unsigned)uw & 0xffff0000u));
                const float u2 = gelu_tanh(__uint_as_float((unsigned)(uw >> 32) << 16)), u3 = gelu_tanh(__uint_as_float((unsigned)(uw >> 32) & 0xffff0000u));
                const unsigned lo = pk2(u0 * (acc[0] + bsv), u1 * (acc[1] + bsv)), hi = pk2(u2 * (acc[2] + bsv), u3 * (acc[3] + bsv));
                *(GAS unsigned long long*)(Ms + (size_t)(tlo + 16 * rt + fr) * D + 512 + h * 64 + cc) = (unsigned long long)lo | ((unsigned long long)hi << 32); }
        }
        __syncthreads();
    }
}
__device__ __forceinline__ void mix_sample_wave(Frame& F, const MixP& P, int b, int h) {
    const int lane = F.lane, ch = h * 64 + lane, li = P.li;
    b = __builtin_amdgcn_readfirstlane(b); h = __builtin_amdgcn_readfirstlane(h);
    const bf16* Zr = uni_ptr(P.Z + (size_t)(MP + b * DECS) * MIXW); bf16* Mr = uni_ptr(P.MIX + (size_t)(MP + b * DECS) * D);
    const size_t sb_ = (size_t)li * DECB + b;
    {
        float wA[31];
        { const float* wp = P.caw;
#pragma unroll
        for (int k = 0; k < 31; ++k) { wA[k] = wp[ch]; wp += 256; OPAQUE_S(wp); } }
        float ext[38];
        { const float* sp = P.st_a + sb_ * 30 * 256; float* so = P.out + O_CA_S + sb_ * 30 * 256;
#pragma unroll
        for (int j = 0; j < 30; ++j) { ext[j] = sp[ch]; sp += 256; OPAQUE_S(sp); }
        const bf16* zp = Zr;
#pragma unroll
        for (int t = 0; t < 8; ++t) { ext[30 + t] = bf2f(zp[ch]) * pg8::sigmoid_f(bf2f(zp[256 + ch])); zp += MIXW; OPAQUE_S(zp); }
#pragma unroll
        for (int j = 0; j < 30; ++j) { so[ch] = ext[j + 8]; so += 256; OPAQUE_S(so); } }
        const float bias = P.cab[ch], g = P.nag[ch], nb = P.nab[ch];
        bf16* mp = Mr; float cvs[8], mean8[8], rstd8[8];
#pragma unroll
        for (int t = 0; t < 8; ++t) { float a = bias;
#pragma unroll
            for (int k = 0; k < 31; ++k) a += wA[k] * ext[t + k];
            cvs[t] = a; }
        ln8_stats(cvs, mean8, rstd8, LN_EPS);
#pragma unroll
        for (int t = 0; t < 8; ++t) { mp[ch] = f2bf16(pg8::silu_f((cvs[t] - mean8[t]) * rstd8[t] * g + nb)); mp += D; OPAQUE_S(mp); }
    }
    {
        float ze[23];
        { const float* sp = P.st_p + sb_ * 15 * 256; float* so = P.out + O_PL_S + sb_ * 15 * 256;
#pragma unroll
        for (int j = 0; j < 15; ++j) { ze[j] = sp[ch]; sp += 256; OPAQUE_S(sp); }
        const bf16* zp = Zr;
#pragma unroll
        for (int t = 0; t < 8; ++t) { ze[15 + t] = bf2f(zp[512 + ch]); zp += MIXW; OPAQUE_S(zp); }
#pragma unroll
        for (int j = 0; j < 15; ++j) { so[ch] = ze[j + 8]; so += 256; OPAQUE_S(so); } }
        float d[8], y[8];
        const float inv = 1.0f / (float)(2 << h);
#pragma unroll
        for (int r = 0; r < 8; ++r) { const float zc = ze[r + 15];
            const float s2 = zc + ze[r + 14], s4 = s2 + (ze[r + 13] + ze[r + 12]), s8 = s4 + ((ze[r + 11] + ze[r + 10]) + (ze[r + 9] + ze[r + 8]));
            const float s16 = s8 + (((ze[r + 7] + ze[r + 6]) + (ze[r + 5] + ze[r + 4])) + ((ze[r + 3] + ze[r + 2]) + (ze[r + 1] + ze[r])));
            d[r] = pool_sel(h, s2, s4, s8, s16) * inv - zc; y[r] = 0.f; }
        const float* pwh = P.pw + (size_t)h * 4096;
#pragma unroll 8
        for (int k = 0; k < 64; ++k) { const float wv = pwh[lane]; pwh += 64;
#pragma unroll
            for (int r = 0; r < 8; ++r) y[r] += __shfl(d[r], k) * wv; }
        const float sc = P.ps[ch];
        bf16* mp = Mr;
#pragma unroll
        for (int r = 0; r < 8; ++r) { mp[256 + ch] = f2bf16(y[r] * sc); mp += D; OPAQUE_S(mp); }
    }
    {
        const float g = P.sng[ch], nb = P.snb[ch];
        float vn[8], ug[8];
        { const bf16* zp = Zr; float* so = P.out + O_CV_S + sb_ * DECS * 256;
#pragma unroll
        for (int t = 0; t < 8; ++t) { vn[t] = gelu_tanh(bf2f(zp[1024 + ch])); ug[t] = gelu_tanh(bf2f(zp[768 + ch])); zp += MIXW; OPAQUE_S(zp); }
        { float mean8[8], rstd8[8]; ln8_stats(vn, mean8, rstd8, LN_EPS);
#pragma unroll
        for (int t = 0; t < 8; ++t) { vn[t] = (vn[t] - mean8[t]) * rstd8[t] * g + nb; so[ch] = vn[t]; so += 256; OPAQUE_S(so); } } }
        bf16* mp = Mr; const float* swp = P.sw + (size_t)h * 128 * 128; const float* sbp = P.sb + h * 128;
#pragma unroll
        for (int t = 0; t < 8; ++t) { float s = sbp[t];
#pragma unroll
            for (int q = 0; q <= t; ++q) s += swp[q] * vn[q];
            swp += 128; OPAQUE_S(swp);
            mp[512 + ch] = f2bf16(ug[t] * s); mp += D; OPAQUE_S(mp); }
    }
    {
        float q[10], bg[8];
        q[0] = P.st_s[(sb_ * 2 + 0) * 256 + ch]; q[1] = P.st_s[(sb_ * 2 + 1) * 256 + ch];
        { const bf16* zp = Zr;
#pragma unroll
        for (int t = 0; t < 8; ++t) { q[2 + t] = bf2f(zp[1536 + ch]) * bf2f(zp[1792 + ch]); bg[t] = bf2f(zp[1280 + ch]); zp += MIXW; OPAQUE_S(zp); } }
        const float w0 = P.scw[ch], w1 = P.scw[256 + ch], w2 = P.scw[512 + ch];
        bf16* mp = Mr;
#pragma unroll
        for (int t = 0; t < 8; ++t) { mp[768 + ch] = f2bf16(bg[t] * (w0 * q[t] + w1 * q[t + 1] + w2 * q[t + 2])); mp += D; OPAQUE_S(mp); }
        P.out[O_SC_S + (sb_ * 2 + 0) * 256 + ch] = q[8]; P.out[O_SC_S + (sb_ * 2 + 1) * 256 + ch] = q[9];
    }
}
constexpr int MIX_PUNITS = BATCH * 16 * 4, MIX_SUNITS = DECB * 4 / NWAVES;
__device__ __forceinline__ void mix_phase(Frame& F, const MixP& P) {
    for (int u = blockIdx.x; u < MIX_PUNITS + MIX_SUNITS; u += F.G) {
        asm volatile("" : "+v"(F.tid), "+v"(F.lane), "+s"(F.wave) :: "memory");
        if (u < MIX_PUNITS) mix_prompt_unit2(F, P, u >> 6, (u >> 2) & 15, u & 3);
        else { const int wu = (u - MIX_PUNITS) * NWAVES + F.wave; mix_sample_wave(F, P, wu >> 2, wu & 3); }
    }
}
__device__ __forceinline__ void small_gemm_resid(Frame& F, const bf16* A, int lda, const bf16* Bt, int K, bf16* XB, float scale, int m0) {
    const int w = F.wave, lane = F.lane, tid = F.tid, fr = lane & 15, fq = lane >> 4, K8 = K >> 3;
    constexpr int PP = 68;
    LAS float* Pt = (LAS float*)(F.lds);
    for (int t = (int)blockIdx.x; t < 256; t += F.G) {
        const int ti = t >> 4, tj = t & 15;
        const bf16* a0 = A + (size_t)(m0 + 64 * ti + fr) * lda + w * K8 + 8 * fq;
        const bf16* b0 = Bt + (size_t)(64 * tj + fr) * lda + w * K8 + 8 * fq;
        f32x4 acc[4][4];
#pragma unroll
        for (int mi = 0; mi < 4; ++mi)
#pragma unroll
            for (int ni = 0; ni < 4; ++ni) acc[mi][ni] = (f32x4){0.f, 0.f, 0.f, 0.f};
#pragma unroll 2
        for (int k = 0; k < K8; k += 32) {
            bf16x8 af[4], bfr[4];
#pragma unroll
            for (int mi = 0; mi < 4; ++mi) af[mi] = *(const bf16x8*)(a0 + (size_t)(16 * mi) * lda + k);
#pragma unroll
            for (int ni = 0; ni < 4; ++ni) bfr[ni] = *(const bf16x8*)(b0 + (size_t)(16 * ni) * lda + k);
#pragma unroll
            for (int mi = 0; mi < 4; ++mi)
#pragma unroll
                for (int ni = 0; ni < 4; ++ni) acc[mi][ni] = __builtin_amdgcn_mfma_f32_16x16x32_bf16(af[mi], bfr[ni], acc[mi][ni], 0, 0, 0);
        }
        LAS float* mine = Pt + (w & 3) * 64 * PP + (4 * fq) * PP + fr;
        if (w >= 4) {
#pragma unroll
            for (int mi = 0; mi < 4; ++mi)
#pragma unroll
                for (int ni = 0; ni < 4; ++ni)
#pragma unroll
                    for (int rg = 0; rg < 4; ++rg) mine[(16 * mi + rg) * PP + 16 * ni] = acc[mi][ni][rg];
        }
        __syncthreads();
        if (w < 4) {
#pragma unroll
            for (int mi = 0; mi < 4; ++mi)
#pragma unroll
                for (int ni = 0; ni < 4; ++ni)
#pragma unroll
                    for (int rg = 0; rg < 4; ++rg) acc[mi][ni][rg] += mine[(16 * mi + rg) * PP + 16 * ni];
#pragma unroll
            for (int mi = 0; mi < 4; ++mi)
#pragma unroll
                for (int ni = 0; ni < 4; ++ni)
#pragma unroll
                    for (int rg = 0; rg < 4; ++rg) mine[(16 * mi + rg) * PP + 16 * ni] = acc[mi][ni][rg];
        }
        __syncthreads();
        { const int row = tid >> 3, c8 = (tid & 7) * 8;
          f32x4 s0 = {0.f, 0.f, 0.f, 0.f}, s1 = {0.f, 0.f, 0.f, 0.f};
#pragma unroll
          for (int q = 0; q < 4; ++q) { const LAS f32x4* p = (const LAS f32x4*)(Pt + (q * 64 + row) * PP + c8); s0 += p[0]; s1 += p[1]; }
          const size_t off = (size_t)(m0 + 64 * ti + row) * D + 64 * tj + c8;
          const v4u rw = *(const GAS v4u*)(XB + off);
          f32x4 x0 = {__uint_as_float(rw.x << 16), __uint_as_float(rw.x & 0xffff0000u), __uint_as_float(rw.y << 16), __uint_as_float(rw.y & 0xffff0000u)};
          f32x4 x1 = {__uint_as_float(rw.z << 16), __uint_as_float(rw.z & 0xffff0000u), __uint_as_float(rw.w << 16), __uint_as_float(rw.w & 0xffff0000u)};
          x0 += s0 * scale; x1 += s1 * scale;
          v4u o; o.x = pk2(x0[0], x0[1]); o.y = pk2(x0[2], x0[3]); o.z = pk2(x1[0], x1[1]); o.w = pk2(x1[2], x1[3]);
          *(GAS v4u*)(XB + off) = o; }
        __syncthreads();
    }
}
__global__ void __launch_bounds__(NWAVES * 64, 2) fwd_megakernel(Args args) {
    extern __shared__ __attribute__((aligned(16))) unsigned char lds[];
    Frame F;
    F.lds = (LAS unsigned char*)lds;
    F.tid = threadIdx.x; F.lane = F.tid & 63; F.wave = __builtin_amdgcn_readfirstlane(F.tid >> 6);
    F.G = gridDim.x; { const int bx = blockIdx.x; F.vcu = (F.G % 8 == 0) ? (bx % 8) * (F.G / 8) + bx / 8 : bx; }
    unsigned char* ws = args.ws;
    for (int u = F.tid; u < (LDS_BYTES - LDSCTL_OFF) / 4; u += NWAVES * 64) ((LAS unsigned*)(F.lds + LDSCTL_OFF))[u] = 0u;
    __syncthreads();
    XcdBarrier bar = xcd_barrier_post((unsigned*)(ws + WS_CTL) + CW_BAR, (volatile LAS unsigned*)(F.lds + MISC_OFF) + 8);
#define GRID_BAR() do { asm volatile("" : "+s"(bar.bar)); xcd_barrier(bar); asm volatile("" : "+v"(F.tid), "+v"(F.lane), "+s"(F.wave) :: "memory"); } while (0)
#if defined(NO_GEMM) || (defined(ONLY) && ONLY != 1)
#define RUN_GEMM1(...)
#else
#define RUN_GEMM1(...) __VA_ARGS__
#endif
#if defined(NO_GEMM) || (defined(ONLY) && ONLY != 2)
#define RUN_GEMM2(...)
#else
#define RUN_GEMM2(...) __VA_ARGS__
#endif
#if defined(NO_GEMM) || (defined(ONLY) && ONLY != 3)
#define RUN_GEMM3(...)
#else
#define RUN_GEMM3(...) __VA_ARGS__
#endif
#if defined(NO_GEMM) || (defined(ONLY) && ONLY != 4)
#define RUN_GEMM4(...)
#else
#define RUN_GEMM4(...) __VA_ARGS__
#endif
#if defined(NO_GEMM) || (defined(ONLY) && ONLY != 5)
#define RUN_GEMM5(...)
#else
#define RUN_GEMM5(...) __VA_ARGS__
#endif
#if defined(NO_GEMM) || (defined(ONLY) && ONLY != 6)
#define RUN_GEMM6(...)
#else
#define RUN_GEMM6(...) __VA_ARGS__
#endif
#if defined(NO_GEMM) || (defined(ONLY) && ONLY != 7)
#define RUN_GEMM7(...)
#else
#define RUN_GEMM7(...) __VA_ARGS__
#endif
#if defined(NO_GEMM) || (defined(ONLY) && ONLY != 8)
#define RUN_GEMM8(...)
#else
#define RUN_GEMM8(...) __VA_ARGS__
#endif

#ifndef NO_PRO
    p0_prologue(F, args);
#ifdef PROBE_PRO2
    p0_prologue(F, args);
#endif
#endif
    if (args.ws == nullptr) cg::this_grid().sync();
    GRID_BAR();

    float* X = args.out;
    pg8::bf16_t* ACT = (pg8::bf16_t*)(ws + WS_ACT);
    if (F.tid == 0) { unsigned ok = (F.G % 8 == 0) ? 1u : 0u; for (unsigned j = 0; j < 8; ++j) ok &= (xb_ld(&bar.bar[XB_XCNT(j)]) == (unsigned)(F.G / 8)) ? 1u : 0u;
        volatile LAS unsigned* stw = (volatile LAS unsigned*)(F.lds + MISC_OFF) + 8; const unsigned rk = stw[4];
        stw[5] = (ok && rk < (unsigned)(F.G / 8) && bar.x < 8u) ? 8u * rk + bar.x : (unsigned)blockIdx.x; }
    __syncthreads();
    const int G = F.G, cu = __builtin_amdgcn_readfirstlane((int)((volatile LAS unsigned*)(F.lds + MISC_OFF))[8 + 5]);
    for (int li = 0; li < DEPTH; ++li) {
        pg8::bf16_t* XB = (pg8::bf16_t*)(ws + ((li & 1) ? WS_BUFB : WS_BUFA));
        pg8::bf16_t* MX = (pg8::bf16_t*)(ws + ((li & 1) ? WS_BUFA : WS_BUFB));
        const unsigned char* wl = ws + WS_W + (size_t)li * W_LAYER;
        { pg8::Gemm g{XB, (const pg8::bf16_t*)(wl + WO_GU1), M, NGU, D}; pg8::StaticOrder S; S.init(M, NGU, G, opaque_s(cu));
          pg8::EpiSwiGLU E{ACT, FF}; RUN_GEMM1(pg8::gemm_phase<pg8::EpiSwiGLU, pg8::StaticOrder, true, true>(F.lds + RING_OFF, g, S, E);)
#ifdef PROBE_P1X2
          pg8::gemm_phase<pg8::EpiSwiGLU, pg8::StaticOrder, true, true>(F.lds + RING_OFF, g, S, E);
#endif
#ifdef PROBE_P1NULL
          { pg8::EpiNull E0; pg8::gemm_phase<pg8::EpiNull, pg8::StaticOrder, true, true>(F.lds + RING_OFF, g, S, E0); }
#endif
        }
        GRID_BAR();
        { pg8::Gemm g{ACT, (const pg8::bf16_t*)(wl + WO_D1), M, D, FF}; pg8::MixedOrder S; S.init(MP, 0, D, G, opaque_s(cu));
          pg8::EpiResid<0> E{XB, XB, 0.5f, nullptr}; RUN_GEMM2(pg8::gemm_phase<pg8::EpiResid<0>, pg8::MixedOrder, true, true>(F.lds + RING_OFF, g, S, E);) }
        small_gemm_resid(F, (const bf16*)ACT, FF, (const bf16*)(wl + WO_D1), FF, (bf16*)XB, 0.5f, MP);
        GRID_BAR();
        { pg8::Gemm g{XB, (const pg8::bf16_t*)(wl + WO_MI), M, MIXW, D}; pg8::MixedOrder S; S.init(MP, MS, MIXW, G, opaque_s(cu));
          pg8::EpiScaleBf16<true> E{ACT, MIXW}; RUN_GEMM3(pg8::gemm_phase<pg8::EpiScaleBf16<true>, pg8::MixedOrder, true, true>(F.lds + RING_OFF, g, S, E);) }
        GRID_BAR();
        { MixP P; P.Z = (const bf16*)ACT; P.MIX = (bf16*)MX; P.caw = args.in[opaque_s(13)] + (size_t)li * 31 * 256; P.cab = args.in[opaque_s(14)] + li * 256; P.nag = args.in[opaque_s(15)] + li * 256; P.nab = args.in[opaque_s(16)] + li * 256;
          P.pw = args.in[opaque_s(17)] + (size_t)li * 4 * 4096; P.ps = args.in[opaque_s(18)] + li * 256; P.sng = args.in[opaque_s(19)] + li * 256; P.snb = args.in[opaque_s(20)] + li * 256;
          P.sw = args.in[opaque_s(21)] + (size_t)li * 4 * 128 * 128; P.sb = args.in[opaque_s(22)] + li * 4 * 128; P.scw = args.in[opaque_s(23)] + li * 3 * 256; P.out = args.out; P.li = li;
          P.st_a = args.in[opaque_s(4)]; P.st_p = args.in[opaque_s(5)]; P.st_s = args.in[opaque_s(6)];
#ifndef NO_MIX
          mix_phase(F, P);
#ifdef PROBE_MIX2
          mix_phase(F, P);
#endif
#endif
        }
        GRID_BAR();
        { pg8::Gemm g{MX, (const pg8::bf16_t*)(wl + WO_MO), M, D, D}; pg8::MixedOrder S; S.init(MP, MS, D, G, opaque_s(cu));
          pg8::EpiResid<0> E{XB, XB, 1.0f, nullptr}; RUN_GEMM4(pg8::gemm_phase<pg8::EpiResid<0>, pg8::MixedOrder, true, true>(F.lds + RING_OFF, g, S, E);) }
        GRID_BAR();
        { pg8::Gemm g{XB, (const pg8::bf16_t*)(wl + WO_GU2), M, NGU, D}; pg8::StaticOrder S; S.init(M, NGU, G, opaque_s(cu));
          pg8::EpiSwiGLU E{ACT, FF}; RUN_GEMM5(pg8::gemm_phase<pg8::EpiSwiGLU, pg8::StaticOrder, true, true>(F.lds + RING_OFF, g, S, E);) }
        GRID_BAR();
        { pg8::Gemm g{ACT, (const pg8::bf16_t*)(wl + WO_D2), M, D, FF}; pg8::MixedOrder S; S.init(MP, 0, D, G, opaque_s(cu));
          pg8::EpiResid<0> E{XB, XB, 0.5f, nullptr}; RUN_GEMM6(pg8::gemm_phase<pg8::EpiResid<0>, pg8::MixedOrder, true, true>(F.lds + RING_OFF, g, S, E);) }
        small_gemm_resid(F, (const bf16*)ACT, FF, (const bf16*)(wl + WO_D2), FF, (bf16*)XB, 0.5f, MP);
        { pg8::Gemm g{(const pg8::bf16_t*)(ws + WS_PB) + (size_t)li * M * DPLE, (const pg8::bf16_t*)(wl + WO_PP), M, D, DPLE}; pg8::StaticOrder S; S.init(M, D, G, opaque_s((cu + 128) % G));
          pg8::EpiScaleBf16<false> E{MX, D}; RUN_GEMM7(pg8::gemm_phase<pg8::EpiScaleBf16<false>, pg8::StaticOrder, true, true>(F.lds + RING_OFF, g, S, E);) }
        GRID_BAR();
        { pg8::Gemm g{XB, (const pg8::bf16_t*)(wl + WO_PG), M, D, D}; pg8::MixedOrder S; S.init(MP, MS, D, G, opaque_s(cu));
          pg8::EpiResid<1> E{MX, XB, 0.f, MX}; RUN_GEMM8(pg8::gemm_phase<pg8::EpiResid<1>, pg8::MixedOrder, true, true>(F.lds + RING_OFF, g, S, E);) }
        GRID_BAR();
    }
#ifndef NO_FIN
    final_norm(F, args, (const bf16*)(ws + ((DEPTH & 1) ? WS_BUFB : WS_BUFA)));
#endif
}

extern "C" void kernel_launch(void* const* d_in, const int* in_sizes, int n_in, void* d_out, int out_size, void* d_ws, size_t ws_size, hipStream_t stream) {
    static int grid = 0;
    if (grid == 0) {
        if (n_in != NIN || in_sizes[0] != MP * D || (size_t)out_size != O_END || ws_size < WS_END) {
            fprintf(stderr, "kernel_launch: unexpected shapes: n_in %d in0 %d out %d (want %zu) ws %zu (need %zu); nothing launched\n", n_in, n_in > 0 ? in_sizes[0] : -1, out_size, (size_t)O_END, ws_size, (size_t)WS_END); grid = -1; return; }
        int dev = 0, cus = 0, per_cu = 0;
        if (hipGetDevice(&dev) != hipSuccess || hipDeviceGetAttribute(&cus, hipDeviceAttributeMultiprocessorCount, dev) != hipSuccess) { grid = -1; return; }
        if (hipFuncSetAttribute((const void*)fwd_megakernel, hipFuncAttributeMaxDynamicSharedMemorySize, LDS_BYTES) != hipSuccess) { fprintf(stderr, "kernel_launch: hipFuncSetAttribute failed\n"); grid = -1; return; }
        if (hipOccupancyMaxActiveBlocksPerMultiprocessor(&per_cu, (const void*)fwd_megakernel, NWAVES * 64, LDS_BYTES) != hipSuccess || per_cu < 1) { fprintf(stderr, "kernel_launch: occupancy query says %d\n", per_cu); per_cu = 1; }
        (void)hipGetLastError();
        grid = cus;
    }
    if (grid < 0) return;
    if (hipMemsetAsync((char*)d_ws + WS_CTL, 0, CTL_ZERO_BYTES, stream) != hipSuccess) { fprintf(stderr, "kernel_launch: memset failed\n"); return; }
    Args a{};
    for (int i = 0; i < NIN; ++i) a.in[i] = (const float*)d_in[i];
    a.out = (float*)d_out; a.ws = (unsigned char*)d_ws;
    void* kargs[] = {&a};
    hipError_t e = hipLaunchCooperativeKernel((const void*)fwd_megakernel, dim3(grid), dim3(NWAVES * 64), kargs, LDS_BYTES, stream);
    if (e != hipSuccess) fprintf(stderr, "kernel_launch: cooperative launch failed: %s (grid %d)\n", hipGetErrorString(e), grid);
}
```

```cpp
#include <hip/hip_runtime.h>
#include <hip/hip_cooperative_groups.h>
#include <cstdio>
#include <cstdint>
namespace cg = cooperative_groups;

namespace pg8 {
#define PG8_LAS __attribute__((address_space(3)))
typedef unsigned short bf16_t;
typedef short bf16x8 __attribute__((ext_vector_type(8)));
typedef float f32x4 __attribute__((ext_vector_type(4)));
typedef unsigned u32x4 __attribute__((ext_vector_type(4)));
constexpr int BM = 256, BK = 64, HALF = 128, HTB = HALF * BK * 2  , STAGE_BYTES = 8 * HTB, NXCD = 8, WGM = 8;

__host__ __device__ __forceinline__ int lds_byte(int r, int c) { const int st = (r >> 4) * 2 + (c >> 5), rr = r & 15, cc = c & 31, ob = rr * 64 + cc * 2; return st * 1024 + (ob ^ (((ob >> 9) & 1) << 5)); }
__host__ __device__ __forceinline__ void stage_rc(int b, int& R, int& C) { const int st = b / 1024, sb = b % 1024, swz = sb ^ (((sb >> 9) & 1) << 5); R = (st >> 1) * 16 + swz / 64; C = (st & 1) * 32 + (swz % 64) / 2; }
__host__ __device__ __forceinline__ int perm32(int rho) { const int n = rho >> 4, i = rho & 15; return 8 * (i >> 2) + 4 * n + (i & 3); }

struct Unit { int pm, pn, sub; };
struct Gemm { const bf16_t* A; const bf16_t* Bt; int M, N, K; };

struct StaticOrder {
    int nM, nN, nwg, G, c;
    __host__ __device__ void init(int M, int N, int G_, int c_) { nM = M / BM; nN = N / BM; nwg = nM * nN; G = G_; c = c_; }
    __host__ __device__ bool next(int i, Unit& u) const {
        const long L = (long)i * G + c; if (L >= nwg) return false;
        int wgid = (int)L; { const int q = nwg / NXCD, r = nwg % NXCD, xcd = wgid % NXCD, off = wgid / NXCD; wgid = (xcd < r ? xcd * (q + 1) : r * (q + 1) + (xcd - r) * q) + off; }
        const int nig = WGM * nN, gid = wgid / nig, fm = gid * WGM, gsz = (nM - fm) < WGM ? (nM - fm) : WGM;
        u.pm = fm + ((wgid % nig) % gsz); u.pn = (wgid % nig) / gsz; u.sub = 15; return true;
    }
    __device__ __forceinline__ void a_ready(const Unit&) const {}
    __device__ __forceinline__ void done(const Unit&) const {}
};

__device__ __forceinline__ unsigned cvt_pk_bf16(float lo, float hi) { unsigned r; asm("v_cvt_pk_bf16_f32 %0, %1, %2" : "=v"(r) : "v"(lo), "v"(hi)); return r; }
typedef float f32x2 __attribute__((ext_vector_type(2)));
struct MixedOrder {
    StaticOrder so; int nP, nQ, nNq, nMf, G, c;
    __device__ __forceinline__ void init(int Mfull, int Mquad, int N, int G_, int c_) { so.init(Mfull, N, G_, c_); nMf = Mfull / BM; nNq = N / BM; nP = nMf * nNq; nQ = (Mquad / BM) * nNq * 4; G = G_; c = c_; }
    __device__ __forceinline__ bool next(int i, Unit& u) const {
        const long L = (long)i * G + c; if (L < nP) return so.next(i, u);
        const int q = (int)(L - nP); if (q >= nQ) return false;
        const int t = q >> 2; u.sub = 1 << (q & 3); u.pn = t % nNq; u.pm = nMf + t / nNq; return true;
    }
    __device__ __forceinline__ void a_ready(const Unit&) const {}
    __device__ __forceinline__ void done(const Unit&) const {}
};
struct RangeOrder {
    int u0, u1, G2, c2;
    __device__ __forceinline__ bool next(int i, Unit& u) const { if (c2 < 0) return false; const int L = u0 + i * G2 + c2; if (L >= u1) return false; u.pm = L >> 2; u.pn = L & 3; u.sub = 15; return true; }
    __device__ __forceinline__ void a_ready(const Unit&) const {}
    __device__ __forceinline__ void done(const Unit&) const {}
};
typedef float f32x2 __attribute__((ext_vector_type(2)));
typedef __bf16 bf2_t __attribute__((ext_vector_type(2)));
typedef __bf16 bf8_t __attribute__((ext_vector_type(8)));
constexpr float RMS_EPS = 1e-6f;
__device__ __forceinline__ float ssq8(bf16x8 v, float s) {
    const bf8_t b = __builtin_bit_cast(bf8_t, v);
#pragma unroll
    for (int i = 0; i < 4; ++i) { const bf2_t p = {b[2 * i], b[2 * i + 1]}; s = __builtin_amdgcn_fdot2_f32_bf16(p, p, s, false); }
    return s;
}
__device__ __forceinline__ float ssq2(bf16x8 v, int i, float s) {
    const bf8_t b = __builtin_bit_cast(bf8_t, v); const bf2_t p = {b[2 * i], b[2 * i + 1]}; return __builtin_amdgcn_fdot2_f32_bf16(p, p, s, false);
}
__device__ __forceinline__ float sigmoid_f(float v) { return __builtin_amdgcn_rcpf(1.0f + __builtin_amdgcn_exp2f(v * -1.4426950408889634f)); }
__device__ __forceinline__ float silu_f(float v) { return v * sigmoid_f(v); }

struct EpiSwiGLU {
    static constexpr bool PERM = true, AFTER_DRAIN = false, NEED_RS = true;
    bf16_t* O; int ldc;
    __device__ __forceinline__ void operator()(const f32x4 (&acc)[2][2][4][2], const float (&rsv)[2][4], const Unit& u, int wr, int wc, int fr, int fq) const {
        const int row0 = u.pm * BM + wr * 64 + fr, col0 = u.pn * HALF + wc * 32 + 8 * fq;
#pragma unroll
        for (int ai = 0; ai < 2; ++ai)
#pragma unroll
            for (int m = 0; m < 4; ++m) { const int row = row0 + ai * HALF + m * 16; const float rs = rsv[ai][m], c1 = rs * -1.4426950408889634f, rs2 = rs * rs;
                unsigned wv[4];
#pragma unroll
                for (int n = 0; n < 2; ++n)
#pragma unroll
                    for (int j = 0; j < 4; j += 2) { const f32x2 g = {acc[ai][0][m][n][j], acc[ai][0][m][n][j + 1]}, up = {acc[ai][1][m][n][j], acc[ai][1][m][n][j + 1]};
                        const f32x2 t = g * c1; f32x2 e; e.x = __builtin_amdgcn_exp2f(t.x); e.y = __builtin_amdgcn_exp2f(t.y);
                        const f32x2 d = e + 1.0f; f32x2 r; r.x = __builtin_amdgcn_rcpf(d.x); r.y = __builtin_amdgcn_rcpf(d.y);
                        const f32x2 o = ((g * up) * rs2) * r;
                        wv[2 * n + (j >> 1)] = cvt_pk_bf16(o.x, o.y); }
                u32x4 w; w.x = wv[0]; w.y = wv[1]; w.z = wv[2]; w.w = wv[3];
                *(u32x4*)(O + (size_t)row * ldc + col0) = w; }
    }
};
template <bool RS> struct EpiScaleBf16 {
    static constexpr bool PERM = true, AFTER_DRAIN = false, NEED_RS = RS;
    bf16_t* O; int ldc;
    __device__ __forceinline__ void operator()(const f32x4 (&acc)[2][2][4][2], const float (&rsv)[2][4], const Unit& u, int wr, int wc, int fr, int fq) const {
        const int row0 = u.pm * BM + wr * 64 + fr, col0 = u.pn * BM + wc * 32 + 8 * fq;
#pragma unroll
        for (int ai = 0; ai < 2; ++ai)
#pragma unroll
            for (int m = 0; m < 4; ++m) { const int row = row0 + ai * HALF + m * 16; const float rs = RS ? rsv[ai][m] : 1.0f;
#pragma unroll
                for (int bj = 0; bj < 2; ++bj) if ((u.sub >> (2 * ai + bj)) & 1) { const f32x4 v0 = acc[ai][bj][m][0] * rs, v1 = acc[ai][bj][m][1] * rs;
                    u32x4 w; w.x = cvt_pk_bf16(v0[0], v0[1]); w.y = cvt_pk_bf16(v0[2], v0[3]); w.z = cvt_pk_bf16(v1[0], v1[1]); w.w = cvt_pk_bf16(v1[2], v1[3]);
                    *(u32x4*)(O + (size_t)row * ldc + col0 + bj * HALF) = w; } }
    }
};
template <int MODE> struct EpiResid {
    static constexpr bool PERM = true, AFTER_DRAIN = false, NEED_RS = (MODE == 1);
    bf16_t* XB; const bf16_t* XR; float scale; const bf16_t* proj;
    __device__ __forceinline__ void operator()(const f32x4 (&acc)[2][2][4][2], const float (&rsv)[2][4], const Unit& u, int wr, int wc, int fr, int fq) const {
        const int row0 = u.pm * BM + wr * 64 + fr, col0 = u.pn * BM + wc * 32 + 8 * fq;
#pragma unroll
        for (int ai = 0; ai < 2; ++ai)
#pragma unroll
            for (int m = 0; m < 4; ++m) { const int row = row0 + ai * HALF + m * 16; const float rs = (MODE == 1) ? rsv[ai][m] : 1.0f;
#pragma unroll
                for (int bj = 0; bj < 2; ++bj) if ((u.sub >> (2 * ai + bj)) & 1) { const size_t off = (size_t)row * 1024 + col0 + bj * HALF;
                    const u32x4 rw = *(const u32x4*)(XR + off);
                    f32x4 x0 = {__uint_as_float(rw.x << 16), __uint_as_float(rw.x & 0xffff0000u), __uint_as_float(rw.y << 16), __uint_as_float(rw.y & 0xffff0000u)};
                    f32x4 x1 = {__uint_as_float(rw.z << 16), __uint_as_float(rw.z & 0xffff0000u), __uint_as_float(rw.w << 16), __uint_as_float(rw.w & 0xffff0000u)};
                    if (MODE == 0) { x0 += acc[ai][bj][m][0] * scale; x1 += acc[ai][bj][m][1] * scale; }
                    else { const u32x4 pw = *(const u32x4*)(proj + off);
                        const f32x4 a0 = acc[ai][bj][m][0] * rs, a1 = acc[ai][bj][m][1] * rs;
                        x0[0] += sigmoid_f(a0[0]) * __uint_as_float(pw.x << 16); x0[1] += sigmoid_f(a0[1]) * __uint_as_float(pw.x & 0xffff0000u);
                        x0[2] += sigmoid_f(a0[2]) * __uint_as_float(pw.y << 16); x0[3] += sigmoid_f(a0[3]) * __uint_as_float(pw.y & 0xffff0000u);
                        x1[0] += sigmoid_f(a1[0]) * __uint_as_float(pw.z << 16); x1[1] += sigmoid_f(a1[1]) * __uint_as_float(pw.z & 0xffff0000u);
                        x1[2] += sigmoid_f(a1[2]) * __uint_as_float(pw.w << 16); x1[3] += sigmoid_f(a1[3]) * __uint_as_float(pw.w & 0xffff0000u); }
                    u32x4 w; w.x = cvt_pk_bf16(x0[0], x0[1]); w.y = cvt_pk_bf16(x0[2], x0[3]); w.z = cvt_pk_bf16(x1[0], x1[1]); w.w = cvt_pk_bf16(x1[2], x1[3]);
                    *(u32x4*)(XB + off) = w; }
                if ((m & 1) == 1) asm volatile("" ::: "memory"); }
    }
};

struct EpiNull { static constexpr bool PERM = true, AFTER_DRAIN = false, NEED_RS = false;
    __device__ __forceinline__ void operator()(const f32x4 (&acc)[2][2][4][2], const float (&rsv)[2][4], const Unit& u, int wr, int wc, int fr, int fq) const {
        float s = 0.f;
#pragma unroll
        for (int a = 0; a < 2; ++a) for (int b = 0; b < 2; ++b) for (int m = 0; m < 4; ++m) for (int n = 0; n < 2; ++n) s += acc[a][b][m][n][0] + acc[a][b][m][n][1] + acc[a][b][m][n][2] + acc[a][b][m][n][3];
        asm volatile("" :: "v"(s)); } };
template <class Epi, class Sched, bool ALIGN_EPI = false, bool SP2 = false>
__device__ __forceinline__ void gemm_phase(PG8_LAS unsigned char* lds, const Gemm g, const Sched& S, const Epi& E) {
    int tid_ = threadIdx.x; asm volatile("" : "+v"(tid_));
    const int tid = tid_, wid = __builtin_amdgcn_readfirstlane(tid >> 6), lane = tid & 63, wr = wid >> 2, wc = wid & 3, fr = lane & 15, fq = lane >> 4;
    int K_ = g.K; asm volatile("" : "+s"(K_));
    const int K = K_, nt = K / BK;
    unsigned voffA[2], voffB[2];
#pragma unroll
    for (int i = 0; i < 2; ++i) { int R, C; stage_rc(tid * 16 + i * 8192, R, C); const int Rb = Epi::PERM ? ((R & ~31) + perm32(R & 31)) : R;
        voffA[i] = (unsigned)(R * K + C) * 2u; voffB[i] = (unsigned)(Rb * K + C) * 2u; }
    const size_t kstep = (size_t)(BK * 2);
    const size_t hstep = (size_t)HALF * K * 2;
    const size_t tstep = 2 * hstep;
    const unsigned ldsw = (unsigned)wid * 1024u;
    const int aoff = lds_byte(wr * 64 + fr, fq * 8), boff = lds_byte(wc * 32 + fr, fq * 8);
#define PG8_SA(b, h) (((b) * 2 + (h)) * HTB)
#define PG8_SB(b, h) ((4 + (b) * 2 + (h)) * HTB)
#define PG8_STAGE(bufoff, gbase, voff) do { _Pragma("unroll") for (int _i = 0; _i < 2; ++_i) \
        __builtin_amdgcn_global_load_lds((const unsigned*)((const char*)(gbase) + (voff)[_i]), (PG8_LAS unsigned*)(lds + (bufoff) + ldsw + _i * 8192), 16, 0, 0); } while (0)
#define PG8_LDA(dst, b, h) do { _Pragma("unroll") for (int m = 0; m < 4; ++m) _Pragma("unroll") for (int k = 0; k < 2; ++k) dst[m][k] = *(const PG8_LAS bf16x8*)(lds + PG8_SA(b, h) + aoff + m * 2048 + k * 1024); } while (0)
#define PG8_LDB(dst, b, h) do { _Pragma("unroll") for (int n = 0; n < 2; ++n) _Pragma("unroll") for (int k = 0; k < 2; ++k) dst[n][k] = *(const PG8_LAS bf16x8*)(lds + PG8_SB(b, h) + boff + n * 2048 + k * 1024); } while (0)
#define PG8_MMA(ai, bj, At, Bt) do { __builtin_amdgcn_s_setprio(1); _Pragma("unroll") for (int m = 0; m < 4; ++m) _Pragma("unroll") for (int n = 0; n < 2; ++n) _Pragma("unroll") for (int k = 0; k < 2; ++k) \
        acc[ai][bj][m][n] = __builtin_amdgcn_mfma_f32_16x16x32_bf16(Bt[n][k], At[m][k], acc[ai][bj][m][n], 0, 0, 0); __builtin_amdgcn_s_setprio(0); } while (0)
#define PG8_SSQ(ai, kt) do { if constexpr (Epi::NEED_RS) { if (wc == ((kt) & 3)) { _Pragma("unroll") for (int k = 0; k < 2; ++k) _Pragma("unroll") for (int i_ = 0; i_ < 4; ++i_) _Pragma("unroll") for (int m = 0; m < 4; ++m) ssq[ai][m] = ssq2(At[m][k], i_, ssq[ai][m]); } } } while (0)
#define PG8_WAIT_V(n) asm volatile("s_waitcnt vmcnt(" #n ")" ::: "memory")
#define PG8_WAIT_L(n) asm volatile("s_waitcnt lgkmcnt(" #n ")" ::: "memory")
#define PG8_BAR __builtin_amdgcn_s_barrier()
#define PG8_SCHED __builtin_amdgcn_sched_barrier(0)
    Unit cur, nxt; int ui = 0;
    if (!S.next(0, cur)) return;
    f32x4 acc[2][2][4][2];
#pragma unroll
    for (int a = 0; a < 2; ++a)
#pragma unroll
        for (int b = 0; b < 2; ++b)
#pragma unroll
            for (int m = 0; m < 4; ++m)
#pragma unroll
                for (int n = 0; n < 2; ++n) acc[a][b][m][n] = (f32x4){0.f, 0.f, 0.f, 0.f};
    bf16x8 At[4][2], B0[2][2], B1[2][2];
    float ssq[2][4] = {{0.f, 0.f, 0.f, 0.f}, {0.f, 0.f, 0.f, 0.f}};
    static_assert(SP2 || !Epi::NEED_RS, "row statistics are gathered in the SP2 loop only");
    const char* cA = (const char*)g.A + (size_t)cur.pm * tstep; const char* cB = (const char*)g.Bt + (size_t)cur.pn * tstep;
    S.a_ready(cur);
    if constexpr (SP2) {
        PG8_STAGE(PG8_SB(0, 0), cB, voffB); PG8_STAGE(PG8_SB(0, 1), cB + hstep, voffB); PG8_STAGE(PG8_SA(0, 0), cA, voffA); PG8_STAGE(PG8_SA(0, 1), cA + hstep, voffA);
        if (wr == 1) PG8_BAR;
        PG8_WAIT_V(2); PG8_BAR;
        PG8_STAGE(PG8_SB(1, 0), cB + kstep, voffB); PG8_STAGE(PG8_SA(1, 0), cA + kstep, voffA); PG8_STAGE(PG8_SB(1, 1), cB + hstep + kstep, voffB);
        PG8_WAIT_V(6); PG8_BAR;
    } else {
        PG8_STAGE(PG8_SB(0, 0), cB, voffB); PG8_STAGE(PG8_SA(0, 0), cA, voffA); PG8_STAGE(PG8_SB(0, 1), cB + hstep, voffB); PG8_STAGE(PG8_SA(0, 1), cA + hstep, voffA);
        if (wr == 1) PG8_BAR;
        PG8_WAIT_V(4); PG8_BAR;
        PG8_STAGE(PG8_SB(1, 0), cB + kstep, voffB); PG8_STAGE(PG8_SA(1, 0), cA + kstep, voffA); PG8_STAGE(PG8_SB(1, 1), cB + hstep + kstep, voffB);
        PG8_WAIT_V(6); PG8_BAR;
    }
    for (;;) {
        const int mk = __builtin_amdgcn_readfirstlane(cur.sub);
        const bool has_next = S.next(ui + 1, nxt);
        const char* nA = has_next ? (const char*)g.A + (size_t)nxt.pm * tstep : cA; const char* nB = has_next ? (const char*)g.Bt + (size_t)nxt.pn * tstep : cB;
        for (int t = 0; t < nt; t += 2) {
            const bool last = (t == nt - 2);
            const char* a1 = cA + (size_t)(t + 1) * kstep;
            const char* a2 = last ? nA : cA + (size_t)(t + 2) * kstep; const char* b2 = last ? nB : cB + (size_t)(t + 2) * kstep;
            const char* a3 = a2 + kstep; const char* b3 = b2 + kstep;
            if (last && has_next) S.a_ready(nxt);
            if constexpr (SP2) {
            PG8_LDB(B0, 0, 0); PG8_LDB(B1, 0, 1); PG8_SCHED; PG8_LDA(At, 0, 0); PG8_STAGE(PG8_SA(1, 1), a1 + hstep, voffA);
            PG8_WAIT_V(8); PG8_WAIT_L(0); PG8_BAR; if (mk & 1) PG8_MMA(0, 0, At, B0); PG8_SSQ(0, t); if (mk & 2) PG8_MMA(0, 1, At, B1); PG8_BAR; PG8_SCHED;
            PG8_LDA(At, 0, 1); PG8_STAGE(PG8_SB(0, 0), b2, voffB); PG8_STAGE(PG8_SB(0, 1), b2 + hstep, voffB); PG8_STAGE(PG8_SA(0, 0), a2, voffA);
            PG8_WAIT_V(8); PG8_WAIT_L(0); PG8_BAR; if (mk & 4) PG8_MMA(1, 0, At, B0); PG8_SSQ(1, t); if (mk & 8) PG8_MMA(1, 1, At, B1); PG8_BAR; PG8_SCHED;
            PG8_LDB(B0, 1, 0); PG8_LDB(B1, 1, 1); PG8_SCHED; PG8_LDA(At, 1, 0); PG8_STAGE(PG8_SA(0, 1), a2 + hstep, voffA);
            PG8_WAIT_V(8); PG8_WAIT_L(0); PG8_BAR; if (mk & 1) PG8_MMA(0, 0, At, B0); PG8_SSQ(0, t + 1); if (mk & 2) PG8_MMA(0, 1, At, B1); PG8_BAR; PG8_SCHED;
            PG8_LDA(At, 1, 1); PG8_STAGE(PG8_SB(1, 0), b3, voffB); PG8_STAGE(PG8_SB(1, 1), b3 + hstep, voffB); PG8_STAGE(PG8_SA(1, 0), a3, voffA);
            PG8_WAIT_V(8); PG8_WAIT_L(0); PG8_BAR; if (mk & 4) PG8_MMA(1, 0, At, B0); PG8_SSQ(1, t + 1); if (mk & 8) PG8_MMA(1, 1, At, B1); PG8_BAR; PG8_SCHED;
            } else {
            PG8_LDB(B0, 0, 0); PG8_SCHED; PG8_LDA(At, 0, 0); PG8_STAGE(PG8_SA(1, 1), a1 + hstep, voffA);
            PG8_WAIT_L(8); PG8_BAR; PG8_WAIT_L(0); PG8_MMA(0, 0, At, B0); PG8_BAR; PG8_SCHED;
            PG8_LDB(B1, 0, 1); PG8_STAGE(PG8_SB(0, 0), b2, voffB);
            PG8_BAR; PG8_WAIT_L(0); PG8_MMA(0, 1, At, B1); PG8_BAR;
            PG8_LDA(At, 0, 1); PG8_STAGE(PG8_SA(0, 0), a2, voffA);
            PG8_BAR; PG8_WAIT_L(0); PG8_MMA(1, 0, At, B0); PG8_BAR; PG8_SCHED;
            PG8_STAGE(PG8_SB(0, 1), b2 + hstep, voffB);
            PG8_WAIT_V(6); PG8_BAR; PG8_MMA(1, 1, At, B1); PG8_BAR;
            PG8_LDB(B0, 1, 0); PG8_SCHED; PG8_LDA(At, 1, 0); PG8_STAGE(PG8_SA(0, 1), a2 + hstep, voffA);
            PG8_WAIT_L(8); PG8_BAR; PG8_WAIT_L(0); PG8_MMA(0, 0, At, B0); PG8_BAR; PG8_SCHED;
            PG8_LDB(B1, 1, 1); PG8_STAGE(PG8_SB(1, 0), b3, voffB);
            PG8_BAR; PG8_WAIT_L(0); PG8_MMA(0, 1, At, B1); PG8_BAR;
            PG8_LDA(At, 1, 1); PG8_STAGE(PG8_SA(1, 0), a3, voffA);
            PG8_BAR; PG8_WAIT_L(0); PG8_MMA(1, 0, At, B0); PG8_BAR; PG8_SCHED;
            PG8_STAGE(PG8_SB(1, 1), b3 + hstep, voffB);
            PG8_WAIT_V(6); PG8_BAR; PG8_MMA(1, 1, At, B1); PG8_BAR;
            }
        }
        if constexpr (ALIGN_EPI) { if (wr == 0) PG8_BAR; }
        { float rsv[2][4];
            if constexpr (Epi::NEED_RS) {
                static_assert(ALIGN_EPI, "the row-statistics exchange needs both halves at the same barrier");
                PG8_LAS float* rst = (PG8_LAS float*)(lds + STAGE_BYTES + 1024);
#pragma unroll
                for (int a = 0; a < 2; ++a)
#pragma unroll
                    for (int m = 0; m < 4; ++m) { float q = ssq[a][m]; q += __shfl_xor(q, 16); q += __shfl_xor(q, 32); if (fq == 0) rst[wc * 256 + a * HALF + wr * 64 + m * 16 + fr] = q; ssq[a][m] = 0.f; }
                PG8_WAIT_L(0); PG8_BAR; asm volatile("" ::: "memory");
#pragma unroll
                for (int a = 0; a < 2; ++a)
#pragma unroll
                    for (int m = 0; m < 4; ++m) { const int r_ = a * HALF + wr * 64 + m * 16 + fr; const float q = (rst[r_] + rst[256 + r_]) + (rst[512 + r_] + rst[768 + r_]);
                        rsv[a][m] = __builtin_amdgcn_rsqf(q * (1.0f / 1024.0f) + RMS_EPS); }
            } else {
#pragma unroll
                for (int a = 0; a < 2; ++a)
#pragma unroll
                    for (int m = 0; m < 4; ++m) rsv[a][m] = 1.0f;
            }
            E(acc, rsv, cur, wr, wc, fr, fq); S.done(cur); }
        if (!has_next) break;
#pragma unroll
        for (int a = 0; a < 2; ++a)
#pragma unroll
            for (int b = 0; b < 2; ++b)
#pragma unroll
                for (int m = 0; m < 4; ++m)
#pragma unroll
                    for (int n = 0; n < 2; ++n) acc[a][b][m][n] = (f32x4){0.f, 0.f, 0.f, 0.f};
        cur = nxt; cA = nA; cB = nB; ++ui;
        if constexpr (ALIGN_EPI) { if (wr == 1) PG8_BAR; }
    }
    PG8_WAIT_V(0);
    if constexpr (!ALIGN_EPI) { if (wr == 0) PG8_BAR; }
    PG8_BAR;
#undef PG8_SA
#undef PG8_SB
#undef PG8_STAGE
#undef PG8_LDA
#undef PG8_LDB
#undef PG8_MMA
#undef PG8_SSQ
#undef PG8_WAIT_V
#undef PG8_WAIT_L
#undef PG8_BAR
#undef PG8_SCHED
}
}
constexpr int NWAVES = 8;
constexpr int D = 1024, FF = 2816, NGU = 2 * FF, MIXW = 2048, DPLE = 256, DEPTH = 2;
constexpr int BATCH = 8, SEQ = 2048, DECB = 128, DECS = 8;
constexpr int MP = BATCH * SEQ, MS = DECB * DECS, M = MP + MS;
constexpr int NIN = 33;
constexpr size_t MiB = 1u << 20;
constexpr size_t WS_CTL = 0, CTL_ZERO_BYTES = 64 * 1024;
constexpr size_t WS_W = 1 * MiB;
constexpr size_t W_GU = (size_t)NGU * D * 2, W_DN = (size_t)D * FF * 2, W_MI = (size_t)MIXW * D * 2, W_MO = (size_t)D * D * 2, W_PG = (size_t)D * D * 2, W_PP = (size_t)D * DPLE * 2;
constexpr size_t WO_GU1 = 0, WO_D1 = WO_GU1 + W_GU, WO_MI = WO_D1 + W_DN, WO_MO = WO_MI + W_MI, WO_GU2 = WO_MO + W_MO, WO_D2 = WO_GU2 + W_GU, WO_PG = WO_D2 + W_DN, WO_PP = WO_PG + W_PG, W_LAYER = WO_PP + W_PP;
constexpr size_t WS_BUFA = WS_W + DEPTH * W_LAYER;
constexpr size_t BUF_BYTES = (size_t)M * D * 2;
constexpr size_t WS_BUFB = WS_BUFA + BUF_BYTES;
constexpr size_t WS_PB = WS_BUFB + BUF_BYTES;
constexpr size_t WS_ACT = WS_PB + (size_t)DEPTH * M * DPLE * 2;
constexpr size_t WS_END = WS_ACT + (size_t)M * FF * 2;
static_assert(WS_W % 256 == 0 && W_LAYER % 256 == 0 && WS_BUFA % 256 == 0 && WS_PB % 256 == 0 && WS_ACT % 256 == 0, "alignment");
constexpr int CW_BAR = 1024;
constexpr int RING_OFF = 0, RING_BYTES = 131072;
constexpr int LDSCTL_OFF = RING_BYTES, MISC_OFF = LDSCTL_OFF + 320;
constexpr int LDS_BYTES = 147456;
#define GAS __attribute__((address_space(1)))
#define LAS __attribute__((address_space(3)))
typedef unsigned short bf16;
typedef unsigned v4u __attribute__((ext_vector_type(4)));
typedef float f32x4 __attribute__((ext_vector_type(4)));
typedef short bf16x8 __attribute__((ext_vector_type(8)));
typedef GAS unsigned gu32;
typedef GAS unsigned long long gu64;
#define RLX_AGENT __ATOMIC_RELAXED, __HIP_MEMORY_SCOPE_AGENT
#define LDS_WAIT() asm volatile("s_waitcnt lgkmcnt(0)" ::: "memory")
#define VM_WAIT() asm volatile("s_waitcnt vmcnt(0)" ::: "memory")
__device__ __forceinline__ unsigned long long rt() { return __builtin_amdgcn_s_memrealtime(); }
__device__ __forceinline__ unsigned pk2(float lo, float hi) { unsigned r; asm("v_cvt_pk_bf16_f32 %0, %1, %2" : "=v"(r) : "v"(lo), "v"(hi)); return r; }
__device__ __forceinline__ unsigned f2bf(float f) { return pk2(f, f) & 0xffffu; }
#define XB_TMO      128
#define XB_XCNT(j)  (256  + 64 * (j))
#define XB_XSUB(j)  (1280 + 64 * (j))
#define XB_XGEN(j)  (2304 + 64 * (j))
#define XB_TOP      3328
#define XB_TOPGEN   3392
#define XCD_BAR_WORDS 3456
#define XB_SPIN_CAP (1u << 18)

__device__ __forceinline__ unsigned xb_ld(unsigned* p)              { return __hip_atomic_load(p, __ATOMIC_RELAXED, __HIP_MEMORY_SCOPE_AGENT); }
__device__ __forceinline__ unsigned xb_add(unsigned* p, unsigned v) { return __hip_atomic_fetch_add(p, v, __ATOMIC_RELAXED, __HIP_MEMORY_SCOPE_AGENT); }
__device__ __forceinline__ unsigned xb_xcc_id() { return (unsigned)__builtin_amdgcn_s_getreg((3 << 11) | 20) & 0xFu; }
#define XB_SPIN(cond, bar) do { unsigned _sp = 0; while (cond) { __builtin_amdgcn_s_sleep(1); \
    if ((++_sp & 255u) == 0u) { if (xb_ld(&(bar)[XB_TMO])) break; if (_sp > XB_SPIN_CAP) { atomicAdd(&(bar)[XB_TMO], 1u); break; } } } } while (0)

struct XcdBarrier {
    unsigned* bar; unsigned x;
    volatile LAS unsigned* st;
};

__device__ __forceinline__ XcdBarrier xcd_barrier_post(unsigned* bar, volatile LAS unsigned* st) {
    XcdBarrier b; b.bar = bar; b.x = xb_xcc_id(); b.st = st;
    if (threadIdx.x == 0) st[4] = xb_add(&bar[XB_XCNT(b.x)], 1u);
    return b;
}
__device__ __forceinline__ void xcd_barrier_complete(unsigned* bar, unsigned x, unsigned& nloc, unsigned& nx) {
    const unsigned G = gridDim.x * gridDim.y * gridDim.z;
    unsigned sum, cnt, mine, sp = 0u;
    for (;;) {
        sum = 0u; cnt = 0u; mine = 0u;
#pragma nounroll
        for (unsigned j = 0; j < 16; ++j) { const unsigned c = xb_ld(&bar[XB_XCNT(j)]); sum += c; cnt += (c > 0u) ? 1u : 0u; mine = (j == x) ? c : mine; }
        if (sum == G) break;
        __builtin_amdgcn_s_sleep(1);
        if ((++sp & 255u) == 0u) { if (xb_ld(&bar[XB_TMO])) break; if (sp > XB_SPIN_CAP) { atomicAdd(&bar[XB_TMO], 1u); break; } }
    }
    nloc = mine > 0u ? mine : 1u; nx = cnt > 0u ? cnt : 1u;
}

__device__ __forceinline__ void xcd_barrier(const XcdBarrier& b) {
    asm volatile("s_waitcnt vmcnt(0)" ::: "memory");
    __syncthreads();
    if (threadIdx.x == 0) {
        unsigned* bar = b.bar; const unsigned bx_ = xb_xcc_id();
        __builtin_amdgcn_s_waitcnt(0);
        unsigned nloc = b.st[0], nx = b.st[1];
        if (nloc == 0u) { xcd_barrier_complete(bar, bx_, nloc, nx); b.st[0] = nloc; b.st[1] = nx; }
        asm volatile("buffer_inv sc1" ::: "memory");
        const unsigned old = xb_add(&bar[XB_XSUB(bx_)], 1u);
        const unsigned gen = old / nloc;
        if (old + 1u == (gen + 1u) * nloc) {
            __builtin_amdgcn_fence(__ATOMIC_RELEASE, "agent");
            asm volatile("s_waitcnt vmcnt(0)" ::: "memory");
            const unsigned og = xb_add(&bar[XB_TOP], 1u);
            const unsigned tg = og / nx;
            if (og + 1u == (tg + 1u) * nx) xb_add(&bar[XB_TOPGEN], 1u);
            else XB_SPIN(xb_ld(&bar[XB_TOPGEN]) == tg, bar);
            asm volatile("" ::: "memory");
            xb_add(&bar[XB_XGEN(bx_)], 1u);
            asm volatile("s_waitcnt vmcnt(0)" ::: "memory");
        } else {
            XB_SPIN(xb_ld(&bar[XB_XGEN(bx_)]) == gen, bar);
            asm volatile("" ::: "memory");
            asm volatile("s_waitcnt vmcnt(0)" ::: "memory");
        }
    }
    __syncthreads();
}

__device__ __forceinline__ int opaque_s(int v) { asm volatile("" : "+s"(v)); return v; }
struct Args { const float* in[NIN]; float* out; unsigned char* ws; };
struct Frame {
    LAS unsigned char* lds;
    int tid, lane, wave, vcu, G;
};
template <int CTRL> __device__ __forceinline__ float dpp_add(float v) {
    const int vi = __builtin_bit_cast(int, v);
    return v + __builtin_bit_cast(float, __builtin_amdgcn_update_dpp(vi, vi, CTRL, 0xF, 0xF, false));
}
__device__ __forceinline__ float wave_sum(float v) {
    v = dpp_add<0xB1>(v); v = dpp_add<0x4E>(v); v = dpp_add<0x141>(v); v = dpp_add<0x140>(v);
    v = dpp_add<0x142>(v);
    v = dpp_add<0x143>(v);
    return __builtin_bit_cast(float, __builtin_amdgcn_readlane(__builtin_bit_cast(int, v), 63));
}
#define WS4_STEP(ctl) "v_add_f32_dpp %0, %0, %0 " ctl " row_mask:0xf bank_mask:0xf\n\tv_add_f32_dpp %1, %1, %1 " ctl " row_mask:0xf bank_mask:0xf\n\tv_add_f32_dpp %2, %2, %2 " ctl " row_mask:0xf bank_mask:0xf\n\tv_add_f32_dpp %3, %3, %3 " ctl " row_mask:0xf bank_mask:0xf\n\t"
__device__ __forceinline__ void wave_sum4(float& a, float& b, float& c, float& d) {
    asm volatile("s_nop 1\n\t" WS4_STEP("quad_perm:[1,0,3,2]") WS4_STEP("quad_perm:[2,3,0,1]") WS4_STEP("row_half_mirror") WS4_STEP("row_mirror") WS4_STEP("row_bcast:15") WS4_STEP("row_bcast:31") "s_nop 1"
                 : "+v"(a), "+v"(b), "+v"(c), "+v"(d));
    a = __builtin_bit_cast(float, __builtin_amdgcn_readlane(__builtin_bit_cast(int, a), 63)); b = __builtin_bit_cast(float, __builtin_amdgcn_readlane(__builtin_bit_cast(int, b), 63));
    c = __builtin_bit_cast(float, __builtin_amdgcn_readlane(__builtin_bit_cast(int, c), 63)); d = __builtin_bit_cast(float, __builtin_amdgcn_readlane(__builtin_bit_cast(int, d), 63));
}
__device__ __forceinline__ void ln8_stats(const float (&v)[8], float (&mean)[8], float (&rstd)[8], float eps) {
    float s[8];
#pragma unroll
    for (int r = 0; r < 8; ++r) s[r] = v[r];
    wave_sum4(s[0], s[1], s[2], s[3]); wave_sum4(s[4], s[5], s[6], s[7]);
#pragma unroll
    for (int r = 0; r < 8; ++r) { mean[r] = s[r] * (1.f / 64.f); const float dv = v[r] - mean[r]; s[r] = dv * dv; }
    wave_sum4(s[0], s[1], s[2], s[3]); wave_sum4(s[4], s[5], s[6], s[7]);
#pragma unroll
    for (int r = 0; r < 8; ++r) rstd[r] = __builtin_amdgcn_rsqf(s[r] * (1.f / 64.f) + eps);
}
__device__ __forceinline__ float bf2f(bf16 v) { return __uint_as_float((unsigned)v << 16); }
__device__ __forceinline__ float gelu_tanh(float v) {
    const float t = 1.5957691216057308f * (v + 0.044715f * v * v * v);
    return v * __builtin_amdgcn_rcpf(1.0f + __builtin_amdgcn_exp2f(t * -1.4426950408889634f));
}
__device__ __forceinline__ void p0_transpose_item(const float* W, int K, int N, bf16* WT, const float* gain, int mode, LAS float* scr, int item, int lane) {
    const int nblk = N / 64, kb = item / nblk, nb = item % nblk, k0 = 32 * kb, n0 = 64 * nb;
    const int c4 = (lane & 15) * 4, kq = lane >> 4;
    f32x4 v[8];
#pragma unroll
    for (int i = 0; i < 8; ++i) v[i] = __builtin_nontemporal_load((const f32x4*)(W + (size_t)(k0 + 4 * i + kq) * N + n0 + c4));
#pragma unroll
    for (int i = 0; i < 8; ++i) { const int kk = 4 * i + kq; const float g = gain ? gain[k0 + kk] : 1.0f; LAS float* s = scr + kk * 65 + c4;
        s[0] = v[i].x * g; s[1] = v[i].y * g; s[2] = v[i].z * g; s[3] = v[i].w * g; }
    LDS_WAIT(); asm volatile("" ::: "memory");
    const int c = lane & 3;
    const int rbase = (mode == 0) ? n0 : (256 * (n0 >> 7) + (n0 & 127) + (mode == 2 ? 128 : 0));
#pragma unroll
    for (int j = 0; j < 4; ++j) { const int n = (lane >> 2) + 16 * j; const LAS float* s = scr + (8 * c) * 65 + n;
        v4u o; o.x = pk2(s[0 * 65], s[1 * 65]); o.y = pk2(s[2 * 65], s[3 * 65]); o.z = pk2(s[4 * 65], s[5 * 65]); o.w = pk2(s[6 * 65], s[7 * 65]);
        *(GAS v4u*)(WT + (size_t)(rbase + n) * K + k0 + 8 * c) = o; }
    LDS_WAIT(); asm volatile("" ::: "memory");
}
__device__ __forceinline__ void p0_prologue(Frame& F, const Args& args) {
    LAS float* scr = (LAS float*)(F.lds + RING_OFF + F.wave * 16384);
    const int gw = F.vcu * NWAVES + F.wave, NGW = F.G * NWAVES;
    unsigned char* ws = args.ws;
    constexpr int I_GU = (D / 32) * (FF / 64), I_DN = (FF / 32) * (D / 64), I_MI = (D / 32) * (MIXW / 64), I_SQ = (D / 32) * (D / 64), I_PP = (DPLE / 32) * (D / 64);
    constexpr int I_LAYER = 6 * I_GU + I_MI + 2 * I_SQ + I_PP;
    static_assert(I_DN == I_GU, "item counts");
    for (int it = gw; it < DEPTH * I_LAYER; it += NGW) {
        const int li = it / I_LAYER; int r = it % I_LAYER;
        unsigned char* wl = ws + WS_W + (size_t)li * W_LAYER;
        if (r < I_GU) { p0_transpose_item(args.in[opaque_s(8)] + (size_t)li * D * FF, D, FF, (bf16*)(wl + WO_GU1), args.in[opaque_s(7)] + li * D, 1, scr, r, F.lane); continue; } r -= I_GU;
        if (r < I_GU) { p0_transpose_item(args.in[opaque_s(9)] + (size_t)li * D * FF, D, FF, (bf16*)(wl + WO_GU1), args.in[opaque_s(7)] + li * D, 2, scr, r, F.lane); continue; } r -= I_GU;
        if (r < I_GU) { p0_transpose_item(args.in[opaque_s(10)] + (size_t)li * D * FF, FF, D, (bf16*)(wl + WO_D1), nullptr, 0, scr, r, F.lane); continue; } r -= I_GU;
        if (r < I_GU) { p0_transpose_item(args.in[opaque_s(26)] + (size_t)li * D * FF, D, FF, (bf16*)(wl + WO_GU2), args.in[opaque_s(25)] + li * D, 1, scr, r, F.lane); continue; } r -= I_GU;
        if (r < I_GU) { p0_transpose_item(args.in[opaque_s(27)] + (size_t)li * D * FF, D, FF, (bf16*)(wl + WO_GU2), args.in[opaque_s(25)] + li * D, 2, scr, r, F.lane); continue; } r -= I_GU;
        if (r < I_GU) { p0_transpose_item(args.in[opaque_s(28)] + (size_t)li * D * FF, FF, D, (bf16*)(wl + WO_D2), nullptr, 0, scr, r, F.lane); continue; } r -= I_GU;
        if (r < I_MI) { p0_transpose_item(args.in[opaque_s(12)] + (size_t)li * D * MIXW, D, MIXW, (bf16*)(wl + WO_MI), args.in[opaque_s(11)] + li * D, 0, scr, r, F.lane); continue; } r -= I_MI;
        if (r < I_SQ) { p0_transpose_item(args.in[opaque_s(24)] + (size_t)li * D * D, D, D, (bf16*)(wl + WO_MO), nullptr, 0, scr, r, F.lane); continue; } r -= I_SQ;
        if (r < I_SQ) { p0_transpose_item(args.in[opaque_s(30)] + (size_t)li * D * D, D, D, (bf16*)(wl + WO_PG), args.in[opaque_s(29)] + li * D, 0, scr, r, F.lane); continue; } r -= I_SQ;
        p0_transpose_item(args.in[opaque_s(31)] + (size_t)li * DPLE * D, DPLE, D, (bf16*)(wl + WO_PP), nullptr, 0, scr, r, F.lane);
    }
    float* X = args.out; bf16* XB = (bf16*)(ws + WS_BUFA);
    for (int m = gw; m < M; m += NGW) {
        const float* src = (m < MP) ? args.in[opaque_s(0)] + (size_t)m * D : args.in[opaque_s(1)] + (size_t)(m - MP) * D;
        const GAS f32x4* xr = (const GAS f32x4*)src + F.lane; GAS f32x4* xo = (GAS f32x4*)(X + (size_t)m * D) + F.lane;
        GAS unsigned long long* o8 = (GAS unsigned long long*)(XB + (size_t)m * D) + F.lane;
#pragma unroll
        for (int j = 0; j < 4; ++j) { const f32x4 v = xr[64 * j];
            o8[64 * j] = (unsigned long long)pk2(v.x, v.y) | ((unsigned long long)pk2(v.z, v.w) << 32); }
    }
    bf16* PB = (bf16*)(ws + WS_PB);
    for (int q = gw; q < DEPTH * M; q += NGW) {
        const int li = q / M, m = q % M;
        const float* src = (m < MP) ? args.in[opaque_s(2)] + ((size_t)li * MP + m) * DPLE : args.in[opaque_s(3)] + ((size_t)li * MS + (m - MP)) * DPLE;
        const f32x4 v = ((const GAS f32x4*)src)[F.lane];
        ((GAS unsigned long long*)(PB + (size_t)q * DPLE))[F.lane] = (unsigned long long)pk2(v.x, v.y) | ((unsigned long long)pk2(v.z, v.w) << 32);
    }
}
__device__ __forceinline__ void final_norm(Frame& F, const Args& args, const bf16* XBF) {
    const int gw = F.vcu * NWAVES + F.wave, NGW = F.G * NWAVES;
    float* Y = args.out; const float* g = args.in[opaque_s(32)];
    f32x4 gv[4];
#pragma unroll
    for (int j = 0; j < 4; ++j) gv[j] = ((const GAS f32x4*)g)[4 * F.lane + j];
    for (int m = gw; m < M; m += NGW) {
        const GAS v4u* xr = (const GAS v4u*)(XBF + (size_t)m * D) + 2 * F.lane;
        const v4u r0 = xr[0], r1 = xr[1];
        f32x4 v[4];
        v[0] = (f32x4){__uint_as_float(r0.x << 16), __uint_as_float(r0.x & 0xffff0000u), __uint_as_float(r0.y << 16), __uint_as_float(r0.y & 0xffff0000u)};
        v[1] = (f32x4){__uint_as_float(r0.z << 16), __uint_as_float(r0.z & 0xffff0000u), __uint_as_float(r0.w << 16), __uint_as_float(r0.w & 0xffff0000u)};
        v[2] = (f32x4){__uint_as_float(r1.x << 16), __uint_as_float(r1.x & 0xffff0000u), __uint_as_float(r1.y << 16), __uint_as_float(r1.y & 0xffff0000u)};
        v[3] = (f32x4){__uint_as_float(r1.z << 16), __uint_as_float(r1.z & 0xffff0000u), __uint_as_float(r1.w << 16), __uint_as_float(r1.w & 0xffff0000u)};
        float s_ = 0.f;
#pragma unroll
        for (int j = 0; j < 4; ++j) s_ += (v[j].x * v[j].x + v[j].y * v[j].y) + (v[j].z * v[j].z + v[j].w * v[j].w);
        const float rs = __builtin_amdgcn_rsqf(wave_sum(s_) * (1.0f / D) + pg8::RMS_EPS);
        GAS f32x4* yo = (GAS f32x4*)(Y + (size_t)m * D) + 4 * F.lane;
#pragma unroll
        for (int j = 0; j < 4; ++j) yo[j] = v[j] * rs * gv[j];
    }
}
constexpr size_t O_Y = 0, O_CA_P = (size_t)M * D, O_CA_S = O_CA_P + (size_t)DEPTH * BATCH * 30 * 256, O_PL_P = O_CA_S + (size_t)DEPTH * DECB * 30 * 256,
                 O_PL_S = O_PL_P + (size_t)DEPTH * BATCH * 15 * 256, O_SC_P = O_PL_S + (size_t)DEPTH * DECB * 15 * 256, O_SC_S = O_SC_P + (size_t)DEPTH * BATCH * 2 * 256,
                 O_CV_S = O_SC_S + (size_t)DEPTH * DECB * 2 * 256, O_END = O_CV_S + (size_t)DEPTH * DECB * DECS * 256;
constexpr float LN_EPS = 1e-6f;
constexpr int VNT_OFF = 0, VNT_PITCH = 272, WPT_OFF = 64 * VNT_PITCH, WPT_PITCH = 144, DT_OFF = WPT_OFF + 64 * WPT_PITCH, DT_PITCH = 144;
struct MixP { const bf16* Z; bf16* MIX; const float *caw, *cab, *nag, *nab, *pw, *ps, *sng, *snb, *sw, *sb, *scw; float* out; int li; const float *st_a, *st_p, *st_s; };
#define OPAQUE_S(p) asm volatile("" : "+s"(p))
template <class T> __device__ __forceinline__ T* uni_ptr(T* p) {
    const unsigned long long v = (unsigned long long)p; const unsigned lo = __builtin_amdgcn_readfirstlane((unsigned)v), hi = __builtin_amdgcn_readfirstlane((unsigned)(v >> 32));
    return (T*)(((unsigned long long)hi << 32) | lo); }
__device__ __forceinline__ bf16 f2bf16(float f) { return (bf16)f2bf(f); }
__device__ __forceinline__ float pool_sel(int h, float s2, float s4, float s8, float s16) { return h == 0 ? s2 : (h == 1 ? s4 : (h == 2 ? s8 : s16)); }

__device__ __forceinline__ void mix_prompt_unit(Frame& F, const MixP& P, int b, int c, int h) {
    const int w = F.wave, lane = F.lane, ch = h * 64 + lane, fr = lane & 15, fq = lane >> 4;
    const int tb = __builtin_amdgcn_readfirstlane(128 * c + 16 * w);
    const bf16* Zs = uni_ptr(P.Z + (size_t)b * SEQ * MIXW);
    bf16* Ms = uni_ptr(P.MIX + (size_t)b * SEQ * D);
    const int li = P.li;
    { const int n = F.tid & 63, kg = F.tid >> 6; const float* src = P.pw + (size_t)h * 4096 + (size_t)(8 * kg) * 64 + n;
      v4u o; o.x = pk2(src[0], src[64]); o.y = pk2(src[128], src[192]); o.z = pk2(src[256], src[320]); o.w = pk2(src[384], src[448]);
      *(LAS v4u*)(F.lds + WPT_OFF + n * WPT_PITCH + kg * 16) = o; }
    {
        float wA[31];
        { const float* wp = P.caw;
#pragma unroll
        for (int k = 0; k < 31; ++k) { wA[k] = wp[ch]; wp += 256; OPAQUE_S(wp); } }
        float ext[46];
        { const bf16* zp = uni_ptr(Zs + ((ptrdiff_t)(tb - 30) * MIXW));
#pragma unroll
        for (int j = 0; j < 46; ++j) { const bool ok = (tb - 30 + j) >= 0; const bf16* zq = ok ? zp : Zs; const float msk = ok ? 1.f : 0.f;
            const float av = bf2f(zq[ch]), ag = bf2f(zq[256 + ch]); ext[j] = av * pg8::sigmoid_f(ag) * msk; zp += MIXW; OPAQUE_S(zp); } }
        const float bias = P.cab[ch], g = P.nag[ch], nb = P.nab[ch];
        bf16* mp = uni_ptr(Ms + (size_t)tb * D);
        float* sp = uni_ptr(P.out + O_CA_P + ((ptrdiff_t)(li * BATCH + b) * 30 + (tb - (SEQ - 30))) * 256);
#pragma unroll
        for (int r = 0; r < 16; ++r) { float cv = bias;
#pragma unroll
            for (int k = 0; k < 31; ++k) cv += wA[k] * ext[r + k];
            const float mean = wave_sum(cv) * (1.f / 64.f), dv = cv - mean, var = wave_sum(dv * dv) * (1.f / 64.f);
            const float y = dv * __builtin_amdgcn_rsqf(var + LN_EPS) * g + nb;
            mp[ch] = f2bf16(pg8::silu_f(y)); mp += D; OPAQUE_S(mp);
            if (c == 15 && tb + r >= SEQ - 30) sp[ch] = ext[r + 30];
            sp += 256; OPAQUE_S(sp); }
    }
    {
        float ze[31];
        { const bf16* zp = uni_ptr(Zs + ((ptrdiff_t)(tb - 15) * MIXW));
#pragma unroll
        for (int j = 0; j < 31; ++j) { const bool ok = (tb - 15 + j) >= 0; const bf16* zq = ok ? zp : Zs; ze[j] = bf2f(zq[512 + ch]) * (ok ? 1.f : 0.f); zp += MIXW; OPAQUE_S(zp); } }
        float* sp = uni_ptr(P.out + O_PL_P + ((ptrdiff_t)(li * BATCH + b) * 15 + (tb - (SEQ - 15))) * 256);
        LAS unsigned char* dT = F.lds + DT_OFF + w * 16 * DT_PITCH;
        const int win = 2 << h;
#pragma unroll
        for (int r = 0; r < 16; ++r) { const float zc = ze[r + 15];
            const float s2 = zc + ze[r + 14], s4 = s2 + (ze[r + 13] + ze[r + 12]), s8 = s4 + ((ze[r + 11] + ze[r + 10]) + (ze[r + 9] + ze[r + 8]));
            const float s16 = s8 + (((ze[r + 7] + ze[r + 6]) + (ze[r + 5] + ze[r + 4])) + ((ze[r + 3] + ze[r + 2]) + (ze[r + 1] + ze[r])));
            const int t = tb + r; const float cnt = (float)((t + 1 < win) ? t + 1 : win);
            const float d = pool_sel(h, s2, s4, s8, s16) / cnt - zc;
            *(LAS bf16*)(dT + r * DT_PITCH + lane * 2) = f2bf16(d);
            if (c == 15 && t >= SEQ - 15) sp[ch] = zc;
            sp += 256; OPAQUE_S(sp); }
    }
    __syncthreads();
    {
        const LAS unsigned char* dT = F.lds + DT_OFF + w * 16 * DT_PITCH;
        const bf16x8 b0 = *(const LAS bf16x8*)(dT + fr * DT_PITCH + (fq * 8) * 2), b1 = *(const LAS bf16x8*)(dT + fr * DT_PITCH + (32 + fq * 8) * 2);
#pragma unroll
        for (int nt = 0; nt < 4; ++nt) {
            const LAS unsigned char* wp = F.lds + WPT_OFF + (16 * nt + fr) * WPT_PITCH;
            const bf16x8 a0 = *(const LAS bf16x8*)(wp + (fq * 8) * 2), a1 = *(const LAS bf16x8*)(wp + (32 + fq * 8) * 2);
            f32x4 acc = {0.f, 0.f, 0.f, 0.f};
            acc = __builtin_amdgcn_mfma_f32_16x16x32_bf16(a0, b0, acc, 0, 0, 0);
            acc = __builtin_amdgcn_mfma_f32_16x16x32_bf16(a1, b1, acc, 0, 0, 0);
            const int n = 16 * nt + 4 * fq; const f32x4 sc = *(const f32x4*)(P.ps + h * 64 + n);
            const unsigned lo = pk2(acc[0] * sc[0], acc[1] * sc[1]), hi = pk2(acc[2] * sc[2], acc[3] * sc[3]);
            *(GAS unsigned long long*)(Ms + (size_t)(tb + fr) * D + 256 + h * 64 + n) = (unsigned long long)lo | ((unsigned long long)hi << 32);
        }
    }
    {
        const float g = P.sng[ch], nb = P.snb[ch];
        unsigned pk[8];
        const bf16* zp = uni_ptr(Zs + (size_t)tb * MIXW);
#pragma unroll
        for (int r = 0; r < 16; r += 2) { float vn[2];
#pragma unroll
            for (int q = 0; q < 2; ++q) { const float v = gelu_tanh(bf2f(zp[1024 + ch])); zp += MIXW; OPAQUE_S(zp);
                const float mean = wave_sum(v) * (1.f / 64.f), dv = v - mean, var = wave_sum(dv * dv) * (1.f / 64.f);
                vn[q] = dv * __builtin_amdgcn_rsqf(var + LN_EPS) * g + nb; }
            pk[r >> 1] = pk2(vn[0], vn[1]); }
        LAS unsigned char* vt = F.lds + VNT_OFF + lane * VNT_PITCH + (16 * w) * 2;
        *(LAS v4u*)(vt) = (v4u){pk[0], pk[1], pk[2], pk[3]}; *(LAS v4u*)(vt + 16) = (v4u){pk[4], pk[5], pk[6], pk[7]};
    }
    __syncthreads();
    {
        const int nks = (w >> 1) + 1, tl = 16 * w + fr;
        const float* wrow = P.sw + ((size_t)h * 128 + tl) * 128;
        bf16x8 bw[4];
#pragma unroll
        for (int ks = 0; ks < 4; ++ks) { bf16x8 t = {0, 0, 0, 0, 0, 0, 0, 0};
            if (ks < nks) { const int s0 = 32 * ks + 8 * fq; const f32x4 a = *(const f32x4*)(wrow + s0), bq = *(const f32x4*)(wrow + s0 + 4);
                float e[8] = {a[0], a[1], a[2], a[3], bq[0], bq[1], bq[2], bq[3]};
#pragma unroll
                for (int j = 0; j < 8; ++j) t[j] = (short)f2bf((s0 + j <= tl) ? e[j] : 0.f); }
            bw[ks] = t; }
        const float bsv = P.sb[h * 128 + tl];
#pragma unroll
        for (int ct = 0; ct < 4; ++ct) {
            const LAS unsigned char* vp = F.lds + VNT_OFF + (16 * ct + fr) * VNT_PITCH + (8 * fq) * 2;
            f32x4 acc = {0.f, 0.f, 0.f, 0.f};
#pragma unroll
            for (int ks = 0; ks < 4; ++ks) if (ks < nks) acc = __builtin_amdgcn_mfma_f32_16x16x32_bf16(*(const LAS bf16x8*)(vp + 64 * ks), bw[ks], acc, 0, 0, 0);
            const int cc = h * 64 + 16 * ct + 4 * fq; const size_t ro = (size_t)(tb + fr);
            const unsigned long long uw = *(const GAS unsigned long long*)(Zs + ro * MIXW + 768 + cc);
            const float u0 = gelu_tanh(__uint_as_float((unsigned)uw << 16)), u1 = gelu_tanh(__uint_as_float((unsigned)uw & 0xffff0000u));
            const float u2 = gelu_tanh(__uint_as_float((unsigned)(uw >> 32) << 16)), u3 = gelu_tanh(__uint_as_float((unsigned)(uw >> 32) & 0xffff0000u));
            const unsigned lo = pk2(u0 * (acc[0] + bsv), u1 * (acc[1] + bsv)), hi = pk2(u2 * (acc[2] + bsv), u3 * (acc[3] + bsv));
            *(GAS unsigned long long*)(Ms + ro * D + 512 + cc) = (unsigned long long)lo | ((unsigned long long)hi << 32);
        }
    }
    {
        float q[18], bg[16];
        { const bf16* zp = uni_ptr(Zs + ((ptrdiff_t)(tb - 2) * MIXW));
#pragma unroll
        for (int j = 0; j < 18; ++j) { const bool ok = (tb - 2 + j) >= 0; const bf16* zq = ok ? zp : Zs; q[j] = bf2f(zq[1536 + ch]) * bf2f(zq[1792 + ch]) * (ok ? 1.f : 0.f);
            if (j >= 2) bg[j - 2] = bf2f(zq[1280 + ch]);
            zp += MIXW; OPAQUE_S(zp); } }
        const float w0 = P.scw[ch], w1 = P.scw[256 + ch], w2 = P.scw[512 + ch];
        bf16* mp = uni_ptr(Ms + (size_t)tb * D);
        float* sp = uni_ptr(P.out + O_SC_P + ((ptrdiff_t)(li * BATCH + b) * 2 + (tb - (SEQ - 2))) * 256);
#pragma unroll
        for (int r = 0; r < 16; ++r) { const int t = tb + r; const float y = w0 * q[r] + w1 * q[r + 1] + w2 * q[r + 2];
            mp[768 + ch] = f2bf16(bg[r] * y); mp += D; OPAQUE_S(mp);
            if (c == 15 && t >= SEQ - 2) sp[ch] = q[r + 2];
            sp += 256; OPAQUE_S(sp); }
    }
    __syncthreads();
}
constexpr int SB01_OFF = 0, SB2_OFF = 24064, SB345_OFF = 34176, SB67_OFF = 58752, VNT2_OFF = 75648, WPT2_OFF = 93056, DT2_OFF = 102272;
__device__ __forceinline__ void mix_prompt_unit2(Frame& F, const MixP& P, int b, int c, int h) {
    const int w = F.wave, lane = F.lane, tid = F.tid, ch = h * 64 + lane, fr = lane & 15, fq = lane >> 4, li = P.li;
    const bf16* Zs = uni_ptr(P.Z + (size_t)b * SEQ * MIXW);
    bf16* Ms = uni_ptr(P.MIX + (size_t)b * SEQ * D);
    LAS unsigned char* L = F.lds;
    const v4u zero4 = {0u, 0u, 0u, 0u};
    { const int n = tid & 63, kg = tid >> 6; const float* src = P.pw + (size_t)h * 4096 + (size_t)(8 * kg) * 64 + n;
      v4u o; o.x = pk2(src[0], src[64]); o.y = pk2(src[128], src[192]); o.z = pk2(src[256], src[320]); o.w = pk2(src[384], src[448]);
      *(LAS v4u*)(L + WPT2_OFF + n * WPT_PITCH + kg * 16) = o; }
    float wA[31];
    { const float* wp = P.caw;
#pragma unroll
    for (int k = 0; k < 31; ++k) { wA[k] = wp[ch]; wp += 256; OPAQUE_S(wp); } }
    for (int hh = 0; hh < 2; ++hh) {
        const int tlo = __builtin_amdgcn_readfirstlane(128 * c + 64 * hh);
        {
            const bf16* zc0 = Zs + h * 64;
            v4u va[3], vb[2], vc[3], vd[3];
#pragma unroll
            for (int k = 0; k < 3; ++k) { const int i = tid + 512 * k; const int r = i >> 4, sl = (i >> 3) & 1, kk = i & 7, tt = tlo - 30 + r;
                va[k] = (i < 1504 && tt >= 0) ? *(const GAS v4u*)(zc0 + (size_t)tt * MIXW + sl * 256 + kk * 8) : zero4; }
#pragma unroll
            for (int k = 0; k < 2; ++k) { const int i = tid + 512 * k; const int r = i >> 3, kk = i & 7, tt = tlo - 15 + r;
                vb[k] = (i < 632 && tt >= 0) ? *(const GAS v4u*)(zc0 + (size_t)tt * MIXW + 512 + kk * 8) : zero4; }
#pragma unroll
            for (int k = 0; k < 3; ++k) { const int i = tid + 512 * k; const int r = i / 24, rem = i - r * 24, sl = rem >> 3, kk = rem & 7, tt = tlo + r;
                vc[k] = *(const GAS v4u*)(zc0 + (size_t)tt * MIXW + (3 + sl) * 256 + kk * 8); }
#pragma unroll
            for (int k = 0; k < 3; ++k) { const int i = tid + 512 * k; const int r = i >> 4, sl = (i >> 3) & 1, kk = i & 7, tt = tlo - 2 + r;
                vd[k] = (i < 1056 && tt >= 0) ? *(const GAS v4u*)(zc0 + (size_t)tt * MIXW + (6 + sl) * 256 + kk * 8) : zero4; }
#pragma unroll
            for (int k = 0; k < 3; ++k) { const int i = tid + 512 * k; if (i < 1504) *(LAS v4u*)(L + SB01_OFF + (i >> 4) * 256 + ((i >> 3) & 1) * 128 + (i & 7) * 16) = va[k]; }
#pragma unroll
            for (int k = 0; k < 2; ++k) { const int i = tid + 512 * k; if (i < 632) *(LAS v4u*)(L + SB2_OFF + (i >> 3) * 128 + (i & 7) * 16) = vb[k]; }
#pragma unroll
            for (int k = 0; k < 3; ++k) { const int i = tid + 512 * k; const int r = i / 24, rem = i - r * 24; *(LAS v4u*)(L + SB345_OFF + r * 384 + (rem >> 3) * 128 + (rem & 7) * 16) = vc[k]; }
#pragma unroll
            for (int k = 0; k < 3; ++k) { const int i = tid + 512 * k; if (i < 1056) *(LAS v4u*)(L + SB67_OFF + (i >> 4) * 256 + ((i >> 3) & 1) * 128 + (i & 7) * 16) = vd[k]; }
        }
        __syncthreads();
        {
            float ha[12], qv[9];
#pragma unroll
            for (int k = 0; k < 12; ++k) { const int i = tid + 512 * k; const int r = i >> 6, cc = i & 63; ha[k] = 0.f;
                if (i < 94 * 64) { const LAS bf16* p = (const LAS bf16*)(L + SB01_OFF + r * 256 + cc * 2); ha[k] = bf2f(p[0]) * pg8::sigmoid_f(bf2f(p[64])); } }
#pragma unroll
            for (int k = 0; k < 9; ++k) { const int i = tid + 512 * k; const int r = i >> 6, cc = i & 63; qv[k] = 0.f;
                if (i < 66 * 64) { const LAS bf16* p = (const LAS bf16*)(L + SB67_OFF + r * 256 + cc * 2); qv[k] = bf2f(p[0]) * bf2f(p[64]); } }
            __syncthreads();
#pragma unroll
            for (int k = 0; k < 12; ++k) { const int i = tid + 512 * k; if (i < 94 * 64) *(LAS float*)(L + SB01_OFF + (i >> 6) * 256 + (i & 63) * 4) = ha[k]; }
#pragma unroll
            for (int k = 0; k < 9; ++k) { const int i = tid + 512 * k; if (i < 66 * 64) *(LAS float*)(L + SB67_OFF + (i >> 6) * 256 + (i & 63) * 4) = qv[k]; }
        }
        __syncthreads();
        const int tb = __builtin_amdgcn_readfirstlane(tlo + 8 * w);
        {
            float ext[38];
#pragma unroll
            for (int e = 0; e < 38; ++e) ext[e] = *(const LAS float*)(L + SB01_OFF + (8 * w + e) * 256 + lane * 4);
            const float bias = P.cab[ch], g = P.nag[ch], nb = P.nab[ch];
            bf16* mp = uni_ptr(Ms + (size_t)tb * D);
            float cv[8], mean[8], rstd[8];
#pragma unroll
            for (int r = 0; r < 8; ++r) { float a = bias;
#pragma unroll
                for (int k = 0; k < 31; ++k) a += wA[k] * ext[r + k];
                cv[r] = a; }
            ln8_stats(cv, mean, rstd, LN_EPS);
#pragma unroll
            for (int r = 0; r < 8; ++r) { const float y = (cv[r] - mean[r]) * rstd[r] * g + nb;
                mp[ch] = f2bf16(pg8::silu_f(y)); mp += D; OPAQUE_S(mp); }
            if (c == 15 && hh == 1) {
                float* sp = uni_ptr(P.out + O_CA_P + ((ptrdiff_t)(li * BATCH + b) * 30 + (tb - (SEQ - 30))) * 256);
#pragma unroll
                for (int r = 0; r < 8; ++r) { if (tb + r >= SEQ - 30) sp[ch] = ext[r + 30]; sp += 256; OPAQUE_S(sp); } }
        }
        {
            float ze[23];
#pragma unroll
            for (int e = 0; e < 23; ++e) ze[e] = bf2f(*(const LAS bf16*)(L + SB2_OFF + (8 * w + e) * 128 + lane * 2));
            const int win = 2 << h;
#pragma unroll
            for (int r = 0; r < 8; ++r) { const float zc = ze[r + 15];
                const float s2 = zc + ze[r + 14], s4 = s2 + (ze[r + 13] + ze[r + 12]), s8 = s4 + ((ze[r + 11] + ze[r + 10]) + (ze[r + 9] + ze[r + 8]));
                const float s16 = s8 + (((ze[r + 7] + ze[r + 6]) + (ze[r + 5] + ze[r + 4])) + ((ze[r + 3] + ze[r + 2]) + (ze[r + 1] + ze[r])));
                const int t = tb + r; const float cnt = (float)((t + 1 < win) ? t + 1 : win);
                *(LAS bf16*)(L + DT2_OFF + (8 * w + r) * DT_PITCH + lane * 2) = f2bf16(pool_sel(h, s2, s4, s8, s16) * __builtin_amdgcn_rcpf(cnt) - zc);
                }
            if (c == 15 && hh == 1) {
                float* sp = uni_ptr(P.out + O_PL_P + ((ptrdiff_t)(li * BATCH + b) * 15 + (tb - (SEQ - 15))) * 256);
#pragma unroll
                for (int r = 0; r < 8; ++r) { if (tb + r >= SEQ - 15) sp[ch] = ze[r + 15]; sp += 256; OPAQUE_S(sp); } }
        }
        {
            const float g = P.sng[ch], nb = P.snb[ch];
            unsigned pk[4]; float vv[8], mean[8], rstd[8];
#pragma unroll
            for (int r = 0; r < 8; ++r) vv[r] = gelu_tanh(bf2f(*(const LAS bf16*)(L + SB345_OFF + (8 * w + r) * 384 + 128 + lane * 2)));
            ln8_stats(vv, mean, rstd, LN_EPS);
#pragma unroll
            for (int r = 0; r < 8; r += 2) pk[r >> 1] = pk2((vv[r] - mean[r]) * rstd[r] * g + nb, (vv[r + 1] - mean[r + 1]) * rstd[r + 1] * g + nb);
            *(LAS v4u*)(L + VNT2_OFF + lane * VNT_PITCH + (64 * hh + 8 * w) * 2) = (v4u){pk[0], pk[1], pk[2], pk[3]};
        }
        {
            float q[10];
#pragma unroll
            for (int e = 0; e < 10; ++e) q[e] = *(const LAS float*)(L + SB67_OFF + (8 * w + e) * 256 + lane * 4);
            const float w0 = P.scw[ch], w1 = P.scw[256 + ch], w2 = P.scw[512 + ch];
            bf16* mp = uni_ptr(Ms + (size_t)tb * D);
#pragma unroll
            for (int r = 0; r < 8; ++r) { const float bg = bf2f(*(const LAS bf16*)(L + SB345_OFF + (8 * w + r) * 384 + 256 + lane * 2));
                mp[768 + ch] = f2bf16(bg * (w0 * q[r] + w1 * q[r + 1] + w2 * q[r + 2])); mp += D; OPAQUE_S(mp); }
            if (c == 15 && hh == 1) {
                float* sp = uni_ptr(P.out + O_SC_P + ((ptrdiff_t)(li * BATCH + b) * 2 + (tb - (SEQ - 2))) * 256);
#pragma unroll
                for (int r = 0; r < 8; ++r) { if (tb + r >= SEQ - 2) sp[ch] = q[r + 2]; sp += 256; OPAQUE_S(sp); } }
        }
        __syncthreads();
        const int rt = w >> 1, t0 = 64 * hh + 16 * rt;
        {
            const LAS unsigned char* dT = L + DT2_OFF + (16 * rt + fr) * DT_PITCH;
            const bf16x8 b0 = *(const LAS bf16x8*)(dT + (fq * 8) * 2), b1 = *(const LAS bf16x8*)(dT + (32 + fq * 8) * 2);
#pragma unroll
            for (int nn = 0; nn < 2; ++nn) { const int nt = 2 * (w & 1) + nn;
                const LAS unsigned char* wp = L + WPT2_OFF + (16 * nt + fr) * WPT_PITCH;
                const bf16x8 a0 = *(const LAS bf16x8*)(wp + (fq * 8) * 2), a1 = *(const LAS bf16x8*)(wp + (32 + fq * 8) * 2);
                f32x4 acc = {0.f, 0.f, 0.f, 0.f};
                acc = __builtin_amdgcn_mfma_f32_16x16x32_bf16(a0, b0, acc, 0, 0, 0);
                acc = __builtin_amdgcn_mfma_f32_16x16x32_bf16(a1, b1, acc, 0, 0, 0);
                const int n = 16 * nt + 4 * fq; const f32x4 sc = *(const f32x4*)(P.ps + h * 64 + n);
                const unsigned lo = pk2(acc[0] * sc[0], acc[1] * sc[1]), hi = pk2(acc[2] * sc[2], acc[3] * sc[3]);
                *(GAS unsigned long long*)(Ms + (size_t)(tlo + 16 * rt + fr) * D + 256 + h * 64 + n) = (unsigned long long)lo | ((unsigned long long)hi << 32); }
        }
        {
            const int nks = (t0 >> 5) + 1, tl = t0 + fr;
            const float* wrow = P.sw + ((size_t)h * 128 + tl) * 128;
            bf16x8 bw[4];
#pragma unroll
            for (int ks = 0; ks < 4; ++ks) { bf16x8 t = {0, 0, 0, 0, 0, 0, 0, 0};
                if (ks < nks) { const int s0 = 32 * ks + 8 * fq; const f32x4 a = *(const f32x4*)(wrow + s0), bq = *(const f32x4*)(wrow + s0 + 4);
                    float e[8] = {a[0], a[1], a[2], a[3], bq[0], bq[1], bq[2], bq[3]};
#pragma unroll
                    for (int j = 0; j < 8; ++j) e[j] = (s0 + j <= tl) ? e[j] : 0.f;
                    const v4u tw = {pk2(e[0], e[1]), pk2(e[2], e[3]), pk2(e[4], e[5]), pk2(e[6], e[7])}; t = __builtin_bit_cast(bf16x8, tw); }
                bw[ks] = t; }
            const float bsv = P.sb[h * 128 + tl];
#pragma unroll
            for (int cn = 0; cn < 2; ++cn) { const int ct = 2 * (w & 1) + cn;
                const LAS unsigned char* vp = L + VNT2_OFF + (16 * ct + fr) * VNT_PITCH + (8 * fq) * 2;
                f32x4 acc = {0.f, 0.f, 0.f, 0.f};
#pragma unroll
                for (int ks = 0; ks < 4; ++ks) if (ks < nks) acc = __builtin_amdgcn_mfma_f32_16x16x32_bf16(*(const LAS bf16x8*)(vp + 64 * ks), bw[ks], acc, 0, 0, 0);
                const int cc = 16 * ct + 4 * fq;
                const unsigned long long uw = *(const LAS unsigned long long*)(L + SB345_OFF + (16 * rt + fr) * 384 + cc * 2);
                const float u0 = gelu_tanh(__uint_as_float((unsigned)uw << 16)), u1 = gelu_tanh(__uint_as_float((unsigned)uw & 0xffff0000u));
                const float u2 = gelu_tanh(__uint_as_float((unsigned)(uw >> 32) << 16)), u3 = gelu_tanh(__uint_as_float((unsigned)(uw >> 32) & 0xffff0000u));
                const unsigned lo = pk2(u0 * (acc[0] + bsv), u1 * (acc[1] + bsv)), hi = pk2(u2 * (acc[2] + bsv), u3 * (acc[3] + bsv));
                *(GAS unsigned long long*)(Ms + (size_t)(tlo + 16 * rt + fr) * D + 512 + h * 64 + cc) = (unsigned long long)lo | ((unsigned long long)hi << 32); }
        }
        __syncthreads();
    }
}
__device__ __forceinline__ void mix_sample_wave(Frame& F, const MixP& P, int b, int h) {
    const int lane = F.lane, ch = h * 64 + lane, li = P.li;
    b = __builtin_amdgcn_readfirstlane(b); h = __builtin_amdgcn_readfirstlane(h);
    const bf16* Zr = uni_ptr(P.Z + (size_t)(MP + b * DECS) * MIXW); bf16* Mr = uni_ptr(P.MIX + (size_t)(MP + b * DECS) * D);
    const size_t sb_ = (size_t)li * DECB + b;
    {
        float wA[31];
        { const float* wp = P.caw;
#pragma unroll
        for (int k = 0; k < 31; ++k) { wA[k] = wp[ch]; wp += 256; OPAQUE_S(wp); } }
        float ext[38];
        { const float* sp = P.st_a + sb_ * 30 * 256; float* so = P.out + O_CA_S + sb_ * 30 * 256;
#pragma unroll
        for (int j = 0; j < 30; ++j) { ext[j] = sp[ch]; sp += 256; OPAQUE_S(sp); }
        const bf16* zp = Zr;
#pragma unroll
        for (int t = 0; t < 8; ++t) { ext[30 + t] = bf2f(zp[ch]) * pg8::sigmoid_f(bf2f(zp[256 + ch])); zp += MIXW; OPAQUE_S(zp); }
#pragma unroll
        for (int j = 0; j < 30; ++j) { so[ch] = ext[j + 8]; so += 256; OPAQUE_S(so); } }
        const float bias = P.cab[ch], g = P.nag[ch], nb = P.nab[ch];
        bf16* mp = Mr; float cvs[8], mean8[8], rstd8[8];
#pragma unroll
        for (int t = 0; t < 8; ++t) { float a = bias;
#pragma unroll
            for (int k = 0; k < 31; ++k) a += wA[k] * ext[t + k];
            cvs[t] = a; }
        ln8_stats(cvs, mean8, rstd8, LN_EPS);
#pragma unroll
        for (int t = 0; t < 8; ++t) { mp[ch] = f2bf16(pg8::silu_f((cvs[t] - mean8[t]) * rstd8[t] * g + nb)); mp += D; OPAQUE_S(mp); }
    }
    {
        float ze[23];
        { const float* sp = P.st_p + sb_ * 15 * 256; float* so = P.out + O_PL_S + sb_ * 15 * 256;
#pragma unroll
        for (int j = 0; j < 15; ++j) { ze[j] = sp[ch]; sp += 256; OPAQUE_S(sp); }
        const bf16* zp = Zr;
#pragma unroll
        for (int t = 0; t < 8; ++t) { ze[15 + t] = bf2f(zp[512 + ch]); zp += MIXW; OPAQUE_S(zp); }
#pragma unroll
        for (int j = 0; j < 15; ++j) { so[ch] = ze[j + 8]; so += 256; OPAQUE_S(so); } }
        float d[8], y[8];
        const float inv = 1.0f / (float)(2 << h);
#pragma unroll
        for (int r = 0; r < 8; ++r) { const float zc = ze[r + 15];
            const float s2 = zc + ze[r + 14], s4 = s2 + (ze[r + 13] + ze[r + 12]), s8 = s4 + ((ze[r + 11] + ze[r + 10]) + (ze[r + 9] + ze[r + 8]));
            const float s16 = s8 + (((ze[r + 7] + ze[r + 6]) + (ze[r + 5] + ze[r + 4])) + ((ze[r + 3] + ze[r + 2]) + (ze[r + 1] + ze[r])));
            d[r] = pool_sel(h, s2, s4, s8, s16) * inv - zc; y[r] = 0.f; }
        const float* pwh = P.pw + (size_t)h * 4096;
#pragma unroll 8
        for (int k = 0; k < 64; ++k) { const float wv = pwh[lane]; pwh += 64;
#pragma unroll
            for (int r = 0; r < 8; ++r) y[r] += __shfl(d[r], k) * wv; }
        const float sc = P.ps[ch];
        bf16* mp = Mr;
#pragma unroll
        for (int r = 0; r < 8; ++r) { mp[256 + ch] = f2bf16(y[r] * sc); mp += D; OPAQUE_S(mp); }
    }
    {
        const float g = P.sng[ch], nb = P.snb[ch];
        float vn[8], ug[8];
        { const bf16* zp = Zr; float* so = P.out + O_CV_S + sb_ * DECS * 256;
#pragma unroll
        for (int t = 0; t < 8; ++t) { vn[t] = gelu_tanh(bf2f(zp[1024 + ch])); ug[t] = gelu_tanh(bf2f(zp[768 + ch])); zp += MIXW; OPAQUE_S(zp); }
        { float mean8[8], rstd8[8]; ln8_stats(vn, mean8, rstd8, LN_EPS);
#pragma unroll
        for (int t = 0; t < 8; ++t) { vn[t] = (vn[t] - mean8[t]) * rstd8[t] * g + nb; so[ch] = vn[t]; so += 256; OPAQUE_S(so); } } }
        bf16* mp = Mr; const float* swp = P.sw + (size_t)h * 128 * 128; const float* sbp = P.sb + h * 128;
#pragma unroll
        for (int t = 0; t < 8; ++t) { float s = sbp[t];
#pragma unroll
            for (int q = 0; q <= t; ++q) s += swp[q] * vn[q];
            swp += 128; OPAQUE_S(swp);
            mp[512 + ch] = f2bf16(ug[t] * s); mp += D; OPAQUE_S(mp); }
    }
    {
        float q[10], bg[8];
        q[0] = P.st_s[(sb_ * 2 + 0) * 256 + ch]; q[1] = P.st_s[(sb_ * 2 + 1) * 256 + ch];
        { const bf16* zp = Zr;
#pragma unroll
        for (int t = 0; t < 8; ++t) { q[2 + t] = bf2f(zp[1536 + ch]) * bf2f(zp[1792 + ch]); bg[t] = bf2f(zp[1280 + ch]); zp += MIXW; OPAQUE_S(zp); } }
        const float w0 = P.scw[ch], w1 = P.scw[256 + ch], w2 = P.scw[512 + ch];
        bf16* mp = Mr;
#pragma unroll
        for (int t = 0; t < 8; ++t) { mp[768 + ch] = f2bf16(bg[t] * (w0 * q[t] + w1 * q[t + 1] + w2 * q[t + 2])); mp += D; OPAQUE_S(mp); }
        P.out[O_SC_S + (sb_ * 2 + 0) * 256 + ch] = q[8]; P.out[O_SC_S + (sb_ * 2 + 1) * 256 + ch] = q[9];
    }
}
constexpr int MIX_PUNITS = BATCH * 16 * 4, MIX_SUNITS = DECB * 4 / NWAVES;
__device__ __forceinline__ void mix_phase(Frame& F, const MixP& P) {
    for (int u = blockIdx.x; u < MIX_PUNITS + MIX_SUNITS; u += F.G) {
        asm volatile("" : "+v"(F.tid), "+v"(F.lane), "+s"(F.wave) :: "memory");
        if (u < MIX_PUNITS) mix_prompt_unit2(F, P, u >> 6, (u >> 2) & 15, u & 3);
        else { const int wu = (u - MIX_PUNITS) * NWAVES + F.wave; mix_sample_wave(F, P, wu >> 2, wu & 3); }
    }
}
__device__ __forceinline__ void small_gemm_resid(Frame& F, const bf16* A, int lda, const bf16* Bt, int K, bf16* XB, float scale, int m0) {
    const int w = F.wave, lane = F.lane, tid = F.tid, fr = lane & 15, fq = lane >> 4, K8 = K >> 3;
    constexpr int PP = 68;
    LAS float* Pt = (LAS float*)(F.lds);
    for (int t = (int)blockIdx.x; t < 256; t += F.G) {
        const int ti = t >> 4, tj = t & 15;
        const bf16* a0 = A + (size_t)(m0 + 64 * ti + fr) * lda + w * K8 + 8 * fq;
        const bf16* b0 = Bt + (size_t)(64 * tj + fr) * lda + w * K8 + 8 * fq;
        f32x4 acc[4][4];
#pragma unroll
        for (int mi = 0; mi < 4; ++mi)
#pragma unroll
            for (int ni = 0; ni < 4; ++ni) acc[mi][ni] = (f32x4){0.f, 0.f, 0.f, 0.f};
#pragma unroll 2
        for (int k = 0; k < K8; k += 32) {
            bf16x8 af[4], bfr[4];
#pragma unroll
            for (int mi = 0; mi < 4; ++mi) af[mi] = *(const bf16x8*)(a0 + (size_t)(16 * mi) * lda + k);
#pragma unroll
            for (int ni = 0; ni < 4; ++ni) bfr[ni] = *(const bf16x8*)(b0 + (size_t)(16 * ni) * lda + k);
#pragma unroll
            for (int mi = 0; mi < 4; ++mi)
#pragma unroll
                for (int ni = 0; ni < 4; ++ni) acc[mi][ni] = __builtin_amdgcn_mfma_f32_16x16x32_bf16(af[mi], bfr[ni], acc[mi][ni], 0, 0, 0);
        }
        LAS float* mine = Pt + (w & 3) * 64 * PP + (4 * fq) * PP + fr;
        if (w >= 4) {
#pragma unroll
            for (int mi = 0; mi < 4; ++mi)
#pragma unroll
                for (int ni = 0; ni < 4; ++ni)
#pragma unroll
                    for (int rg = 0; rg < 4; ++rg) mine[(16 * mi + rg) * PP + 16 * ni] = acc[mi][ni][rg];
        }
        __syncthreads();
        if (w < 4) {
#pragma unroll
            for (int mi = 0; mi < 4; ++mi)
#pragma unroll
                for (int ni = 0; ni < 4; ++ni)
#pragma unroll
                    for (int rg = 0; rg < 4; ++rg) acc[mi][ni][rg] += mine[(16 * mi + rg) * PP + 16 * ni];
#pragma unroll
            for (int mi = 0; mi < 4; ++mi)
#pragma unroll
                for (int ni = 0; ni < 4; ++ni)
#pragma unroll
                    for (int rg = 0; rg < 4; ++rg) mine[(16 * mi + rg) * PP + 16 * ni] = acc[mi][ni][rg];
        }
        __syncthreads();
        { const int row = tid >> 3, c8 = (tid & 7) * 8;
          f32x4 s0 = {0.f, 0.f, 0.f, 0.f}, s1 = {0.f, 0.f, 0.f, 0.f};
#pragma unroll
          for (int q = 0; q < 4; ++q) { const LAS f32x4* p = (const LAS f32x4*)(Pt + (q * 64 + row) * PP + c8); s0 += p[0]; s1 += p[1]; }
          const size_t off = (size_t)(m0 + 64 * ti + row) * D + 64 * tj + c8;
          const v4u rw = *(const GAS v4u*)(XB + off);
          f32x4 x0 = {__uint_as_float(rw.x << 16), __uint_as_float(rw.x & 0xffff0000u), __uint_as_float(rw.y << 16), __uint_as_float(rw.y & 0xffff0000u)};
          f32x4 x1 = {__uint_as_float(rw.z << 16), __uint_as_float(rw.z & 0xffff0000u), __uint_as_float(rw.w << 16), __uint_as_float(rw.w & 0xffff0000u)};
          x0 += s0 * scale; x1 += s1 * scale;
          v4u o; o.x = pk2(x0[0], x0[1]); o.y = pk2(x0[2], x0[3]); o.z = pk2(x1[0], x1[1]); o.w = pk2(x1[2], x1[3]);
          *(GAS v4u*)(XB + off) = o; }
        __syncthreads();
    }
}
__global__ void __launch_bounds__(NWAVES * 64, 2) fwd_megakernel(Args args) {
    extern __shared__ __attribute__((aligned(16))) unsigned char lds[];
    Frame F;
    F.lds = (LAS unsigned char*)lds;
    F.tid = threadIdx.x; F.lane = F.tid & 63; F.wave = __builtin_amdgcn_readfirstlane(F.tid >> 6);
    F.G = gridDim.x; { const int bx = blockIdx.x; F.vcu = (F.G % 8 == 0) ? (bx % 8) * (F.G / 8) + bx / 8 : bx; }
    unsigned char* ws = args.ws;
    for (int u = F.tid; u < (LDS_BYTES - LDSCTL_OFF) / 4; u += NWAVES * 64) ((LAS unsigned*)(F.lds + LDSCTL_OFF))[u] = 0u;
    __syncthreads();
    XcdBarrier bar = xcd_barrier_post((unsigned*)(ws + WS_CTL) + CW_BAR, (volatile LAS unsigned*)(F.lds + MISC_OFF) + 8);
#define GRID_BAR() do { asm volatile("" : "+s"(bar.bar)); xcd_barrier(bar); asm volatile("" : "+v"(F.tid), "+v"(F.lane), "+s"(F.wave) :: "memory"); } while (0)
#if defined(NO_GEMM) || (defined(ONLY) && ONLY != 1)
#define RUN_GEMM1(...)
#else
#define RUN_GEMM1(...) __VA_ARGS__
#endif
#if defined(NO_GEMM) || (defined(ONLY) && ONLY != 2)
#define RUN_GEMM2(...)
#else
#define RUN_GEMM2(...) __VA_ARGS__
#endif
#if defined(NO_GEMM) || (defined(ONLY) && ONLY != 3)
#define RUN_GEMM3(...)
#else
#define RUN_GEMM3(...) __VA_ARGS__
#endif
#if defined(NO_GEMM) || (defined(ONLY) && ONLY != 4)
#define RUN_GEMM4(...)
#else
#define RUN_GEMM4(...) __VA_ARGS__
#endif
#if defined(NO_GEMM) || (defined(ONLY) && ONLY != 5)
#define RUN_GEMM5(...)
#else
#define RUN_GEMM5(...) __VA_ARGS__
#endif
#if defined(NO_GEMM) || (defined(ONLY) && ONLY != 6)
#define RUN_GEMM6(...)
#else
#define RUN_GEMM6(...) __VA_ARGS__
#endif
#if defined(NO_GEMM) || (defined(ONLY) && ONLY != 7)
#define RUN_GEMM7(...)
#else
#define RUN_GEMM7(...) __VA_ARGS__
#endif
#if defined(NO_GEMM) || (defined(ONLY) && ONLY != 8)
#define RUN_GEMM8(...)
#else
#define RUN_GEMM8(...) __VA_ARGS__
#endif

#ifndef NO_PRO
    p0_prologue(F, args);
#ifdef PROBE_PRO2
    p0_prologue(F, args);
#endif
#endif
    if (args.ws == nullptr) cg::this_grid().sync();
    GRID_BAR();

    float* X = args.out;
    pg8::bf16_t* ACT = (pg8::bf16_t*)(ws + WS_ACT);
    if (F.tid == 0) { unsigned ok = (F.G % 8 == 0) ? 1u : 0u; for (unsigned j = 0; j < 8; ++j) ok &= (xb_ld(&bar.bar[XB_XCNT(j)]) == (unsigned)(F.G / 8)) ? 1u : 0u;
        volatile LAS unsigned* stw = (volatile LAS unsigned*)(F.lds + MISC_OFF) + 8; const unsigned rk = stw[4];
        stw[5] = (ok && rk < (unsigned)(F.G / 8) && bar.x < 8u) ? 8u * rk + bar.x : (unsigned)blockIdx.x; }
    __syncthreads();
    const int G = F.G, cu = __builtin_amdgcn_readfirstlane((int)((volatile LAS unsigned*)(F.lds + MISC_OFF))[8 + 5]);
    for (int li = 0; li < DEPTH; ++li) {
        pg8::bf16_t* XB = (pg8::bf16_t*)(ws + ((li & 1) ? WS_BUFB : WS_BUFA));
        pg8::bf16_t* MX = (pg8::bf16_t*)(ws + ((li & 1) ? WS_BUFA : WS_BUFB));
        const unsigned char* wl = ws + WS_W + (size_t)li * W_LAYER;
        { pg8::Gemm g{XB, (const pg8::bf16_t*)(wl + WO_GU1), M, NGU, D}; pg8::StaticOrder S; S.init(M, NGU, G, opaque_s(cu));
          pg8::EpiSwiGLU E{ACT, FF}; RUN_GEMM1(pg8::gemm_phase<pg8::EpiSwiGLU, pg8::StaticOrder, true, true>(F.lds + RING_OFF, g, S, E);)
#ifdef PROBE_P1X2
          pg8::gemm_phase<pg8::EpiSwiGLU, pg8::StaticOrder, true, true>(F.lds + RING_OFF, g, S, E);
#endif
#ifdef PROBE_P1NULL
          { pg8::EpiNull E0; pg8::gemm_phase<pg8::EpiNull, pg8::StaticOrder, true, true>(F.lds + RING_OFF, g, S, E0); }
#endif
        }
        GRID_BAR();
        { pg8::Gemm g{ACT, (const pg8::bf16_t*)(wl + WO_D1), M, D, FF}; pg8::MixedOrder S; S.init(MP, 0, D, G, opaque_s(cu));
          pg8::EpiResid<0> E{XB, XB, 0.5f, nullptr}; RUN_GEMM2(pg8::gemm_phase<pg8::EpiResid<0>, pg8::MixedOrder, true, true>(F.lds + RING_OFF, g, S, E);) }
        small_gemm_resid(F, (const bf16*)ACT, FF, (const bf16*)(wl + WO_D1), FF, (bf16*)XB, 0.5f, MP);
        GRID_BAR();
        { pg8::Gemm g{XB, (const pg8::bf16_t*)(wl + WO_MI), M, MIXW, D}; pg8::MixedOrder S; S.init(MP, MS, MIXW, G, opaque_s(cu));
          pg8::EpiScaleBf16<true> E{ACT, MIXW}; RUN_GEMM3(pg8::gemm_phase<pg8::EpiScaleBf16<true>, pg8::MixedOrder, true, true>(F.lds + RING_OFF, g, S, E);) }
        GRID_BAR();
        { MixP P; P.Z = (const bf16*)ACT; P.MIX = (bf16*)MX; P.caw = args.in[opaque_s(13)] + (size_t)li * 31 * 256; P.cab = args.in[opaque_s(14)] + li * 256; P.nag = args.in[opaque_s(15)] + li * 256; P.nab = args.in[opaque_s(16)] + li * 256;
          P.pw = args.in[opaque_s(17)] + (size_t)li * 4 * 4096; P.ps = args.in[opaque_s(18)] + li * 256; P.sng = args.in[opaque_s(19)] + li * 256; P.snb = args.in[opaque_s(20)] + li * 256;
          P.sw = args.in[opaque_s(21)] + (size_t)li * 4 * 128 * 128; P.sb = args.in[opaque_s(22)] + li * 4 * 128; P.scw = args.in[opaque_s(23)] + li * 3 * 256; P.out = args.out; P.li = li;
          P.st_a = args.in[opaque_s(4)]; P.st_p = args.in[opaque_s(5)]; P.st_s = args.in[opaque_s(6)];
#ifndef NO_MIX
          mix_phase(F, P);
#ifdef PROBE_MIX2
          mix_phase(F, P);
#endif
#endif
        }
        GRID_BAR();
        { pg8::Gemm g{MX, (const pg8::bf16_t*)(wl + WO_MO), M, D, D}; pg8::MixedOrder S; S.init(MP, MS, D, G, opaque_s(cu));
          pg8::EpiResid<0> E{XB, XB, 1.0f, nullptr}; RUN_GEMM4(pg8::gemm_phase<pg8::EpiResid<0>, pg8::MixedOrder, true, true>(F.lds + RING_OFF, g, S, E);) }
        { const int nq = (MS / 256) * (D / 256) * 4; pg8::bf16_t* PROJ = (pg8::bf16_t*)args.out + (size_t)li * M * D;
          pg8::Gemm g{(const pg8::bf16_t*)(ws + WS_PB) + (size_t)li * M * DPLE, (const pg8::bf16_t*)(wl + WO_PP), M, D, DPLE};
          pg8::RangeOrder S{0, (M / 256) * (D / 256), G > nq ? G - nq : G, opaque_s(G > nq ? (cu >= nq ? cu - nq : -1) : cu)};
          pg8::EpiScaleBf16<false> E{PROJ, D}; pg8::gemm_phase<pg8::EpiScaleBf16<false>, pg8::RangeOrder, true, true>(F.lds + RING_OFF, g, S, E); }
        GRID_BAR();
        { pg8::Gemm g{XB, (const pg8::bf16_t*)(wl + WO_GU2), M, NGU, D}; pg8::StaticOrder S; S.init(M, NGU, G, opaque_s(cu));
          pg8::EpiSwiGLU E{ACT, FF}; RUN_GEMM5(pg8::gemm_phase<pg8::EpiSwiGLU, pg8::StaticOrder, true, true>(F.lds + RING_OFF, g, S, E);) }
        GRID_BAR();
        { pg8::Gemm g{ACT, (const pg8::bf16_t*)(wl + WO_D2), M, D, FF}; pg8::MixedOrder S; S.init(MP, 0, D, G, opaque_s(cu));
          pg8::EpiResid<0> E{XB, XB, 0.5f, nullptr}; RUN_GEMM6(pg8::gemm_phase<pg8::EpiResid<0>, pg8::MixedOrder, true, true>(F.lds + RING_OFF, g, S, E);) }
        small_gemm_resid(F, (const bf16*)ACT, FF, (const bf16*)(wl + WO_D2), FF, (bf16*)XB, 0.5f, MP);
        GRID_BAR();
        { pg8::Gemm g{XB, (const pg8::bf16_t*)(wl + WO_PG), M, D, D}; pg8::MixedOrder S; S.init(MP, MS, D, G, opaque_s(cu));
          pg8::EpiResid<1> E{MX, XB, 0.f, (const pg8::bf16_t*)args.out + (size_t)li * M * D}; RUN_GEMM8(pg8::gemm_phase<pg8::EpiResid<1>, pg8::MixedOrder, true, true>(F.lds + RING_OFF, g, S, E);) }
        GRID_BAR();
    }
#ifndef NO_FIN
    final_norm(F, args, (const bf16*)(ws + ((DEPTH & 1) ? WS_BUFB : WS_BUFA)));
#endif
}

extern "C" void kernel_launch(void* const* d_in, const int* in_sizes, int n_in, void* d_out, int out_size, void* d_ws, size_t ws_size, hipStream_t stream) {
    static int grid = 0;
    if (grid == 0) {
        if (n_in != NIN || in_sizes[0] != MP * D || (size_t)out_size != O_END || ws_size < WS_END) {
            fprintf(stderr, "kernel_launch: unexpected shapes: n_in %d in0 %d out %d (want %zu) ws %zu (need %zu); nothing launched\n", n_in, n_in > 0 ? in_sizes[0] : -1, out_size, (size_t)O_END, ws_size, (size_t)WS_END); grid = -1; return; }
        int dev = 0, cus = 0, per_cu = 0;
        if (hipGetDevice(&dev) != hipSuccess || hipDeviceGetAttribute(&cus, hipDeviceAttributeMultiprocessorCount, dev) != hipSuccess) { grid = -1; return; }
        if (hipFuncSetAttribute((const void*)fwd_megakernel, hipFuncAttributeMaxDynamicSharedMemorySize, LDS_BYTES) != hipSuccess) { fprintf(stderr, "kernel_launch: hipFuncSetAttribute failed\n"); grid = -1; return; }
        if (hipOccupancyMaxActiveBlocksPerMultiprocessor(&per_cu, (const void*)fwd_megakernel, NWAVES * 64, LDS_BYTES) != hipSuccess || per_cu < 1) { fprintf(stderr, "kernel_launch: occupancy query says %d\n", per_cu); per_cu = 1; }
        (void)hipGetLastError();
        grid = cus;
    }
    if (grid < 0) return;
    if (hipMemsetAsync((char*)d_ws + WS_CTL, 0, CTL_ZERO_BYTES, stream) != hipSuccess) { fprintf(stderr, "kernel_launch: memset failed\n"); return; }
    Args a{};
    for (int i = 0; i < NIN; ++i) a.in[i] = (const float*)d_in[i];
    a.out = (float*)d_out; a.ws = (unsigned char*)d_ws;
    void* kargs[] = {&a};
    hipError_t e = hipLaunchCooperativeKernel((const void*)fwd_megakernel, dim3(grid), dim3(NWAVES * 64), kargs, LDS_BYTES, stream);
    if (e != hipSuccess) fprintf(stderr, "kernel_launch: cooperative launch failed: %s (grid %d)\n", hipGetErrorString(e), grid);
}
```

```cpp
#include <hip/hip_runtime.h>
#include <hip/hip_cooperative_groups.h>
#include <cstdio>
#include <cstdint>
namespace cg = cooperative_groups;

namespace pg8 {
#define PG8_LAS __attribute__((address_space(3)))
typedef unsigned short bf16_t;
typedef short bf16x8 __attribute__((ext_vector_type(8)));
typedef float f32x4 __attribute__((ext_vector_type(4)));
typedef unsigned u32x4 __attribute__((ext_vector_type(4)));
constexpr int BM = 256, BK = 64, HALF = 128, HTB = HALF * BK * 2  , STAGE_BYTES = 8 * HTB, NXCD = 8, WGM = 8;

__host__ __device__ __forceinline__ int lds_byte(int r, int c) { const int st = (r >> 4) * 2 + (c >> 5), rr = r & 15, cc = c & 31, ob = rr * 64 + cc * 2; return st * 1024 + (ob ^ (((ob >> 9) & 1) << 5)); }
__host__ __device__ __forceinline__ void stage_rc(int b, int& R, int& C) { const int st = b / 1024, sb = b % 1024, swz = sb ^ (((sb >> 9) & 1) << 5); R = (st >> 1) * 16 + swz / 64; C = (st & 1) * 32 + (swz % 64) / 2; }
__host__ __device__ __forceinline__ int perm32(int rho) { const int n = rho >> 4, i = rho & 15; return 8 * (i >> 2) + 4 * n + (i & 3); }

struct Unit { int pm, pn, sub; };
struct Gemm { const bf16_t* A; const bf16_t* Bt; int M, N, K; };

struct StaticOrder {
    int nM, nN, nwg, G, c;
    __host__ __device__ void init(int M, int N, int G_, int c_) { nM = M / BM; nN = N / BM; nwg = nM * nN; G = G_; c = c_; }
    __host__ __device__ bool next(int i, Unit& u) const {
        const long L = (long)i * G + c; if (L >= nwg) return false;
        int wgid = (int)L; { const int q = nwg / NXCD, r = nwg % NXCD, xcd = wgid % NXCD, off = wgid / NXCD; wgid = (xcd < r ? xcd * (q + 1) : r * (q + 1) + (xcd - r) * q) + off; }
        const int nig = WGM * nN, gid = wgid / nig, fm = gid * WGM, gsz = (nM - fm) < WGM ? (nM - fm) : WGM;
        u.pm = fm + ((wgid % nig) % gsz); u.pn = (wgid % nig) / gsz; u.sub = 15; return true;
    }
    __device__ __forceinline__ void a_ready(const Unit&) const {}
    __device__ __forceinline__ void done(const Unit&) const {}
};

__device__ __forceinline__ unsigned cvt_pk_bf16(float lo, float hi) { unsigned r; asm("v_cvt_pk_bf16_f32 %0, %1, %2" : "=v"(r) : "v"(lo), "v"(hi)); return r; }
typedef float f32x2 __attribute__((ext_vector_type(2)));
struct MixedOrder {
    StaticOrder so; int nP, nQ, nNq, nMf, G, c;
    __device__ __forceinline__ void init(int Mfull, int Mquad, int N, int G_, int c_) { so.init(Mfull, N, G_, c_); nMf = Mfull / BM; nNq = N / BM; nP = nMf * nNq; nQ = (Mquad / BM) * nNq * 4; G = G_; c = c_; }
    __device__ __forceinline__ bool next(int i, Unit& u) const {
        const long L = (long)i * G + c; if (L < nP) return so.next(i, u);
        const int q = (int)(L - nP); if (q >= nQ) return false;
        const int t = q >> 2; u.sub = 1 << (q & 3); u.pn = t % nNq; u.pm = nMf + t / nNq; return true;
    }
    __device__ __forceinline__ void a_ready(const Unit&) const {}
    __device__ __forceinline__ void done(const Unit&) const {}
};
struct RangeOrder {
    int u0, u1, G2, c2;
    __device__ __forceinline__ bool next(int i, Unit& u) const { if (c2 < 0) return false; const int L = u0 + i * G2 + c2; if (L >= u1) return false; u.pm = L >> 2; u.pn = L & 3; u.sub = 15; return true; }
    __device__ __forceinline__ void a_ready(const Unit&) const {}
    __device__ __forceinline__ void done(const Unit&) const {}
};
typedef float f32x2 __attribute__((ext_vector_type(2)));
typedef __bf16 bf2_t __attribute__((ext_vector_type(2)));
typedef __bf16 bf8_t __attribute__((ext_vector_type(8)));
constexpr float RMS_EPS = 1e-6f;
__device__ __forceinline__ float ssq8(bf16x8 v, float s) {
    const bf8_t b = __builtin_bit_cast(bf8_t, v);
#pragma unroll
    for (int i = 0; i < 4; ++i) { const bf2_t p = {b[2 * i], b[2 * i + 1]}; s = __builtin_amdgcn_fdot2_f32_bf16(p, p, s, false); }
    return s;
}
__device__ __forceinline__ float ssq2(bf16x8 v, int i, float s) {
    const bf8_t b = __builtin_bit_cast(bf8_t, v); const bf2_t p = {b[2 * i], b[2 * i + 1]}; return __builtin_amdgcn_fdot2_f32_bf16(p, p, s, false);
}
__device__ __forceinline__ float sigmoid_f(float v) { return __builtin_amdgcn_rcpf(1.0f + __builtin_amdgcn_exp2f(v * -1.4426950408889634f)); }
__device__ __forceinline__ float silu_f(float v) { return v * sigmoid_f(v); }

struct EpiSwiGLU {
    static constexpr bool PERM = true, AFTER_DRAIN = false, NEED_RS = true;
    bf16_t* O; int ldc;
    __device__ __forceinline__ void operator()(const f32x4 (&acc)[2][2][4][2], const float (&rsv)[2][4], const Unit& u, int wr, int wc, int fr, int fq) const {
        const int row0 = u.pm * BM + wr * 64 + fr, col0 = u.pn * HALF + wc * 32 + 8 * fq;
#pragma unroll
        for (int ai = 0; ai < 2; ++ai)
#pragma unroll
            for (int m = 0; m < 4; ++m) { const int row = row0 + ai * HALF + m * 16; const float rs = rsv[ai][m], c1 = rs * -1.4426950408889634f, rs2 = rs * rs;
                unsigned wv[4];
#pragma unroll
                for (int n = 0; n < 2; ++n)
#pragma unroll
                    for (int j = 0; j < 4; j += 2) { const f32x2 g = {acc[ai][0][m][n][j], acc[ai][0][m][n][j + 1]}, up = {acc[ai][1][m][n][j], acc[ai][1][m][n][j + 1]};
                        const f32x2 t = g * c1; f32x2 e; e.x = __builtin_amdgcn_exp2f(t.x); e.y = __builtin_amdgcn_exp2f(t.y);
                        const f32x2 d = e + 1.0f; f32x2 r; r.x = __builtin_amdgcn_rcpf(d.x); r.y = __builtin_amdgcn_rcpf(d.y);
                        const f32x2 o = ((g * up) * rs2) * r;
                        wv[2 * n + (j >> 1)] = cvt_pk_bf16(o.x, o.y); }
                u32x4 w; w.x = wv[0]; w.y = wv[1]; w.z = wv[2]; w.w = wv[3];
                *(u32x4*)(O + (size_t)row * ldc + col0) = w; }
    }
};
template <bool RS> struct EpiScaleBf16 {
    static constexpr bool PERM = true, AFTER_DRAIN = false, NEED_RS = RS;
    bf16_t* O; int ldc;
    __device__ __forceinline__ void operator()(const f32x4 (&acc)[2][2][4][2], const float (&rsv)[2][4], const Unit& u, int wr, int wc, int fr, int fq) const {
        const int row0 = u.pm * BM + wr * 64 + fr, col0 = u.pn * BM + wc * 32 + 8 * fq;
#pragma unroll
        for (int ai = 0; ai < 2; ++ai)
#pragma unroll
            for (int m = 0; m < 4; ++m) { const int row = row0 + ai * HALF + m * 16; const float rs = RS ? rsv[ai][m] : 1.0f;
#pragma unroll
                for (int bj = 0; bj < 2; ++bj) if ((u.sub >> (2 * ai + bj)) & 1) { const f32x4 v0 = acc[ai][bj][m][0] * rs, v1 = acc[ai][bj][m][1] * rs;
                    u32x4 w; w.x = cvt_pk_bf16(v0[0], v0[1]); w.y = cvt_pk_bf16(v0[2], v0[3]); w.z = cvt_pk_bf16(v1[0], v1[1]); w.w = cvt_pk_bf16(v1[2], v1[3]);
                    *(u32x4*)(O + (size_t)row * ldc + col0 + bj * HALF) = w; } }
    }
};
template <int MODE> struct EpiResid {
    static constexpr bool PERM = true, AFTER_DRAIN = false, NEED_RS = (MODE == 1);
    bf16_t* XB; const bf16_t* XR; float scale; const bf16_t* proj;
    __device__ __forceinline__ void operator()(const f32x4 (&acc)[2][2][4][2], const float (&rsv)[2][4], const Unit& u, int wr, int wc, int fr, int fq) const {
        const int row0 = u.pm * BM + wr * 64 + fr, col0 = u.pn * BM + wc * 32 + 8 * fq;
#pragma unroll
        for (int ai = 0; ai < 2; ++ai)
#pragma unroll
            for (int m = 0; m < 4; ++m) { const int row = row0 + ai * HALF + m * 16; const float rs = (MODE == 1) ? rsv[ai][m] : 1.0f;
#pragma unroll
                for (int bj = 0; bj < 2; ++bj) if ((u.sub >> (2 * ai + bj)) & 1) { const size_t off = (size_t)row * 1024 + col0 + bj * HALF;
                    const u32x4 rw = *(const u32x4*)(XR + off);
                    f32x4 x0 = {__uint_as_float(rw.x << 16), __uint_as_float(rw.x & 0xffff0000u), __uint_as_float(rw.y << 16), __uint_as_float(rw.y & 0xffff0000u)};
                    f32x4 x1 = {__uint_as_float(rw.z << 16), __uint_as_float(rw.z & 0xffff0000u), __uint_as_float(rw.w << 16), __uint_as_float(rw.w & 0xffff0000u)};
                    if (MODE == 0) { x0 += acc[ai][bj][m][0] * scale; x1 += acc[ai][bj][m][1] * scale; }
                    else { const u32x4 pw = *(const u32x4*)(proj + off);
                        const f32x4 a0 = acc[ai][bj][m][0] * rs, a1 = acc[ai][bj][m][1] * rs;
                        x0[0] += sigmoid_f(a0[0]) * __uint_as_float(pw.x << 16); x0[1] += sigmoid_f(a0[1]) * __uint_as_float(pw.x & 0xffff0000u);
                        x0[2] += sigmoid_f(a0[2]) * __uint_as_float(pw.y << 16); x0[3] += sigmoid_f(a0[3]) * __uint_as_float(pw.y & 0xffff0000u);
                        x1[0] += sigmoid_f(a1[0]) * __uint_as_float(pw.z << 16); x1[1] += sigmoid_f(a1[1]) * __uint_as_float(pw.z & 0xffff0000u);
                        x1[2] += sigmoid_f(a1[2]) * __uint_as_float(pw.w << 16); x1[3] += sigmoid_f(a1[3]) * __uint_as_float(pw.w & 0xffff0000u); }
                    u32x4 w; w.x = cvt_pk_bf16(x0[0], x0[1]); w.y = cvt_pk_bf16(x0[2], x0[3]); w.z = cvt_pk_bf16(x1[0], x1[1]); w.w = cvt_pk_bf16(x1[2], x1[3]);
                    *(u32x4*)(XB + off) = w; }
                if ((m & 1) == 1) asm volatile("" ::: "memory"); }
    }
};

struct EpiNull { static constexpr bool PERM = true, AFTER_DRAIN = false, NEED_RS = false;
    __device__ __forceinline__ void operator()(const f32x4 (&acc)[2][2][4][2], const float (&rsv)[2][4], const Unit& u, int wr, int wc, int fr, int fq) const {
        float s = 0.f;
#pragma unroll
        for (int a = 0; a < 2; ++a) for (int b = 0; b < 2; ++b) for (int m = 0; m < 4; ++m) for (int n = 0; n < 2; ++n) s += acc[a][b][m][n][0] + acc[a][b][m][n][1] + acc[a][b][m][n][2] + acc[a][b][m][n][3];
        asm volatile("" :: "v"(s)); } };
template <class Epi, class Sched, bool ALIGN_EPI = false, bool SP2 = false>
__device__ __forceinline__ void gemm_phase(PG8_LAS unsigned char* lds, const Gemm g, const Sched& S, const Epi& E) {
    int tid_ = threadIdx.x; asm volatile("" : "+v"(tid_));
    const int tid = tid_, wid = __builtin_amdgcn_readfirstlane(tid >> 6), lane = tid & 63, wr = wid >> 2, wc = wid & 3, fr = lane & 15, fq = lane >> 4;
    int K_ = g.K; asm volatile("" : "+s"(K_));
    const int K = K_, nt = K / BK;
    unsigned voffA[2], voffB[2];
#pragma unroll
    for (int i = 0; i < 2; ++i) { int R, C; stage_rc(tid * 16 + i * 8192, R, C); const int Rb = Epi::PERM ? ((R & ~31) + perm32(R & 31)) : R;
        voffA[i] = (unsigned)(R * K + C) * 2u; voffB[i] = (unsigned)(Rb * K + C) * 2u; }
    const size_t kstep = (size_t)(BK * 2);
    const size_t hstep = (size_t)HALF * K * 2;
    const size_t tstep = 2 * hstep;
    const unsigned ldsw = (unsigned)wid * 1024u;
    const int aoff = lds_byte(wr * 64 + fr, fq * 8), boff = lds_byte(wc * 32 + fr, fq * 8);
#define PG8_SA(b, h) (((b) * 2 + (h)) * HTB)
#define PG8_SB(b, h) ((4 + (b) * 2 + (h)) * HTB)
#define PG8_STAGE(bufoff, gbase, voff) do { _Pragma("unroll") for (int _i = 0; _i < 2; ++_i) \
        __builtin_amdgcn_global_load_lds((const unsigned*)((const char*)(gbase) + (voff)[_i]), (PG8_LAS unsigned*)(lds + (bufoff) + ldsw + _i * 8192), 16, 0, 0); } while (0)
#define PG8_LDA(dst, b, h) do { _Pragma("unroll") for (int m = 0; m < 4; ++m) _Pragma("unroll") for (int k = 0; k < 2; ++k) dst[m][k] = *(const PG8_LAS bf16x8*)(lds + PG8_SA(b, h) + aoff + m * 2048 + k * 1024); } while (0)
#define PG8_LDB(dst, b, h) do { _Pragma("unroll") for (int n = 0; n < 2; ++n) _Pragma("unroll") for (int k = 0; k < 2; ++k) dst[n][k] = *(const PG8_LAS bf16x8*)(lds + PG8_SB(b, h) + boff + n * 2048 + k * 1024); } while (0)
#define PG8_MMA(ai, bj, At, Bt) do { __builtin_amdgcn_s_setprio(1); _Pragma("unroll") for (int m = 0; m < 4; ++m) _Pragma("unroll") for (int n = 0; n < 2; ++n) _Pragma("unroll") for (int k = 0; k < 2; ++k) \
        acc[ai][bj][m][n] = __builtin_amdgcn_mfma_f32_16x16x32_bf16(Bt[n][k], At[m][k], acc[ai][bj][m][n], 0, 0, 0); __builtin_amdgcn_s_setprio(0); } while (0)
#define PG8_SSQ(ai, kt) do { if constexpr (Epi::NEED_RS) { if (wc == ((kt) & 3)) { _Pragma("unroll") for (int k = 0; k < 2; ++k) _Pragma("unroll") for (int i_ = 0; i_ < 4; ++i_) _Pragma("unroll") for (int m = 0; m < 4; ++m) ssq[ai][m] = ssq2(At[m][k], i_, ssq[ai][m]); } } } while (0)
#define PG8_WAIT_V(n) asm volatile("s_waitcnt vmcnt(" #n ")" ::: "memory")
#define PG8_WAIT_L(n) asm volatile("s_waitcnt lgkmcnt(" #n ")" ::: "memory")
#define PG8_BAR __builtin_amdgcn_s_barrier()
#define PG8_SCHED __builtin_amdgcn_sched_barrier(0)
    Unit cur, nxt; int ui = 0;
    if (!S.next(0, cur)) return;
    f32x4 acc[2][2][4][2];
#pragma unroll
    for (int a = 0; a < 2; ++a)
#pragma unroll
        for (int b = 0; b < 2; ++b)
#pragma unroll
            for (int m = 0; m < 4; ++m)
#pragma unroll
                for (int n = 0; n < 2; ++n) acc[a][b][m][n] = (f32x4){0.f, 0.f, 0.f, 0.f};
    bf16x8 At[4][2], B0[2][2], B1[2][2];
    float ssq[2][4] = {{0.f, 0.f, 0.f, 0.f}, {0.f, 0.f, 0.f, 0.f}};
    static_assert(SP2 || !Epi::NEED_RS, "row statistics are gathered in the SP2 loop only");
    const char* cA = (const char*)g.A + (size_t)cur.pm * tstep; const char* cB = (const char*)g.Bt + (size_t)cur.pn * tstep;
    S.a_ready(cur);
    if constexpr (SP2) {
        PG8_STAGE(PG8_SB(0, 0), cB, voffB); PG8_STAGE(PG8_SB(0, 1), cB + hstep, voffB); PG8_STAGE(PG8_SA(0, 0), cA, voffA); PG8_STAGE(PG8_SA(0, 1), cA + hstep, voffA);
        if (wr == 1) PG8_BAR;
        PG8_WAIT_V(2); PG8_BAR;
        PG8_STAGE(PG8_SB(1, 0), cB + kstep, voffB); PG8_STAGE(PG8_SA(1, 0), cA + kstep, voffA); PG8_STAGE(PG8_SB(1, 1), cB + hstep + kstep, voffB);
        PG8_WAIT_V(6); PG8_BAR;
    } else {
        PG8_STAGE(PG8_SB(0, 0), cB, voffB); PG8_STAGE(PG8_SA(0, 0), cA, voffA); PG8_STAGE(PG8_SB(0, 1), cB + hstep, voffB); PG8_STAGE(PG8_SA(0, 1), cA + hstep, voffA);
        if (wr == 1) PG8_BAR;
        PG8_WAIT_V(4); PG8_BAR;
        PG8_STAGE(PG8_SB(1, 0), cB + kstep, voffB); PG8_STAGE(PG8_SA(1, 0), cA + kstep, voffA); PG8_STAGE(PG8_SB(1, 1), cB + hstep + kstep, voffB);
        PG8_WAIT_V(6); PG8_BAR;
    }
    for (;;) {
        const int mk = __builtin_amdgcn_readfirstlane(cur.sub);
        const bool has_next = S.next(ui + 1, nxt);
        const char* nA = has_next ? (const char*)g.A + (size_t)nxt.pm * tstep : cA; const char* nB = has_next ? (const char*)g.Bt + (size_t)nxt.pn * tstep : cB;
        for (int t = 0; t < nt; t += 2) {
            const bool last = (t == nt - 2);
            const char* a1 = cA + (size_t)(t + 1) * kstep;
            const char* a2 = last ? nA : cA + (size_t)(t + 2) * kstep; const char* b2 = last ? nB : cB + (size_t)(t + 2) * kstep;
            const char* a3 = a2 + kstep; const char* b3 = b2 + kstep;
            if (last && has_next) S.a_ready(nxt);
            if constexpr (SP2) {
            PG8_LDB(B0, 0, 0); PG8_LDB(B1, 0, 1); PG8_SCHED; PG8_LDA(At, 0, 0); PG8_STAGE(PG8_SA(1, 1), a1 + hstep, voffA);
            PG8_WAIT_V(8); PG8_WAIT_L(0); PG8_BAR; if (mk & 1) PG8_MMA(0, 0, At, B0); PG8_SSQ(0, t); if (mk & 2) PG8_MMA(0, 1, At, B1); PG8_BAR; PG8_SCHED;
            PG8_LDA(At, 0, 1); PG8_STAGE(PG8_SB(0, 0), b2, voffB); PG8_STAGE(PG8_SB(0, 1), b2 + hstep, voffB); PG8_STAGE(PG8_SA(0, 0), a2, voffA);
            PG8_WAIT_V(8); PG8_WAIT_L(0); PG8_BAR; if (mk & 4) PG8_MMA(1, 0, At, B0); PG8_SSQ(1, t); if (mk & 8) PG8_MMA(1, 1, At, B1); PG8_BAR; PG8_SCHED;
            PG8_LDB(B0, 1, 0); PG8_LDB(B1, 1, 1); PG8_SCHED; PG8_LDA(At, 1, 0); PG8_STAGE(PG8_SA(0, 1), a2 + hstep, voffA);
            PG8_WAIT_V(8); PG8_WAIT_L(0); PG8_BAR; if (mk & 1) PG8_MMA(0, 0, At, B0); PG8_SSQ(0, t + 1); if (mk & 2) PG8_MMA(0, 1, At, B1); PG8_BAR; PG8_SCHED;
            PG8_LDA(At, 1, 1); PG8_STAGE(PG8_SB(1, 0), b3, voffB); PG8_STAGE(PG8_SB(1, 1), b3 + hstep, voffB); PG8_STAGE(PG8_SA(1, 0), a3, voffA);
            PG8_WAIT_V(8); PG8_WAIT_L(0); PG8_BAR; if (mk & 4) PG8_MMA(1, 0, At, B0); PG8_SSQ(1, t + 1); if (mk & 8) PG8_MMA(1, 1, At, B1); PG8_BAR; PG8_SCHED;
            } else {
            PG8_LDB(B0, 0, 0); PG8_SCHED; PG8_LDA(At, 0, 0); PG8_STAGE(PG8_SA(1, 1), a1 + hstep, voffA);
            PG8_WAIT_L(8); PG8_BAR; PG8_WAIT_L(0); PG8_MMA(0, 0, At, B0); PG8_BAR; PG8_SCHED;
            PG8_LDB(B1, 0, 1); PG8_STAGE(PG8_SB(0, 0), b2, voffB);
            PG8_BAR; PG8_WAIT_L(0); PG8_MMA(0, 1, At, B1); PG8_BAR;
            PG8_LDA(At, 0, 1); PG8_STAGE(PG8_SA(0, 0), a2, voffA);
            PG8_BAR; PG8_WAIT_L(0); PG8_MMA(1, 0, At, B0); PG8_BAR; PG8_SCHED;
            PG8_STAGE(PG8_SB(0, 1), b2 + hstep, voffB);
            PG8_WAIT_V(6); PG8_BAR; PG8_MMA(1, 1, At, B1); PG8_BAR;
            PG8_LDB(B0, 1, 0); PG8_SCHED; PG8_LDA(At, 1, 0); PG8_STAGE(PG8_SA(0, 1), a2 + hstep, voffA);
            PG8_WAIT_L(8); PG8_BAR; PG8_WAIT_L(0); PG8_MMA(0, 0, At, B0); PG8_BAR; PG8_SCHED;
            PG8_LDB(B1, 1, 1); PG8_STAGE(PG8_SB(1, 0), b3, voffB);
            PG8_BAR; PG8_WAIT_L(0); PG8_MMA(0, 1, At, B1); PG8_BAR;
            PG8_LDA(At, 1, 1); PG8_STAGE(PG8_SA(1, 0), a3, voffA);
            PG8_BAR; PG8_WAIT_L(0); PG8_MMA(1, 0, At, B0); PG8_BAR; PG8_SCHED;
            PG8_STAGE(PG8_SB(1, 1), b3 + hstep, voffB);
            PG8_WAIT_V(6); PG8_BAR; PG8_MMA(1, 1, At, B1); PG8_BAR;
            }
        }
        if constexpr (ALIGN_EPI) { if (wr == 0) PG8_BAR; }
        { float rsv[2][4];
            if constexpr (Epi::NEED_RS) {
                static_assert(ALIGN_EPI, "the row-statistics exchange needs both halves at the same barrier");
                PG8_LAS float* rst = (PG8_LAS float*)(lds + STAGE_BYTES + 1024);
#pragma unroll
                for (int a = 0; a < 2; ++a)
#pragma unroll
                    for (int m = 0; m < 4; ++m) { float q = ssq[a][m]; q += __shfl_xor(q, 16); q += __shfl_xor(q, 32); if (fq == 0) rst[wc * 256 + a * HALF + wr * 64 + m * 16 + fr] = q; ssq[a][m] = 0.f; }
                PG8_WAIT_L(0); PG8_BAR; asm volatile("" ::: "memory");
#pragma unroll
                for (int a = 0; a < 2; ++a)
#pragma unroll
                    for (int m = 0; m < 4; ++m) { const int r_ = a * HALF + wr * 64 + m * 16 + fr; const float q = (rst[r_] + rst[256 + r_]) + (rst[512 + r_] + rst[768 + r_]);
                        rsv[a][m] = __builtin_amdgcn_rsqf(q * (1.0f / 1024.0f) + RMS_EPS); }
            } else {
#pragma unroll
                for (int a = 0; a < 2; ++a)
#pragma unroll
                    for (int m = 0; m < 4; ++m) rsv[a][m] = 1.0f;
            }
            E(acc, rsv, cur, wr, wc, fr, fq); S.done(cur); }
        if (!has_next) break;
#pragma unroll
        for (int a = 0; a < 2; ++a)
#pragma unroll
            for (int b = 0; b < 2; ++b)
#pragma unroll
                for (int m = 0; m < 4; ++m)
#pragma unroll
                    for (int n = 0; n < 2; ++n) acc[a][b][m][n] = (f32x4){0.f, 0.f, 0.f, 0.f};
        cur = nxt; cA = nA; cB = nB; ++ui;
        if constexpr (ALIGN_EPI) { if (wr == 1) PG8_BAR; }
    }
    PG8_WAIT_V(0);
    if constexpr (!ALIGN_EPI) { if (wr == 0) PG8_BAR; }
    PG8_BAR;
#undef PG8_SA
#undef PG8_SB
#undef PG8_STAGE
#undef PG8_LDA
#undef PG8_LDB
#undef PG8_MMA
#undef PG8_SSQ
#undef PG8_WAIT_V
#undef PG8_WAIT_L
#undef PG8_BAR
#undef PG8_SCHED
}
}
constexpr int NWAVES = 8;
constexpr int D = 1024, FF = 2816, NGU = 2 * FF, MIXW = 2048, DPLE = 256, DEPTH = 2;
constexpr int BATCH = 8, SEQ = 2048, DECB = 128, DECS = 8;
constexpr int MP = BATCH * SEQ, MS = DECB * DECS, M = MP + MS;
constexpr int NIN = 33;
constexpr size_t MiB = 1u << 20;
constexpr size_t WS_CTL = 0, CTL_ZERO_BYTES = 64 * 1024;
constexpr size_t WS_W = 1 * MiB;
constexpr size_t W_GU = (size_t)NGU * D * 2, W_DN = (size_t)D * FF * 2, W_MI = (size_t)MIXW * D * 2, W_MO = (size_t)D * D * 2, W_PG = (size_t)D * D * 2, W_PP = (size_t)D * DPLE * 2;
constexpr size_t WO_GU1 = 0, WO_D1 = WO_GU1 + W_GU, WO_MI = WO_D1 + W_DN, WO_MO = WO_MI + W_MI, WO_GU2 = WO_MO + W_MO, WO_D2 = WO_GU2 + W_GU, WO_PG = WO_D2 + W_DN, WO_PP = WO_PG + W_PG, W_LAYER = WO_PP + W_PP;
constexpr size_t WS_BUFA = WS_W + DEPTH * W_LAYER;
constexpr size_t BUF_BYTES = (size_t)M * D * 2;
constexpr size_t WS_BUFB = WS_BUFA + BUF_BYTES;
constexpr size_t WS_PB = WS_BUFB + BUF_BYTES;
constexpr size_t WS_ACT = WS_PB + (size_t)DEPTH * M * DPLE * 2;
constexpr size_t WS_END = WS_ACT + (size_t)M * FF * 2;
static_assert(WS_W % 256 == 0 && W_LAYER % 256 == 0 && WS_BUFA % 256 == 0 && WS_PB % 256 == 0 && WS_ACT % 256 == 0, "alignment");
constexpr int CW_BAR = 1024;
constexpr int RING_OFF = 0, RING_BYTES = 131072;
constexpr int LDSCTL_OFF = RING_BYTES, MISC_OFF = LDSCTL_OFF + 320;
constexpr int LDS_BYTES = 147456;
#define GAS __attribute__((address_space(1)))
#define LAS __attribute__((address_space(3)))
typedef unsigned short bf16;
typedef unsigned v4u __attribute__((ext_vector_type(4)));
typedef float f32x4 __attribute__((ext_vector_type(4)));
typedef short bf16x8 __attribute__((ext_vector_type(8)));
typedef GAS unsigned gu32;
typedef GAS unsigned long long gu64;
#define RLX_AGENT __ATOMIC_RELAXED, __HIP_MEMORY_SCOPE_AGENT
#define LDS_WAIT() asm volatile("s_waitcnt lgkmcnt(0)" ::: "memory")
#define VM_WAIT() asm volatile("s_waitcnt vmcnt(0)" ::: "memory")
__device__ __forceinline__ unsigned long long rt() { return __builtin_amdgcn_s_memrealtime(); }
__device__ __forceinline__ unsigned pk2(float lo, float hi) { unsigned r; asm("v_cvt_pk_bf16_f32 %0, %1, %2" : "=v"(r) : "v"(lo), "v"(hi)); return r; }
__device__ __forceinline__ unsigned f2bf(float f) { return pk2(f, f) & 0xffffu; }
#define XB_TMO      128
#define XB_XCNT(j)  (256  + 64 * (j))
#define XB_XSUB(j)  (1280 + 64 * (j))
#define XB_XGEN(j)  (2304 + 64 * (j))
#define XB_TOP      3328
#define XB_TOPGEN   3392
#define XCD_BAR_WORDS 3456
#define XB_SPIN_CAP (1u << 18)

__device__ __forceinline__ unsigned xb_ld(unsigned* p)              { return __hip_atomic_load(p, __ATOMIC_RELAXED, __HIP_MEMORY_SCOPE_AGENT); }
__device__ __forceinline__ unsigned xb_add(unsigned* p, unsigned v) { return __hip_atomic_fetch_add(p, v, __ATOMIC_RELAXED, __HIP_MEMORY_SCOPE_AGENT); }
__device__ __forceinline__ unsigned xb_xcc_id() { return (unsigned)__builtin_amdgcn_s_getreg((3 << 11) | 20) & 0xFu; }
#define XB_SPIN(cond, bar) do { unsigned _sp = 0; while (cond) { __builtin_amdgcn_s_sleep(1); \
    if ((++_sp & 255u) == 0u) { if (xb_ld(&(bar)[XB_TMO])) break; if (_sp > XB_SPIN_CAP) { atomicAdd(&(bar)[XB_TMO], 1u); break; } } } } while (0)

struct XcdBarrier {
    unsigned* bar; unsigned x;
    volatile LAS unsigned* st;
};

__device__ __forceinline__ XcdBarrier xcd_barrier_post(unsigned* bar, volatile LAS unsigned* st) {
    XcdBarrier b; b.bar = bar; b.x = xb_xcc_id(); b.st = st;
    if (threadIdx.x == 0) st[4] = xb_add(&bar[XB_XCNT(b.x)], 1u);
    return b;
}
__device__ __forceinline__ void xcd_barrier_complete(unsigned* bar, unsigned x, unsigned& nloc, unsigned& nx) {
    const unsigned G = gridDim.x * gridDim.y * gridDim.z;
    unsigned sum, cnt, mine, sp = 0u;
    for (;;) {
        sum = 0u; cnt = 0u; mine = 0u;
#pragma nounroll
        for (unsigned j = 0; j < 16; ++j) { const unsigned c = xb_ld(&bar[XB_XCNT(j)]); sum += c; cnt += (c > 0u) ? 1u : 0u; mine = (j == x) ? c : mine; }
        if (sum == G) break;
        __builtin_amdgcn_s_sleep(1);
        if ((++sp & 255u) == 0u) { if (xb_ld(&bar[XB_TMO])) break; if (sp > XB_SPIN_CAP) { atomicAdd(&bar[XB_TMO], 1u); break; } }
    }
    nloc = mine > 0u ? mine : 1u; nx = cnt > 0u ? cnt : 1u;
}

__device__ __forceinline__ void xcd_barrier(const XcdBarrier& b) {
    asm volatile("s_waitcnt vmcnt(0)" ::: "memory");
    __syncthreads();
    if (threadIdx.x == 0) {
        unsigned* bar = b.bar; const unsigned bx_ = xb_xcc_id();
        __builtin_amdgcn_s_waitcnt(0);
        unsigned nloc = b.st[0], nx = b.st[1];
        if (nloc == 0u) { xcd_barrier_complete(bar, bx_, nloc, nx); b.st[0] = nloc; b.st[1] = nx; }
        asm volatile("buffer_inv sc1" ::: "memory");
        const unsigned old = xb_add(&bar[XB_XSUB(bx_)], 1u);
        const unsigned gen = old / nloc;
        if (old + 1u == (gen + 1u) * nloc) {
            __builtin_amdgcn_fence(__ATOMIC_RELEASE, "agent");
            asm volatile("s_waitcnt vmcnt(0)" ::: "memory");
            const unsigned og = xb_add(&bar[XB_TOP], 1u);
            const unsigned tg = og / nx;
            if (og + 1u == (tg + 1u) * nx) xb_add(&bar[XB_TOPGEN], 1u);
            else XB_SPIN(xb_ld(&bar[XB_TOPGEN]) == tg, bar);
            asm volatile("" ::: "memory");
            xb_add(&bar[XB_XGEN(bx_)], 1u);
            asm volatile("s_waitcnt vmcnt(0)" ::: "memory");
        } else {
            XB_SPIN(xb_ld(&bar[XB_XGEN(bx_)]) == gen, bar);
            asm volatile("" ::: "memory");
            asm volatile("s_waitcnt vmcnt(0)" ::: "memory");
        }
    }
    __syncthreads();
}

__device__ __forceinline__ int opaque_s(int v) { asm volatile("" : "+s"(v)); return v; }
struct Args { const float* in[NIN]; float* out; unsigned char* ws; };
struct Frame {
    LAS unsigned char* lds;
    int tid, lane, wave, vcu, G;
};
template <int CTRL> __device__ __forceinline__ float dpp_add(float v) {
    const int vi = __builtin_bit_cast(int, v);
    return v + __builtin_bit_cast(float, __builtin_amdgcn_update_dpp(vi, vi, CTRL, 0xF, 0xF, false));
}
__device__ __forceinline__ float wave_sum(float v) {
    v = dpp_add<0xB1>(v); v = dpp_add<0x4E>(v); v = dpp_add<0x141>(v); v = dpp_add<0x140>(v);
    v = dpp_add<0x142>(v);
    v = dpp_add<0x143>(v);
    return __builtin_bit_cast(float, __builtin_amdgcn_readlane(__builtin_bit_cast(int, v), 63));
}
#define WS4_STEP(ctl) "v_add_f32_dpp %0, %0, %0 " ctl " row_mask:0xf bank_mask:0xf\n\tv_add_f32_dpp %1, %1, %1 " ctl " row_mask:0xf bank_mask:0xf\n\tv_add_f32_dpp %2, %2, %2 " ctl " row_mask:0xf bank_mask:0xf\n\tv_add_f32_dpp %3, %3, %3 " ctl " row_mask:0xf bank_mask:0xf\n\t"
__device__ __forceinline__ void wave_sum4(float& a, float& b, float& c, float& d) {
    asm volatile("s_nop 1\n\t" WS4_STEP("quad_perm:[1,0,3,2]") WS4_STEP("quad_perm:[2,3,0,1]") WS4_STEP("row_half_mirror") WS4_STEP("row_mirror") WS4_STEP("row_bcast:15") WS4_STEP("row_bcast:31") "s_nop 1"
                 : "+v"(a), "+v"(b), "+v"(c), "+v"(d));
    a = __builtin_bit_cast(float, __builtin_amdgcn_readlane(__builtin_bit_cast(int, a), 63)); b = __builtin_bit_cast(float, __builtin_amdgcn_readlane(__builtin_bit_cast(int, b), 63));
    c = __builtin_bit_cast(float, __builtin_amdgcn_readlane(__builtin_bit_cast(int, c), 63)); d = __builtin_bit_cast(float, __builtin_amdgcn_readlane(__builtin_bit_cast(int, d), 63));
}
__device__ __forceinline__ void ln8_stats(const float (&v)[8], float (&mean)[8], float (&rstd)[8], float eps) {
    float s[8];
#pragma unroll
    for (int r = 0; r < 8; ++r) s[r] = v[r];
    wave_sum4(s[0], s[1], s[2], s[3]); wave_sum4(s[4], s[5], s[6], s[7]);
#pragma unroll
    for (int r = 0; r < 8; ++r) { mean[r] = s[r] * (1.f / 64.f); const float dv = v[r] - mean[r]; s[r] = dv * dv; }
    wave_sum4(s[0], s[1], s[2], s[3]); wave_sum4(s[4], s[5], s[6], s[7]);
#pragma unroll
    for (int r = 0; r < 8; ++r) rstd[r] = __builtin_amdgcn_rsqf(s[r] * (1.f / 64.f) + eps);
}
__device__ __forceinline__ float bf2f(bf16 v) { return __uint_as_float((unsigned)v << 16); }
__device__ __forceinline__ float gelu_tanh(float v) {
    const float t = 1.5957691216057308f * (v + 0.044715f * v * v * v);
    return v * __builtin_amdgcn_rcpf(1.0f + __builtin_amdgcn_exp2f(t * -1.4426950408889634f));
}
__device__ __forceinline__ void p0_transpose_item(const float* W, int K, int N, bf16* WT, const float* gain, int mode, LAS float* scr, int item, int lane) {
    const int nblk = N / 64, kb = item / nblk, nb = item % nblk, k0 = 32 * kb, n0 = 64 * nb;
    const int c4 = (lane & 15) * 4, kq = lane >> 4;
    f32x4 v[8];
#pragma unroll
    for (int i = 0; i < 8; ++i) v[i] = __builtin_nontemporal_load((const f32x4*)(W + (size_t)(k0 + 4 * i + kq) * N + n0 + c4));
#pragma unroll
    for (int i = 0; i < 8; ++i) { const int kk = 4 * i + kq; const float g = gain ? gain[k0 + kk] : 1.0f; LAS float* s = scr + kk * 65 + c4;
        s[0] = v[i].x * g; s[1] = v[i].y * g; s[2] = v[i].z * g; s[3] = v[i].w * g; }
    LDS_WAIT(); asm volatile("" ::: "memory");
    const int c = lane & 3;
    const int rbase = (mode == 0) ? n0 : (256 * (n0 >> 7) + (n0 & 127) + (mode == 2 ? 128 : 0));
#pragma unroll
    for (int j = 0; j < 4; ++j) { const int n = (lane >> 2) + 16 * j; const LAS float* s = scr + (8 * c) * 65 + n;
        v4u o; o.x = pk2(s[0 * 65], s[1 * 65]); o.y = pk2(s[2 * 65], s[3 * 65]); o.z = pk2(s[4 * 65], s[5 * 65]); o.w = pk2(s[6 * 65], s[7 * 65]);
        *(GAS v4u*)(WT + (size_t)(rbase + n) * K + k0 + 8 * c) = o; }
    LDS_WAIT(); asm volatile("" ::: "memory");
}
__device__ __forceinline__ void p0_convert(Frame& F, const Args& args, int it0, int it1, int gw, int NGW) {
    LAS float* scr = (LAS float*)(F.lds + RING_OFF + F.wave * 16384);
    unsigned char* ws = args.ws;
    constexpr int I_GU = (D / 32) * (FF / 64), I_DN = (FF / 32) * (D / 64), I_MI = (D / 32) * (MIXW / 64), I_SQ = (D / 32) * (D / 64), I_PP = (DPLE / 32) * (D / 64);
    constexpr int I_LAYER = 6 * I_GU + I_MI + 2 * I_SQ + I_PP;
    static_assert(I_DN == I_GU, "item counts");
    for (int it = it0 + gw; it < it1; it += NGW) {
        const int li = it / I_LAYER; int r = it % I_LAYER;
        unsigned char* wl = ws + WS_W + (size_t)li * W_LAYER;
        if (r < I_GU) { p0_transpose_item(args.in[opaque_s(8)] + (size_t)li * D * FF, D, FF, (bf16*)(wl + WO_GU1), args.in[opaque_s(7)] + li * D, 1, scr, r, F.lane); continue; } r -= I_GU;
        if (r < I_GU) { p0_transpose_item(args.in[opaque_s(9)] + (size_t)li * D * FF, D, FF, (bf16*)(wl + WO_GU1), args.in[opaque_s(7)] + li * D, 2, scr, r, F.lane); continue; } r -= I_GU;
        if (r < I_GU) { p0_transpose_item(args.in[opaque_s(10)] + (size_t)li * D * FF, FF, D, (bf16*)(wl + WO_D1), nullptr, 0, scr, r, F.lane); continue; } r -= I_GU;
        if (r < I_GU) { p0_transpose_item(args.in[opaque_s(26)] + (size_t)li * D * FF, D, FF, (bf16*)(wl + WO_GU2), args.in[opaque_s(25)] + li * D, 1, scr, r, F.lane); continue; } r -= I_GU;
        if (r < I_GU) { p0_transpose_item(args.in[opaque_s(27)] + (size_t)li * D * FF, D, FF, (bf16*)(wl + WO_GU2), args.in[opaque_s(25)] + li * D, 2, scr, r, F.lane); continue; } r -= I_GU;
        if (r < I_GU) { p0_transpose_item(args.in[opaque_s(28)] + (size_t)li * D * FF, FF, D, (bf16*)(wl + WO_D2), nullptr, 0, scr, r, F.lane); continue; } r -= I_GU;
        if (r < I_MI) { p0_transpose_item(args.in[opaque_s(12)] + (size_t)li * D * MIXW, D, MIXW, (bf16*)(wl + WO_MI), args.in[opaque_s(11)] + li * D, 0, scr, r, F.lane); continue; } r -= I_MI;
        if (r < I_SQ) { p0_transpose_item(args.in[opaque_s(24)] + (size_t)li * D * D, D, D, (bf16*)(wl + WO_MO), nullptr, 0, scr, r, F.lane); continue; } r -= I_SQ;
        if (r < I_SQ) { p0_transpose_item(args.in[opaque_s(30)] + (size_t)li * D * D, D, D, (bf16*)(wl + WO_PG), args.in[opaque_s(29)] + li * D, 0, scr, r, F.lane); continue; } r -= I_SQ;
        p0_transpose_item(args.in[opaque_s(31)] + (size_t)li * DPLE * D, DPLE, D, (bf16*)(wl + WO_PP), nullptr, 0, scr, r, F.lane);
    }
}
constexpr int P0_I_LAYER = 6 * (D / 32) * (FF / 64) + (D / 32) * (MIXW / 64) + 2 * (D / 32) * (D / 64) + (DPLE / 32) * (D / 64);
__device__ __forceinline__ void p0_prologue(Frame& F, const Args& args) {
    const int gw = F.vcu * NWAVES + F.wave, NGW = F.G * NWAVES;
    unsigned char* ws = args.ws;
    p0_convert(F, args, 0, P0_I_LAYER, gw, NGW);
    float* X = args.out; bf16* XB = (bf16*)(ws + WS_BUFA);
    for (int m = gw; m < M; m += NGW) {
        const float* src = (m < MP) ? args.in[opaque_s(0)] + (size_t)m * D : args.in[opaque_s(1)] + (size_t)(m - MP) * D;
        const GAS f32x4* xr = (const GAS f32x4*)src + F.lane; GAS f32x4* xo = (GAS f32x4*)(X + (size_t)m * D) + F.lane;
        GAS unsigned long long* o8 = (GAS unsigned long long*)(XB + (size_t)m * D) + F.lane;
#pragma unroll
        for (int j = 0; j < 4; ++j) { const f32x4 v = xr[64 * j];
            o8[64 * j] = (unsigned long long)pk2(v.x, v.y) | ((unsigned long long)pk2(v.z, v.w) << 32); }
    }
    bf16* PB = (bf16*)(ws + WS_PB);
    for (int q = gw; q < DEPTH * M; q += NGW) {
        const int li = q / M, m = q % M;
        const float* src = (m < MP) ? args.in[opaque_s(2)] + ((size_t)li * MP + m) * DPLE : args.in[opaque_s(3)] + ((size_t)li * MS + (m - MP)) * DPLE;
        const f32x4 v = ((const GAS f32x4*)src)[F.lane];
        ((GAS unsigned long long*)(PB + (size_t)q * DPLE))[F.lane] = (unsigned long long)pk2(v.x, v.y) | ((unsigned long long)pk2(v.z, v.w) << 32);
    }
}
__device__ __forceinline__ void final_norm(Frame& F, const Args& args, const bf16* XBF) {
    const int gw = F.vcu * NWAVES + F.wave, NGW = F.G * NWAVES;
    float* Y = args.out; const float* g = args.in[opaque_s(32)];
    f32x4 gv[4];
#pragma unroll
    for (int j = 0; j < 4; ++j) gv[j] = ((const GAS f32x4*)g)[4 * F.lane + j];
    for (int m = gw; m < M; m += NGW) {
        const GAS v4u* xr = (const GAS v4u*)(XBF + (size_t)m * D) + 2 * F.lane;
        const v4u r0 = xr[0], r1 = xr[1];
        f32x4 v[4];
        v[0] = (f32x4){__uint_as_float(r0.x << 16), __uint_as_float(r0.x & 0xffff0000u), __uint_as_float(r0.y << 16), __uint_as_float(r0.y & 0xffff0000u)};
        v[1] = (f32x4){__uint_as_float(r0.z << 16), __uint_as_float(r0.z & 0xffff0000u), __uint_as_float(r0.w << 16), __uint_as_float(r0.w & 0xffff0000u)};
        v[2] = (f32x4){__uint_as_float(r1.x << 16), __uint_as_float(r1.x & 0xffff0000u), __uint_as_float(r1.y << 16), __uint_as_float(r1.y & 0xffff0000u)};
        v[3] = (f32x4){__uint_as_float(r1.z << 16), __uint_as_float(r1.z & 0xffff0000u), __uint_as_float(r1.w << 16), __uint_as_float(r1.w & 0xffff0000u)};
        float s_ = 0.f;
#pragma unroll
        for (int j = 0; j < 4; ++j) s_ += (v[j].x * v[j].x + v[j].y * v[j].y) + (v[j].z * v[j].z + v[j].w * v[j].w);
        const float rs = __builtin_amdgcn_rsqf(wave_sum(s_) * (1.0f / D) + pg8::RMS_EPS);
        GAS f32x4* yo = (GAS f32x4*)(Y + (size_t)m * D) + 4 * F.lane;
#pragma unroll
        for (int j = 0; j < 4; ++j) yo[j] = v[j] * rs * gv[j];
    }
}
constexpr size_t O_Y = 0, O_CA_P = (size_t)M * D, O_CA_S = O_CA_P + (size_t)DEPTH * BATCH * 30 * 256, O_PL_P = O_CA_S + (size_t)DEPTH * DECB * 30 * 256,
                 O_PL_S = O_PL_P + (size_t)DEPTH * BATCH * 15 * 256, O_SC_P = O_PL_S + (size_t)DEPTH * DECB * 15 * 256, O_SC_S = O_SC_P + (size_t)DEPTH * BATCH * 2 * 256,
                 O_CV_S = O_SC_S + (size_t)DEPTH * DECB * 2 * 256, O_END = O_CV_S + (size_t)DEPTH * DECB * DECS * 256;
constexpr float LN_EPS = 1e-6f;
constexpr int VNT_OFF = 0, VNT_PITCH = 272, WPT_OFF = 64 * VNT_PITCH, WPT_PITCH = 144, DT_OFF = WPT_OFF + 64 * WPT_PITCH, DT_PITCH = 144;
struct MixP { const bf16* Z; bf16* MIX; const float *caw, *cab, *nag, *nab, *pw, *ps, *sng, *snb, *sw, *sb, *scw; float* out; int li; const float *st_a, *st_p, *st_s; };
#define OPAQUE_S(p) asm volatile("" : "+s"(p))
template <class T> __device__ __forceinline__ T* uni_ptr(T* p) {
    const unsigned long long v = (unsigned long long)p; const unsigned lo = __builtin_amdgcn_readfirstlane((unsigned)v), hi = __builtin_amdgcn_readfirstlane((unsigned)(v >> 32));
    return (T*)(((unsigned long long)hi << 32) | lo); }
__device__ __forceinline__ bf16 f2bf16(float f) { return (bf16)f2bf(f); }
__device__ __forceinline__ float pool_sel(int h, float s2, float s4, float s8, float s16) { return h == 0 ? s2 : (h == 1 ? s4 : (h == 2 ? s8 : s16)); }

__device__ __forceinline__ void mix_prompt_unit(Frame& F, const MixP& P, int b, int c, int h) {
    const int w = F.wave, lane = F.lane, ch = h * 64 + lane, fr = lane & 15, fq = lane >> 4;
    const int tb = __builtin_amdgcn_readfirstlane(128 * c + 16 * w);
    const bf16* Zs = uni_ptr(P.Z + (size_t)b * SEQ * MIXW);
    bf16* Ms = uni_ptr(P.MIX + (size_t)b * SEQ * D);
    const int li = P.li;
    { const int n = F.tid & 63, kg = F.tid >> 6; const float* src = P.pw + (size_t)h * 4096 + (size_t)(8 * kg) * 64 + n;
      v4u o; o.x = pk2(src[0], src[64]); o.y = pk2(src[128], src[192]); o.z = pk2(src[256], src[320]); o.w = pk2(src[384], src[448]);
      *(LAS v4u*)(F.lds + WPT_OFF + n * WPT_PITCH + kg * 16) = o; }
    {
        float wA[31];
        { const float* wp = P.caw;
#pragma unroll
        for (int k = 0; k < 31; ++k) { wA[k] = wp[ch]; wp += 256; OPAQUE_S(wp); } }
        float ext[46];
        { const bf16* zp = uni_ptr(Zs + ((ptrdiff_t)(tb - 30) * MIXW));
#pragma unroll
        for (int j = 0; j < 46; ++j) { const bool ok = (tb - 30 + j) >= 0; const bf16* zq = ok ? zp : Zs; const float msk = ok ? 1.f : 0.f;
            const float av = bf2f(zq[ch]), ag = bf2f(zq[256 + ch]); ext[j] = av * pg8::sigmoid_f(ag) * msk; zp += MIXW; OPAQUE_S(zp); } }
        const float bias = P.cab[ch], g = P.nag[ch], nb = P.nab[ch];
        bf16* mp = uni_ptr(Ms + (size_t)tb * D);
        float* sp = uni_ptr(P.out + O_CA_P + ((ptrdiff_t)(li * BATCH + b) * 30 + (tb - (SEQ - 30))) * 256);
#pragma unroll
        for (int r = 0; r < 16; ++r) { float cv = bias;
#pragma unroll
            for (int k = 0; k < 31; ++k) cv += wA[k] * ext[r + k];
            const float mean = wave_sum(cv) * (1.f / 64.f), dv = cv - mean, var = wave_sum(dv * dv) * (1.f / 64.f);
            const float y = dv * __builtin_amdgcn_rsqf(var + LN_EPS) * g + nb;
            mp[ch] = f2bf16(pg8::silu_f(y)); mp += D; OPAQUE_S(mp);
            if (c == 15 && tb + r >= SEQ - 30) sp[ch] = ext[r + 30];
            sp += 256; OPAQUE_S(sp); }
    }
    {
        float ze[31];
        { const bf16* zp = uni_ptr(Zs + ((ptrdiff_t)(tb - 15) * MIXW));
#pragma unroll
        for (int j = 0; j < 31; ++j) { const bool ok = (tb - 15 + j) >= 0; const bf16* zq = ok ? zp : Zs; ze[j] = bf2f(zq[512 + ch]) * (ok ? 1.f : 0.f); zp += MIXW; OPAQUE_S(zp); } }
        float* sp = uni_ptr(P.out + O_PL_P + ((ptrdiff_t)(li * BATCH + b) * 15 + (tb - (SEQ - 15))) * 256);
        LAS unsigned char* dT = F.lds + DT_OFF + w * 16 * DT_PITCH;
        const int win = 2 << h;
#pragma unroll
        for (int r = 0; r < 16; ++r) { const float zc = ze[r + 15];
            const float s2 = zc + ze[r + 14], s4 = s2 + (ze[r + 13] + ze[r + 12]), s8 = s4 + ((ze[r + 11] + ze[r + 10]) + (ze[r + 9] + ze[r + 8]));
            const float s16 = s8 + (((ze[r + 7] + ze[r + 6]) + (ze[r + 5] + ze[r + 4])) + ((ze[r + 3] + ze[r + 2]) + (ze[r + 1] + ze[r])));
            const int t = tb + r; const float cnt = (float)((t + 1 < win) ? t + 1 : win);
            const float d = pool_sel(h, s2, s4, s8, s16) / cnt - zc;
            *(LAS bf16*)(dT + r * DT_PITCH + lane * 2) = f2bf16(d);
            if (c == 15 && t >= SEQ - 15) sp[ch] = zc;
            sp += 256; OPAQUE_S(sp); }
    }
    __syncthreads();
    {
        const LAS unsigned char* dT = F.lds + DT_OFF + w * 16 * DT_PITCH;
        const bf16x8 b0 = *(const LAS bf16x8*)(dT + fr * DT_PITCH + (fq * 8) * 2), b1 = *(const LAS bf16x8*)(dT + fr * DT_PITCH + (32 + fq * 8) * 2);
#pragma unroll
        for (int nt = 0; nt < 4; ++nt) {
            const LAS unsigned char* wp = F.lds + WPT_OFF + (16 * nt + fr) * WPT_PITCH;
            const bf16x8 a0 = *(const LAS bf16x8*)(wp + (fq * 8) * 2), a1 = *(const LAS bf16x8*)(wp + (32 + fq * 8) * 2);
            f32x4 acc = {0.f, 0.f, 0.f, 0.f};
            acc = __builtin_amdgcn_mfma_f32_16x16x32_bf16(a0, b0, acc, 0, 0, 0);
            acc = __builtin_amdgcn_mfma_f32_16x16x32_bf16(a1, b1, acc, 0, 0, 0);
            const int n = 16 * nt + 4 * fq; const f32x4 sc = *(const f32x4*)(P.ps + h * 64 + n);
            const unsigned lo = pk2(acc[0] * sc[0], acc[1] * sc[1]), hi = pk2(acc[2] * sc[2], acc[3] * sc[3]);
            *(GAS unsigned long long*)(Ms + (size_t)(tb + fr) * D + 256 + h * 64 + n) = (unsigned long long)lo | ((unsigned long long)hi << 32);
        }
    }
    {
        const float g = P.sng[ch], nb = P.snb[ch];
        unsigned pk[8];
        const bf16* zp = uni_ptr(Zs + (size_t)tb * MIXW);
#pragma unroll
        for (int r = 0; r < 16; r += 2) { float vn[2];
#pragma unroll
            for (int q = 0; q < 2; ++q) { const float v = gelu_tanh(bf2f(zp[1024 + ch])); zp += MIXW; OPAQUE_S(zp);
                const float mean = wave_sum(v) * (1.f / 64.f), dv = v - mean, var = wave_sum(dv * dv) * (1.f / 64.f);
                vn[q] = dv * __builtin_amdgcn_rsqf(var + LN_EPS) * g + nb; }
            pk[r >> 1] = pk2(vn[0], vn[1]); }
        LAS unsigned char* vt = F.lds + VNT_OFF + lane * VNT_PITCH + (16 * w) * 2;
        *(LAS v4u*)(vt) = (v4u){pk[0], pk[1], pk[2], pk[3]}; *(LAS v4u*)(vt + 16) = (v4u){pk[4], pk[5], pk[6], pk[7]};
    }
    __syncthreads();
    {
        const int nks = (w >> 1) + 1, tl = 16 * w + fr;
        const float* wrow = P.sw + ((size_t)h * 128 + tl) * 128;
        bf16x8 bw[4];
#pragma unroll
        for (int ks = 0; ks < 4; ++ks) { bf16x8 t = {0, 0, 0, 0, 0, 0, 0, 0};
            if (ks < nks) { const int s0 = 32 * ks + 8 * fq; const f32x4 a = *(const f32x4*)(wrow + s0), bq = *(const f32x4*)(wrow + s0 + 4);
                float e[8] = {a[0], a[1], a[2], a[3], bq[0], bq[1], bq[2], bq[3]};
#pragma unroll
                for (int j = 0; j < 8; ++j) t[j] = (short)f2bf((s0 + j <= tl) ? e[j] : 0.f); }
            bw[ks] = t; }
        const float bsv = P.sb[h * 128 + tl];
#pragma unroll
        for (int ct = 0; ct < 4; ++ct) {
            const LAS unsigned char* vp = F.lds + VNT_OFF + (16 * ct + fr) * VNT_PITCH + (8 * fq) * 2;
            f32x4 acc = {0.f, 0.f, 0.f, 0.f};
#pragma unroll
            for (int ks = 0; ks < 4; ++ks) if (ks < nks) acc = __builtin_amdgcn_mfma_f32_16x16x32_bf16(*(const LAS bf16x8*)(vp + 64 * ks), bw[ks], acc, 0, 0, 0);
            const int cc = h * 64 + 16 * ct + 4 * fq; const size_t ro = (size_t)(tb + fr);
            const unsigned long long uw = *(const GAS unsigned long long*)(Zs + ro * MIXW + 768 + cc);
            const float u0 = gelu_tanh(__uint_as_float((unsigned)uw << 16)), u1 = gelu_tanh(__uint_as_float((unsigned)uw & 0xffff0000u));
            const float u2 = gelu_tanh(__uint_as_float((unsigned)(uw >> 32) << 16)), u3 = gelu_tanh(__uint_as_float((unsigned)(uw >> 32) & 0xffff0000u));
            const unsigned lo = pk2(u0 * (acc[0] + bsv), u1 * (acc[1] + bsv)), hi = pk2(u2 * (acc[2] + bsv), u3 * (acc[3] + bsv));
            *(GAS unsigned long long*)(Ms + ro * D + 512 + cc) = (unsigned long long)lo | ((unsigned long long)hi << 32);
        }
    }
    {
        float q[18], bg[16];
        { const bf16* zp = uni_ptr(Zs + ((ptrdiff_t)(tb - 2) * MIXW));
#pragma unroll
        for (int j = 0; j < 18; ++j) { const bool ok = (tb - 2 + j) >= 0; const bf16* zq = ok ? zp : Zs; q[j] = bf2f(zq[1536 + ch]) * bf2f(zq[1792 + ch]) * (ok ? 1.f : 0.f);
            if (j >= 2) bg[j - 2] = bf2f(zq[1280 + ch]);
            zp += MIXW; OPAQUE_S(zp); } }
        const float w0 = P.scw[ch], w1 = P.scw[256 + ch], w2 = P.scw[512 + ch];
        bf16* mp = uni_ptr(Ms + (size_t)tb * D);
        float* sp = uni_ptr(P.out + O_SC_P + ((ptrdiff_t)(li * BATCH + b) * 2 + (tb - (SEQ - 2))) * 256);
#pragma unroll
        for (int r = 0; r < 16; ++r) { const int t = tb + r; const float y = w0 * q[r] + w1 * q[r + 1] + w2 * q[r + 2];
            mp[768 + ch] = f2bf16(bg[r] * y); mp += D; OPAQUE_S(mp);
            if (c == 15 && t >= SEQ - 2) sp[ch] = q[r + 2];
            sp += 256; OPAQUE_S(sp); }
    }
    __syncthreads();
}
constexpr int SB01_OFF = 0, SB2_OFF = 24064, SB345_OFF = 34176, SB67_OFF = 58752, VNT2_OFF = 75648, WPT2_OFF = 93056, DT2_OFF = 102272;
__device__ __forceinline__ void mix_prompt_unit2(Frame& F, const MixP& P, int b, int c, int h) {
    const int w = F.wave, lane = F.lane, tid = F.tid, ch = h * 64 + lane, fr = lane & 15, fq = lane >> 4, li = P.li;
    const bf16* Zs = uni_ptr(P.Z + (size_t)b * SEQ * MIXW);
    bf16* Ms = uni_ptr(P.MIX + (size_t)b * SEQ * D);
    LAS unsigned char* L = F.lds;
    const v4u zero4 = {0u, 0u, 0u, 0u};
    { const int n = tid & 63, kg = tid >> 6; const float* src = P.pw + (size_t)h * 4096 + (size_t)(8 * kg) * 64 + n;
      v4u o; o.x = pk2(src[0], src[64]); o.y = pk2(src[128], src[192]); o.z = pk2(src[256], src[320]); o.w = pk2(src[384], src[448]);
      *(LAS v4u*)(L + WPT2_OFF + n * WPT_PITCH + kg * 16) = o; }
    float wA[31];
    { const float* wp = P.caw;
#pragma unroll
    for (int k = 0; k < 31; ++k) { wA[k] = wp[ch]; wp += 256; OPAQUE_S(wp); } }
    for (int hh = 0; hh < 2; ++hh) {
        const int tlo = __builtin_amdgcn_readfirstlane(128 * c + 64 * hh);
        {
            const bf16* zc0 = Zs + h * 64;
            v4u va[3], vb[2], vc[3], vd[3];
#pragma unroll
            for (int k = 0; k < 3; ++k) { const int i = tid + 512 * k; const int r = i >> 4, sl = (i >> 3) & 1, kk = i & 7, tt = tlo - 30 + r;
                va[k] = (i < 1504 && tt >= 0) ? *(const GAS v4u*)(zc0 + (size_t)tt * MIXW + sl * 256 + kk * 8) : zero4; }
#pragma unroll
            for (int k = 0; k < 2; ++k) { const int i = tid + 512 * k; const int r = i >> 3, kk = i & 7, tt = tlo - 15 + r;
                vb[k] = (i < 632 && tt >= 0) ? *(const GAS v4u*)(zc0 + (size_t)tt * MIXW + 512 + kk * 8) : zero4; }
#pragma unroll
            for (int k = 0; k < 3; ++k) { const int i = tid + 512 * k; const int r = i / 24, rem = i - r * 24, sl = rem >> 3, kk = rem & 7, tt = tlo + r;
                vc[k] = *(const GAS v4u*)(zc0 + (size_t)tt * MIXW + (3 + sl) * 256 + kk * 8); }
#pragma unroll
            for (int k = 0; k < 3; ++k) { const int i = tid + 512 * k; const int r = i >> 4, sl = (i >> 3) & 1, kk = i & 7, tt = tlo - 2 + r;
                vd[k] = (i < 1056 && tt >= 0) ? *(const GAS v4u*)(zc0 + (size_t)tt * MIXW + (6 + sl) * 256 + kk * 8) : zero4; }
#pragma unroll
            for (int k = 0; k < 3; ++k) { const int i = tid + 512 * k; if (i < 1504) *(LAS v4u*)(L + SB01_OFF + (i >> 4) * 256 + ((i >> 3) & 1) * 128 + (i & 7) * 16) = va[k]; }
#pragma unroll
            for (int k = 0; k < 2; ++k) { const int i = tid + 512 * k; if (i < 632) *(LAS v4u*)(L + SB2_OFF + (i >> 3) * 128 + (i & 7) * 16) = vb[k]; }
#pragma unroll
            for (int k = 0; k < 3; ++k) { const int i = tid + 512 * k; const int r = i / 24, rem = i - r * 24; *(LAS v4u*)(L + SB345_OFF + r * 384 + (rem >> 3) * 128 + (rem & 7) * 16) = vc[k]; }
#pragma unroll
            for (int k = 0; k < 3; ++k) { const int i = tid + 512 * k; if (i < 1056) *(LAS v4u*)(L + SB67_OFF + (i >> 4) * 256 + ((i >> 3) & 1) * 128 + (i & 7) * 16) = vd[k]; }
        }
        __syncthreads();
        {
            float ha[12], qv[9];
#pragma unroll
            for (int k = 0; k < 12; ++k) { const int i = tid + 512 * k; const int r = i >> 6, cc = i & 63; ha[k] = 0.f;
                if (i < 94 * 64) { const LAS bf16* p = (const LAS bf16*)(L + SB01_OFF + r * 256 + cc * 2); ha[k] = bf2f(p[0]) * pg8::sigmoid_f(bf2f(p[64])); } }
#pragma unroll
            for (int k = 0; k < 9; ++k) { const int i = tid + 512 * k; const int r = i >> 6, cc = i & 63; qv[k] = 0.f;
                if (i < 66 * 64) { const LAS bf16* p = (const LAS bf16*)(L + SB67_OFF + r * 256 + cc * 2); qv[k] = bf2f(p[0]) * bf2f(p[64]); } }
            __syncthreads();
#pragma unroll
            for (int k = 0; k < 12; ++k) { const int i = tid + 512 * k; if (i < 94 * 64) *(LAS float*)(L + SB01_OFF + (i >> 6) * 256 + (i & 63) * 4) = ha[k]; }
#pragma unroll
            for (int k = 0; k < 9; ++k) { const int i = tid + 512 * k; if (i < 66 * 64) *(LAS float*)(L + SB67_OFF + (i >> 6) * 256 + (i & 63) * 4) = qv[k]; }
        }
        __syncthreads();
        const int tb = __builtin_amdgcn_readfirstlane(tlo + 8 * w);
        {
            float ext[38];
#pragma unroll
            for (int e = 0; e < 38; ++e) ext[e] = *(const LAS float*)(L + SB01_OFF + (8 * w + e) * 256 + lane * 4);
            const float bias = P.cab[ch], g = P.nag[ch], nb = P.nab[ch];
            bf16* mp = uni_ptr(Ms + (size_t)tb * D);
            float cv[8], mean[8], rstd[8];
#pragma unroll
            for (int r = 0; r < 8; ++r) { float a = bias;
#pragma unroll
                for (int k = 0; k < 31; ++k) a += wA[k] * ext[r + k];
                cv[r] = a; }
            ln8_stats(cv, mean, rstd, LN_EPS);
#pragma unroll
            for (int r = 0; r < 8; ++r) { const float y = (cv[r] - mean[r]) * rstd[r] * g + nb;
                mp[ch] = f2bf16(pg8::silu_f(y)); mp += D; OPAQUE_S(mp); }
            if (c == 15 && hh == 1) {
                float* sp = uni_ptr(P.out + O_CA_P + ((ptrdiff_t)(li * BATCH + b) * 30 + (tb - (SEQ - 30))) * 256);
#pragma unroll
                for (int r = 0; r < 8; ++r) { if (tb + r >= SEQ - 30) sp[ch] = ext[r + 30]; sp += 256; OPAQUE_S(sp); } }
        }
        {
            float ze[23];
#pragma unroll
            for (int e = 0; e < 23; ++e) ze[e] = bf2f(*(const LAS bf16*)(L + SB2_OFF + (8 * w + e) * 128 + lane * 2));
            const int win = 2 << h;
#pragma unroll
            for (int r = 0; r < 8; ++r) { const float zc = ze[r + 15];
                const float s2 = zc + ze[r + 14], s4 = s2 + (ze[r + 13] + ze[r + 12]), s8 = s4 + ((ze[r + 11] + ze[r + 10]) + (ze[r + 9] + ze[r + 8]));
                const float s16 = s8 + (((ze[r + 7] + ze[r + 6]) + (ze[r + 5] + ze[r + 4])) + ((ze[r + 3] + ze[r + 2]) + (ze[r + 1] + ze[r])));
                const int t = tb + r; const float cnt = (float)((t + 1 < win) ? t + 1 : win);
                *(LAS bf16*)(L + DT2_OFF + (8 * w + r) * DT_PITCH + lane * 2) = f2bf16(pool_sel(h, s2, s4, s8, s16) * __builtin_amdgcn_rcpf(cnt) - zc);
                }
            if (c == 15 && hh == 1) {
                float* sp = uni_ptr(P.out + O_PL_P + ((ptrdiff_t)(li * BATCH + b) * 15 + (tb - (SEQ - 15))) * 256);
#pragma unroll
                for (int r = 0; r < 8; ++r) { if (tb + r >= SEQ - 15) sp[ch] = ze[r + 15]; sp += 256; OPAQUE_S(sp); } }
        }
        {
            const float g = P.sng[ch], nb = P.snb[ch];
            unsigned pk[4]; float vv[8], mean[8], rstd[8];
#pragma unroll
            for (int r = 0; r < 8; ++r) vv[r] = gelu_tanh(bf2f(*(const LAS bf16*)(L + SB345_OFF + (8 * w + r) * 384 + 128 + lane * 2)));
            ln8_stats(vv, mean, rstd, LN_EPS);
#pragma unroll
            for (int r = 0; r < 8; r += 2) pk[r >> 1] = pk2((vv[r] - mean[r]) * rstd[r] * g + nb, (vv[r + 1] - mean[r + 1]) * rstd[r + 1] * g + nb);
            *(LAS v4u*)(L + VNT2_OFF + lane * VNT_PITCH + (64 * hh + 8 * w) * 2) = (v4u){pk[0], pk[1], pk[2], pk[3]};
        }
        {
            float q[10];
#pragma unroll
            for (int e = 0; e < 10; ++e) q[e] = *(const LAS float*)(L + SB67_OFF + (8 * w + e) * 256 + lane * 4);
            const float w0 = P.scw[ch], w1 = P.scw[256 + ch], w2 = P.scw[512 + ch];
            bf16* mp = uni_ptr(Ms + (size_t)tb * D);
#pragma unroll
            for (int r = 0; r < 8; ++r) { const float bg = bf2f(*(const LAS bf16*)(L + SB345_OFF + (8 * w + r) * 384 + 256 + lane * 2));
                mp[768 + ch] = f2bf16(bg * (w0 * q[r] + w1 * q[r + 1] + w2 * q[r + 2])); mp += D; OPAQUE_S(mp); }
            if (c == 15 && hh == 1) {
                float* sp = uni_ptr(P.out + O_SC_P + ((ptrdiff_t)(li * BATCH + b) * 2 + (tb - (SEQ - 2))) * 256);
#pragma unroll
                for (int r = 0; r < 8; ++r) { if (tb + r >= SEQ - 2) sp[ch] = q[r + 2]; sp += 256; OPAQUE_S(sp); } }
        }
        __syncthreads();
        const int rt = w >> 1, t0 = 64 * hh + 16 * rt;
        {
            const LAS unsigned char* dT = L + DT2_OFF + (16 * rt + fr) * DT_PITCH;
            const bf16x8 b0 = *(const LAS bf16x8*)(dT + (fq * 8) * 2), b1 = *(const LAS bf16x8*)(dT + (32 + fq * 8) * 2);
#pragma unroll
            for (int nn = 0; nn < 2; ++nn) { const int nt = 2 * (w & 1) + nn;
                const LAS unsigned char* wp = L + WPT2_OFF + (16 * nt + fr) * WPT_PITCH;
                const bf16x8 a0 = *(const LAS bf16x8*)(wp + (fq * 8) * 2), a1 = *(const LAS bf16x8*)(wp + (32 + fq * 8) * 2);
                f32x4 acc = {0.f, 0.f, 0.f, 0.f};
                acc = __builtin_amdgcn_mfma_f32_16x16x32_bf16(a0, b0, acc, 0, 0, 0);
                acc = __builtin_amdgcn_mfma_f32_16x16x32_bf16(a1, b1, acc, 0, 0, 0);
                const int n = 16 * nt + 4 * fq; const f32x4 sc = *(const f32x4*)(P.ps + h * 64 + n);
                const unsigned lo = pk2(acc[0] * sc[0], acc[1] * sc[1]), hi = pk2(acc[2] * sc[2], acc[3] * sc[3]);
                *(GAS unsigned long long*)(Ms + (size_t)(tlo + 16 * rt + fr) * D + 256 + h * 64 + n) = (unsigned long long)lo | ((unsigned long long)hi << 32); }
        }
        {
            const int nks = (t0 >> 5) + 1, tl = t0 + fr;
            const float* wrow = P.sw + ((size_t)h * 128 + tl) * 128;
            bf16x8 bw[4];
#pragma unroll
            for (int ks = 0; ks < 4; ++ks) { bf16x8 t = {0, 0, 0, 0, 0, 0, 0, 0};
                if (ks < nks) { const int s0 = 32 * ks + 8 * fq; const f32x4 a = *(const f32x4*)(wrow + s0), bq = *(const f32x4*)(wrow + s0 + 4);
                    float e[8] = {a[0], a[1], a[2], a[3], bq[0], bq[1], bq[2], bq[3]};
#pragma unroll
                    for (int j = 0; j < 8; ++j) e[j] = (s0 + j <= tl) ? e[j] : 0.f;
                    const v4u tw = {pk2(e[0], e[1]), pk2(e[2], e[3]), pk2(e[4], e[5]), pk2(e[6], e[7])}; t = __builtin_bit_cast(bf16x8, tw); }
                bw[ks] = t; }
            const float bsv = P.sb[h * 128 + tl];
#pragma unroll
            for (int cn = 0; cn < 2; ++cn) { const int ct = 2 * (w & 1) + cn;
                const LAS unsigned char* vp = L + VNT2_OFF + (16 * ct + fr) * VNT_PITCH + (8 * fq) * 2;
                f32x4 acc = {0.f, 0.f, 0.f, 0.f};
#pragma unroll
                for (int ks = 0; ks < 4; ++ks) if (ks < nks) acc = __builtin_amdgcn_mfma_f32_16x16x32_bf16(*(const LAS bf16x8*)(vp + 64 * ks), bw[ks], acc, 0, 0, 0);
                const int cc = 16 * ct + 4 * fq;
                const unsigned long long uw = *(const LAS unsigned long long*)(L + SB345_OFF + (16 * rt + fr) * 384 + cc * 2);
                const float u0 = gelu_tanh(__uint_as_float((unsigned)uw << 16)), u1 = gelu_tanh(__uint_as_float((unsigned)uw & 0xffff0000u));
                const float u2 = gelu_tanh(__uint_as_float((unsigned)(uw >> 32) << 16)), u3 = gelu_tanh(__uint_as_float((unsigned)(uw >> 32) & 0xffff0000u));
                const unsigned lo = pk2(u0 * (acc[0] + bsv), u1 * (acc[1] + bsv)), hi = pk2(u2 * (acc[2] + bsv), u3 * (acc[3] + bsv));
                *(GAS unsigned long long*)(Ms + (size_t)(tlo + 16 * rt + fr) * D + 512 + h * 64 + cc) = (unsigned long long)lo | ((unsigned long long)hi << 32); }
        }
        __syncthreads();
    }
}
__device__ __forceinline__ void mix_sample_wave(Frame& F, const MixP& P, int b, int h) {
    const int lane = F.lane, ch = h * 64 + lane, li = P.li;
    b = __builtin_amdgcn_readfirstlane(b); h = __builtin_amdgcn_readfirstlane(h);
    const bf16* Zr = uni_ptr(P.Z + (size_t)(MP + b * DECS) * MIXW); bf16* Mr = uni_ptr(P.MIX + (size_t)(MP + b * DECS) * D);
    const size_t sb_ = (size_t)li * DECB + b;
    {
        float wA[31];
        { const float* wp = P.caw;
#pragma unroll
        for (int k = 0; k < 31; ++k) { wA[k] = wp[ch]; wp += 256; OPAQUE_S(wp); } }
        float ext[38];
        { const float* sp = P.st_a + sb_ * 30 * 256; float* so = P.out + O_CA_S + sb_ * 30 * 256;
#pragma unroll
        for (int j = 0; j < 30; ++j) { ext[j] = sp[ch]; sp += 256; OPAQUE_S(sp); }
        const bf16* zp = Zr;
#pragma unroll
        for (int t = 0; t < 8; ++t) { ext[30 + t] = bf2f(zp[ch]) * pg8::sigmoid_f(bf2f(zp[256 + ch])); zp += MIXW; OPAQUE_S(zp); }
#pragma unroll
        for (int j = 0; j < 30; ++j) { so[ch] = ext[j + 8]; so += 256; OPAQUE_S(so); } }
        const float bias = P.cab[ch], g = P.nag[ch], nb = P.nab[ch];
        bf16* mp = Mr; float cvs[8], mean8[8], rstd8[8];
#pragma unroll
        for (int t = 0; t < 8; ++t) { float a = bias;
#pragma unroll
            for (int k = 0; k < 31; ++k) a += wA[k] * ext[t + k];
            cvs[t] = a; }
        ln8_stats(cvs, mean8, rstd8, LN_EPS);
#pragma unroll
        for (int t = 0; t < 8; ++t) { mp[ch] = f2bf16(pg8::silu_f((cvs[t] - mean8[t]) * rstd8[t] * g + nb)); mp += D; OPAQUE_S(mp); }
    }
    {
        float ze[23];
        { const float* sp = P.st_p + sb_ * 15 * 256; float* so = P.out + O_PL_S + sb_ * 15 * 256;
#pragma unroll
        for (int j = 0; j < 15; ++j) { ze[j] = sp[ch]; sp += 256; OPAQUE_S(sp); }
        const bf16* zp = Zr;
#pragma unroll
        for (int t = 0; t < 8; ++t) { ze[15 + t] = bf2f(zp[512 + ch]); zp += MIXW; OPAQUE_S(zp); }
#pragma unroll
        for (int j = 0; j < 15; ++j) { so[ch] = ze[j + 8]; so += 256; OPAQUE_S(so); } }
        float d[8], y[8];
        const float inv = 1.0f / (float)(2 << h);
#pragma unroll
        for (int r = 0; r < 8; ++r) { const float zc = ze[r + 15];
            const float s2 = zc + ze[r + 14], s4 = s2 + (ze[r + 13] + ze[r + 12]), s8 = s4 + ((ze[r + 11] + ze[r + 10]) + (ze[r + 9] + ze[r + 8]));
            const float s16 = s8 + (((ze[r + 7] + ze[r + 6]) + (ze[r + 5] + ze[r + 4])) + ((ze[r + 3] + ze[r + 2]) + (ze[r + 1] + ze[r])));
            d[r] = pool_sel(h, s2, s4, s8, s16) * inv - zc; y[r] = 0.f; }
        const float* pwh = P.pw + (size_t)h * 4096;
#pragma unroll 8
        for (int k = 0; k < 64; ++k) { const float wv = pwh[lane]; pwh += 64;
#pragma unroll
            for (int r = 0; r < 8; ++r) y[r] += __shfl(d[r], k) * wv; }
        const float sc = P.ps[ch];
        bf16* mp = Mr;
#pragma unroll
        for (int r = 0; r < 8; ++r) { mp[256 + ch] = f2bf16(y[r] * sc); mp += D; OPAQUE_S(mp); }
    }
    {
        const float g = P.sng[ch], nb = P.snb[ch];
        float vn[8], ug[8];
        { const bf16* zp = Zr; float* so = P.out + O_CV_S + sb_ * DECS * 256;
#pragma unroll
        for (int t = 0; t < 8; ++t) { vn[t] = gelu_tanh(bf2f(zp[1024 + ch])); ug[t] = gelu_tanh(bf2f(zp[768 + ch])); zp += MIXW; OPAQUE_S(zp); }
        { float mean8[8], rstd8[8]; ln8_stats(vn, mean8, rstd8, LN_EPS);
#pragma unroll
        for (int t = 0; t < 8; ++t) { vn[t] = (vn[t] - mean8[t]) * rstd8[t] * g + nb; so[ch] = vn[t]; so += 256; OPAQUE_S(so); } } }
        bf16* mp = Mr; const float* swp = P.sw + (size_t)h * 128 * 128; const float* sbp = P.sb + h * 128;
#pragma unroll
        for (int t = 0; t < 8; ++t) { float s = sbp[t];
#pragma unroll
            for (int q = 0; q <= t; ++q) s += swp[q] * vn[q];
            swp += 128; OPAQUE_S(swp);
            mp[512 + ch] = f2bf16(ug[t] * s); mp += D; OPAQUE_S(mp); }
    }
    {
        float q[10], bg[8];
        q[0] = P.st_s[(sb_ * 2 + 0) * 256 + ch]; q[1] = P.st_s[(sb_ * 2 + 1) * 256 + ch];
        { const bf16* zp = Zr;
#pragma unroll
        for (int t = 0; t < 8; ++t) { q[2 + t] = bf2f(zp[1536 + ch]) * bf2f(zp[1792 + ch]); bg[t] = bf2f(zp[1280 + ch]); zp += MIXW; OPAQUE_S(zp); } }
        const float w0 = P.scw[ch], w1 = P.scw[256 + ch], w2 = P.scw[512 + ch];
        bf16* mp = Mr;
#pragma unroll
        for (int t = 0; t < 8; ++t) { mp[768 + ch] = f2bf16(bg[t] * (w0 * q[t] + w1 * q[t + 1] + w2 * q[t + 2])); mp += D; OPAQUE_S(mp); }
        P.out[O_SC_S + (sb_ * 2 + 0) * 256 + ch] = q[8]; P.out[O_SC_S + (sb_ * 2 + 1) * 256 + ch] = q[9];
    }
}
constexpr int MIX_PUNITS = BATCH * 16 * 4, MIX_SUNITS = DECB * 4 / NWAVES;
__device__ __forceinline__ void mix_phase(Frame& F, const MixP& P) {
    for (int u = blockIdx.x; u < MIX_PUNITS + MIX_SUNITS; u += F.G) {
        asm volatile("" : "+v"(F.tid), "+v"(F.lane), "+s"(F.wave) :: "memory");
        if (u < MIX_PUNITS) mix_prompt_unit2(F, P, u >> 6, (u >> 2) & 15, u & 3);
        else { const int wu = (u - MIX_PUNITS) * NWAVES + F.wave; mix_sample_wave(F, P, wu >> 2, wu & 3); }
    }
}
__device__ __forceinline__ void small_gemm_resid(Frame& F, const bf16* A, int lda, const bf16* Bt, int K, bf16* XB, float scale, int m0) {
    const int w = F.wave, lane = F.lane, tid = F.tid, fr = lane & 15, fq = lane >> 4, K8 = K >> 3;
    constexpr int PP = 68;
    LAS float* Pt = (LAS float*)(F.lds);
    for (int t = (int)blockIdx.x; t < 256; t += F.G) {
        const int ti = t >> 4, tj = t & 15;
        const bf16* a0 = A + (size_t)(m0 + 64 * ti + fr) * lda + w * K8 + 8 * fq;
        const bf16* b0 = Bt + (size_t)(64 * tj + fr) * lda + w * K8 + 8 * fq;
        f32x4 acc[4][4];
#pragma unroll
        for (int mi = 0; mi < 4; ++mi)
#pragma unroll
            for (int ni = 0; ni < 4; ++ni) acc[mi][ni] = (f32x4){0.f, 0.f, 0.f, 0.f};
#pragma unroll 2
        for (int k = 0; k < K8; k += 32) {
            bf16x8 af[4], bfr[4];
#pragma unroll
            for (int mi = 0; mi < 4; ++mi) af[mi] = *(const bf16x8*)(a0 + (size_t)(16 * mi) * lda + k);
#pragma unroll
            for (int ni = 0; ni < 4; ++ni) bfr[ni] = *(const bf16x8*)(b0 + (size_t)(16 * ni) * lda + k);
#pragma unroll
            for (int mi = 0; mi < 4; ++mi)
#pragma unroll
                for (int ni = 0; ni < 4; ++ni) acc[mi][ni] = __builtin_amdgcn_mfma_f32_16x16x32_bf16(af[mi], bfr[ni], acc[mi][ni], 0, 0, 0);
        }
        LAS float* mine = Pt + (w & 3) * 64 * PP + (4 * fq) * PP + fr;
        if (w >= 4) {
#pragma unroll
            for (int mi = 0; mi < 4; ++mi)
#pragma unroll
                for (int ni = 0; ni < 4; ++ni)
#pragma unroll
                    for (int rg = 0; rg < 4; ++rg) mine[(16 * mi + rg) * PP + 16 * ni] = acc[mi][ni][rg];
        }
        __syncthreads();
        if (w < 4) {
#pragma unroll
            for (int mi = 0; mi < 4; ++mi)
#pragma unroll
                for (int ni = 0; ni < 4; ++ni)
#pragma unroll
                    for (int rg = 0; rg < 4; ++rg) acc[mi][ni][rg] += mine[(16 * mi + rg) * PP + 16 * ni];
#pragma unroll
            for (int mi = 0; mi < 4; ++mi)
#pragma unroll
                for (int ni = 0; ni < 4; ++ni)
#pragma unroll
                    for (int rg = 0; rg < 4; ++rg) mine[(16 * mi + rg) * PP + 16 * ni] = acc[mi][ni][rg];
        }
        __syncthreads();
        { const int row = tid >> 3, c8 = (tid & 7) * 8;
          f32x4 s0 = {0.f, 0.f, 0.f, 0.f}, s1 = {0.f, 0.f, 0.f, 0.f};
#pragma unroll
          for (int q = 0; q < 4; ++q) { const LAS f32x4* p = (const LAS f32x4*)(Pt + (q * 64 + row) * PP + c8); s0 += p[0]; s1 += p[1]; }
          const size_t off = (size_t)(m0 + 64 * ti + row) * D + 64 * tj + c8;
          const v4u rw = *(const GAS v4u*)(XB + off);
          f32x4 x0 = {__uint_as_float(rw.x << 16), __uint_as_float(rw.x & 0xffff0000u), __uint_as_float(rw.y << 16), __uint_as_float(rw.y & 0xffff0000u)};
          f32x4 x1 = {__uint_as_float(rw.z << 16), __uint_as_float(rw.z & 0xffff0000u), __uint_as_float(rw.w << 16), __uint_as_float(rw.w & 0xffff0000u)};
          x0 += s0 * scale; x1 += s1 * scale;
          v4u o; o.x = pk2(x0[0], x0[1]); o.y = pk2(x0[2], x0[3]); o.z = pk2(x1[0], x1[1]); o.w = pk2(x1[2], x1[3]);
          *(GAS v4u*)(XB + off) = o; }
        __syncthreads();
    }
}
__global__ void __launch_bounds__(NWAVES * 64, 2) fwd_megakernel(Args args) {
    extern __shared__ __attribute__((aligned(16))) unsigned char lds[];
    Frame F;
    F.lds = (LAS unsigned char*)lds;
    F.tid = threadIdx.x; F.lane = F.tid & 63; F.wave = __builtin_amdgcn_readfirstlane(F.tid >> 6);
    F.G = gridDim.x; { const int bx = blockIdx.x; F.vcu = (F.G % 8 == 0) ? (bx % 8) * (F.G / 8) + bx / 8 : bx; }
    unsigned char* ws = args.ws;
    for (int u = F.tid; u < (LDS_BYTES - LDSCTL_OFF) / 4; u += NWAVES * 64) ((LAS unsigned*)(F.lds + LDSCTL_OFF))[u] = 0u;
    __syncthreads();
    XcdBarrier bar = xcd_barrier_post((unsigned*)(ws + WS_CTL) + CW_BAR, (volatile LAS unsigned*)(F.lds + MISC_OFF) + 8);
#define GRID_BAR() do { asm volatile("" : "+s"(bar.bar)); xcd_barrier(bar); asm volatile("" : "+v"(F.tid), "+v"(F.lane), "+s"(F.wave) :: "memory"); } while (0)
#if defined(NO_GEMM) || (defined(ONLY) && ONLY != 1)
#define RUN_GEMM1(...)
#else
#define RUN_GEMM1(...) __VA_ARGS__
#endif
#if defined(NO_GEMM) || (defined(ONLY) && ONLY != 2)
#define RUN_GEMM2(...)
#else
#define RUN_GEMM2(...) __VA_ARGS__
#endif
#if defined(NO_GEMM) || (defined(ONLY) && ONLY != 3)
#define RUN_GEMM3(...)
#else
#define RUN_GEMM3(...) __VA_ARGS__
#endif
#if defined(NO_GEMM) || (defined(ONLY) && ONLY != 4)
#define RUN_GEMM4(...)
#else
#define RUN_GEMM4(...) __VA_ARGS__
#endif
#if defined(NO_GEMM) || (defined(ONLY) && ONLY != 5)
#define RUN_GEMM5(...)
#else
#define RUN_GEMM5(...) __VA_ARGS__
#endif
#if defined(NO_GEMM) || (defined(ONLY) && ONLY != 6)
#define RUN_GEMM6(...)
#else
#define RUN_GEMM6(...) __VA_ARGS__
#endif
#if defined(NO_GEMM) || (defined(ONLY) && ONLY != 7)
#define RUN_GEMM7(...)
#else
#define RUN_GEMM7(...) __VA_ARGS__
#endif
#if defined(NO_GEMM) || (defined(ONLY) && ONLY != 8)
#define RUN_GEMM8(...)
#else
#define RUN_GEMM8(...) __VA_ARGS__
#endif

#ifndef NO_PRO
    p0_prologue(F, args);
#ifdef PROBE_PRO2
    p0_prologue(F, args);
#endif
#endif
    if (args.ws == nullptr) cg::this_grid().sync();
    GRID_BAR();

    float* X = args.out;
    pg8::bf16_t* ACT = (pg8::bf16_t*)(ws + WS_ACT);
    if (F.tid == 0) { unsigned ok = (F.G % 8 == 0) ? 1u : 0u; for (unsigned j = 0; j < 8; ++j) ok &= (xb_ld(&bar.bar[XB_XCNT(j)]) == (unsigned)(F.G / 8)) ? 1u : 0u;
        volatile LAS unsigned* stw = (volatile LAS unsigned*)(F.lds + MISC_OFF) + 8; const unsigned rk = stw[4];
        stw[5] = (ok && rk < (unsigned)(F.G / 8) && bar.x < 8u) ? 8u * rk + bar.x : (unsigned)blockIdx.x; }
    __syncthreads();
    const int G = F.G, cu = __builtin_amdgcn_readfirstlane((int)((volatile LAS unsigned*)(F.lds + MISC_OFF))[8 + 5]);
    for (int li = 0; li < DEPTH; ++li) {
        pg8::bf16_t* XB = (pg8::bf16_t*)(ws + ((li & 1) ? WS_BUFB : WS_BUFA));
        pg8::bf16_t* MX = (pg8::bf16_t*)(ws + ((li & 1) ? WS_BUFA : WS_BUFB));
        const unsigned char* wl = ws + WS_W + (size_t)li * W_LAYER;
        { pg8::Gemm g{XB, (const pg8::bf16_t*)(wl + WO_GU1), M, NGU, D}; pg8::StaticOrder S; S.init(M, NGU, G, opaque_s(cu));
          pg8::EpiSwiGLU E{ACT, FF}; RUN_GEMM1(pg8::gemm_phase<pg8::EpiSwiGLU, pg8::StaticOrder, true, true>(F.lds + RING_OFF, g, S, E);)
#ifdef PROBE_P1X2
          pg8::gemm_phase<pg8::EpiSwiGLU, pg8::StaticOrder, true, true>(F.lds + RING_OFF, g, S, E);
#endif
#ifdef PROBE_P1NULL
          { pg8::EpiNull E0; pg8::gemm_phase<pg8::EpiNull, pg8::StaticOrder, true, true>(F.lds + RING_OFF, g, S, E0); }
#endif
        }
        GRID_BAR();
        { pg8::Gemm g{ACT, (const pg8::bf16_t*)(wl + WO_D1), M, D, FF}; pg8::MixedOrder S; S.init(MP, 0, D, G, opaque_s(cu));
          pg8::EpiResid<0> E{XB, XB, 0.5f, nullptr}; RUN_GEMM2(pg8::gemm_phase<pg8::EpiResid<0>, pg8::MixedOrder, true, true>(F.lds + RING_OFF, g, S, E);) }
        small_gemm_resid(F, (const bf16*)ACT, FF, (const bf16*)(wl + WO_D1), FF, (bf16*)XB, 0.5f, MP);
        GRID_BAR();
        { pg8::Gemm g{XB, (const pg8::bf16_t*)(wl + WO_MI), M, MIXW, D}; pg8::MixedOrder S; S.init(MP, MS, MIXW, G, opaque_s(cu));
          pg8::EpiScaleBf16<true> E{ACT, MIXW}; RUN_GEMM3(pg8::gemm_phase<pg8::EpiScaleBf16<true>, pg8::MixedOrder, true, true>(F.lds + RING_OFF, g, S, E);) }
        if (li == 0 && DEPTH > 1) {
            const int nq = (MS / 256) * (MIXW / 256) * 4, half = (DEPTH - 1) * P0_I_LAYER / 2;
            if (G > nq) { if (cu >= nq) p0_convert(F, args, P0_I_LAYER, P0_I_LAYER + half, (cu - nq) * NWAVES + F.wave, (G - nq) * NWAVES); }
            else p0_convert(F, args, P0_I_LAYER, P0_I_LAYER + half, cu * NWAVES + F.wave, G * NWAVES);
        }
        GRID_BAR();
        { MixP P; P.Z = (const bf16*)ACT; P.MIX = (bf16*)MX; P.caw = args.in[opaque_s(13)] + (size_t)li * 31 * 256; P.cab = args.in[opaque_s(14)] + li * 256; P.nag = args.in[opaque_s(15)] + li * 256; P.nab = args.in[opaque_s(16)] + li * 256;
          P.pw = args.in[opaque_s(17)] + (size_t)li * 4 * 4096; P.ps = args.in[opaque_s(18)] + li * 256; P.sng = args.in[opaque_s(19)] + li * 256; P.snb = args.in[opaque_s(20)] + li * 256;
          P.sw = args.in[opaque_s(21)] + (size_t)li * 4 * 128 * 128; P.sb = args.in[opaque_s(22)] + li * 4 * 128; P.scw = args.in[opaque_s(23)] + li * 3 * 256; P.out = args.out; P.li = li;
          P.st_a = args.in[opaque_s(4)]; P.st_p = args.in[opaque_s(5)]; P.st_s = args.in[opaque_s(6)];
#ifndef NO_MIX
          mix_phase(F, P);
#ifdef PROBE_MIX2
          mix_phase(F, P);
#endif
#endif
        }
        GRID_BAR();
        { pg8::Gemm g{MX, (const pg8::bf16_t*)(wl + WO_MO), M, D, D}; pg8::MixedOrder S; S.init(MP, MS, D, G, opaque_s(cu));
          pg8::EpiResid<0> E{XB, XB, 1.0f, nullptr}; RUN_GEMM4(pg8::gemm_phase<pg8::EpiResid<0>, pg8::MixedOrder, true, true>(F.lds + RING_OFF, g, S, E);) }
        { const int nq = (MS / 256) * (D / 256) * 4; pg8::bf16_t* PROJ = (pg8::bf16_t*)args.out + (size_t)li * M * D;
          pg8::Gemm g{(const pg8::bf16_t*)(ws + WS_PB) + (size_t)li * M * DPLE, (const pg8::bf16_t*)(wl + WO_PP), M, D, DPLE};
          pg8::RangeOrder S{0, (M / 256) * (D / 256), G > nq ? G - nq : G, opaque_s(G > nq ? (cu >= nq ? cu - nq : -1) : cu)};
          pg8::EpiScaleBf16<false> E{PROJ, D}; pg8::gemm_phase<pg8::EpiScaleBf16<false>, pg8::RangeOrder, true, true>(F.lds + RING_OFF, g, S, E); }
        GRID_BAR();
        { pg8::Gemm g{XB, (const pg8::bf16_t*)(wl + WO_GU2), M, NGU, D}; pg8::StaticOrder S; S.init(M, NGU, G, opaque_s(cu));
          pg8::EpiSwiGLU E{ACT, FF}; RUN_GEMM5(pg8::gemm_phase<pg8::EpiSwiGLU, pg8::StaticOrder, true, true>(F.lds + RING_OFF, g, S, E);) }
        GRID_BAR();
        { pg8::Gemm g{ACT, (const pg8::bf16_t*)(wl + WO_D2), M, D, FF}; pg8::MixedOrder S; S.init(MP, 0, D, G, opaque_s(cu));
          pg8::EpiResid<0> E{XB, XB, 0.5f, nullptr}; RUN_GEMM6(pg8::gemm_phase<pg8::EpiResid<0>, pg8::MixedOrder, true, true>(F.lds + RING_OFF, g, S, E);) }
        small_gemm_resid(F, (const bf16*)ACT, FF, (const bf16*)(wl + WO_D2), FF, (bf16*)XB, 0.5f, MP);
        GRID_BAR();
        { pg8::Gemm g{XB, (const pg8::bf16_t*)(wl + WO_PG), M, D, D}; pg8::MixedOrder S; S.init(MP, MS, D, G, opaque_s(cu));
          pg8::EpiResid<1> E{MX, XB, 0.f, (const pg8::bf16_t*)args.out + (size_t)li * M * D}; RUN_GEMM8(pg8::gemm_phase<pg8::EpiResid<1>, pg8::MixedOrder, true, true>(F.lds + RING_OFF, g, S, E);) }
        if (li == 0 && DEPTH > 1) {
            const int nq = (MS / 256) * (D / 256) * 4, half = (DEPTH - 1) * P0_I_LAYER / 2;
            if (G > nq) { if (cu >= nq) p0_convert(F, args, P0_I_LAYER + half, DEPTH * P0_I_LAYER, (cu - nq) * NWAVES + F.wave, (G - nq) * NWAVES); }
            else p0_convert(F, args, P0_I_LAYER + half, DEPTH * P0_I_LAYER, cu * NWAVES + F.wave, G * NWAVES);
        }
        GRID_BAR();
    }
#ifndef NO_FIN
    final_norm(F, args, (const bf16*)(ws + ((DEPTH & 1) ? WS_BUFB : WS_BUFA)));
#endif
}

extern "C" void kernel_launch(void* const* d_in, const int* in_sizes, int n_in, void* d_out, int out_size, void* d_ws, size_t ws_size, hipStream_t stream) {
    static int grid = 0;
    if (grid == 0) {
        if (n_in != NIN || in_sizes[0] != MP * D || (size_t)out_size != O_END || ws_size < WS_END) {
            fprintf(stderr, "kernel_launch: unexpected shapes: n_in %d in0 %d out %d (want %zu) ws %zu (need %zu); nothing launched\n", n_in, n_in > 0 ? in_sizes[0] : -1, out_size, (size_t)O_END, ws_size, (size_t)WS_END); grid = -1; return; }
        int dev = 0, cus = 0, per_cu = 0;
        if (hipGetDevice(&dev) != hipSuccess || hipDeviceGetAttribute(&cus, hipDeviceAttributeMultiprocessorCount, dev) != hipSuccess) { grid = -1; return; }
        if (hipFuncSetAttribute((const void*)fwd_megakernel, hipFuncAttributeMaxDynamicSharedMemorySize, LDS_BYTES) != hipSuccess) { fprintf(stderr, "kernel_launch: hipFuncSetAttribute failed\n"); grid = -1; return; }
        if (hipOccupancyMaxActiveBlocksPerMultiprocessor(&per_cu, (const void*)fwd_megakernel, NWAVES * 64, LDS_BYTES) != hipSuccess || per_cu < 1) { fprintf(stderr, "kernel_launch: occupancy query says %d\n", per_cu); per_cu = 1; }
        (void)hipGetLastError();
        grid = cus;
    }
    if (grid < 0) return;
    if (hipMemsetAsync((char*)d_ws + WS_CTL, 0, CTL_ZERO_BYTES, stream) != hipSuccess) { fprintf(stderr, "kernel_launch: memset failed\n"); return; }
    Args a{};
    for (int i = 0; i < NIN; ++i) a.in[i] = (const float*)d_in[i];
    a.out = (float*)d_out; a.ws = (unsigned char*)d_ws;
    void* kargs[] = {&a};
    hipError_t e = hipLaunchCooperativeKernel((const void*)fwd_megakernel, dim3(grid), dim3(NWAVES * 64), kargs, LDS_BYTES, stream);
    if (e != hipSuccess) fprintf(stderr, "kernel_launch: cooperative launch failed: %s (grid %d)\n", hipGetErrorString(e), grid);
}
```

```cpp
#include <hip/hip_runtime.h>
#include <hip/hip_cooperative_groups.h>
#include <cstdio>
#include <cstdint>
namespace cg = cooperative_groups;

namespace pg8 {
#define PG8_LAS __attribute__((address_space(3)))
typedef unsigned short bf16_t;
typedef short bf16x8 __attribute__((ext_vector_type(8)));
typedef float f32x4 __attribute__((ext_vector_type(4)));
typedef unsigned u32x4 __attribute__((ext_vector_type(4)));
constexpr int BM = 256, BK = 64, HALF = 128, HTB = HALF * BK * 2  , STAGE_BYTES = 8 * HTB, NXCD = 8, WGM = 8;

__host__ __device__ __forceinline__ int lds_byte(int r, int c) { const int st = (r >> 4) * 2 + (c >> 5), rr = r & 15, cc = c & 31, ob = rr * 64 + cc * 2; return st * 1024 + (ob ^ (((ob >> 9) & 1) << 5)); }
__host__ __device__ __forceinline__ void stage_rc(int b, int& R, int& C) { const int st = b / 1024, sb = b % 1024, swz = sb ^ (((sb >> 9) & 1) << 5); R = (st >> 1) * 16 + swz / 64; C = (st & 1) * 32 + (swz % 64) / 2; }
__host__ __device__ __forceinline__ int perm32(int rho) { const int n = rho >> 4, i = rho & 15; return 8 * (i >> 2) + 4 * n + (i & 3); }

struct Unit { int pm, pn, sub; };
struct Gemm { const bf16_t* A; const bf16_t* Bt; int M, N, K; };

struct StaticOrder {
    int nM, nN, nwg, G, c;
    __host__ __device__ void init(int M, int N, int G_, int c_) { nM = M / BM; nN = N / BM; nwg = nM * nN; G = G_; c = c_; }
    __host__ __device__ bool next(int i, Unit& u) const {
        const long L = (long)i * G + c; if (L >= nwg) return false;
        int wgid = (int)L; { const int q = nwg / NXCD, r = nwg % NXCD, xcd = wgid % NXCD, off = wgid / NXCD; wgid = (xcd < r ? xcd * (q + 1) : r * (q + 1) + (xcd - r) * q) + off; }
        const int nig = WGM * nN, gid = wgid / nig, fm = gid * WGM, gsz = (nM - fm) < WGM ? (nM - fm) : WGM;
        u.pm = fm + ((wgid % nig) % gsz); u.pn = (wgid % nig) / gsz; u.sub = 15; return true;
    }
    __device__ __forceinline__ void a_ready(const Unit&) const {}
    __device__ __forceinline__ void done(const Unit&) const {}
};

__device__ __forceinline__ unsigned cvt_pk_bf16(float lo, float hi) { unsigned r; asm("v_cvt_pk_bf16_f32 %0, %1, %2" : "=v"(r) : "v"(lo), "v"(hi)); return r; }
typedef float f32x2 __attribute__((ext_vector_type(2)));
struct MixedOrder {
    StaticOrder so; int nP, nQ, nNq, nMf, G, c;
    __device__ __forceinline__ void init(int Mfull, int Mquad, int N, int G_, int c_) { so.init(Mfull, N, G_, c_); nMf = Mfull / BM; nNq = N / BM; nP = nMf * nNq; nQ = (Mquad / BM) * nNq * 4; G = G_; c = c_; }
    __device__ __forceinline__ bool next(int i, Unit& u) const {
        const long L = (long)i * G + c; if (L < nP) return so.next(i, u);
        const int q = (int)(L - nP); if (q >= nQ) return false;
        const int t = q >> 2; u.sub = 1 << (q & 3); u.pn = t % nNq; u.pm = nMf + t / nNq; return true;
    }
    __device__ __forceinline__ void a_ready(const Unit&) const {}
    __device__ __forceinline__ void done(const Unit&) const {}
};
struct RangeOrder {
    int u0, u1, G2, c2;
    __device__ __forceinline__ bool next(int i, Unit& u) const { if (c2 < 0) return false; const int L = u0 + i * G2 + c2; if (L >= u1) return false; u.pm = L >> 2; u.pn = L & 3; u.sub = 15; return true; }
    __device__ __forceinline__ void a_ready(const Unit&) const {}
    __device__ __forceinline__ void done(const Unit&) const {}
};
typedef float f32x2 __attribute__((ext_vector_type(2)));
typedef __bf16 bf2_t __attribute__((ext_vector_type(2)));
typedef __bf16 bf8_t __attribute__((ext_vector_type(8)));
constexpr float RMS_EPS = 1e-6f;
__device__ __forceinline__ float ssq8(bf16x8 v, float s) {
    const bf8_t b = __builtin_bit_cast(bf8_t, v);
#pragma unroll
    for (int i = 0; i < 4; ++i) { const bf2_t p = {b[2 * i], b[2 * i + 1]}; s = __builtin_amdgcn_fdot2_f32_bf16(p, p, s, false); }
    return s;
}
__device__ __forceinline__ float ssq2(bf16x8 v, int i, float s) {
    const bf8_t b = __builtin_bit_cast(bf8_t, v); const bf2_t p = {b[2 * i], b[2 * i + 1]}; return __builtin_amdgcn_fdot2_f32_bf16(p, p, s, false);
}
__device__ __forceinline__ float sigmoid_f(float v) { return __builtin_amdgcn_rcpf(1.0f + __builtin_amdgcn_exp2f(v * -1.4426950408889634f)); }
__device__ __forceinline__ float silu_f(float v) { return v * sigmoid_f(v); }

struct EpiSwiGLU {
    static constexpr bool PERM = true, AFTER_DRAIN = false, NEED_RS = true;
    bf16_t* O; int ldc;
    __device__ __forceinline__ void operator()(const f32x4 (&acc)[2][2][4][2], const float (&rsv)[2][4], const Unit& u, int wr, int wc, int fr, int fq) const {
        const int row0 = u.pm * BM + wr * 64 + fr, col0 = u.pn * HALF + wc * 32 + 8 * fq;
#pragma unroll
        for (int ai = 0; ai < 2; ++ai)
#pragma unroll
            for (int m = 0; m < 4; ++m) { const int row = row0 + ai * HALF + m * 16; const float rs = rsv[ai][m], c1 = rs * -1.4426950408889634f, rs2 = rs * rs;
                unsigned wv[4];
#pragma unroll
                for (int n = 0; n < 2; ++n)
#pragma unroll
                    for (int j = 0; j < 4; j += 2) { const f32x2 g = {acc[ai][0][m][n][j], acc[ai][0][m][n][j + 1]}, up = {acc[ai][1][m][n][j], acc[ai][1][m][n][j + 1]};
                        const f32x2 t = g * c1; f32x2 e; e.x = __builtin_amdgcn_exp2f(t.x); e.y = __builtin_amdgcn_exp2f(t.y);
                        const f32x2 d = e + 1.0f; f32x2 r; r.x = __builtin_amdgcn_rcpf(d.x); r.y = __builtin_amdgcn_rcpf(d.y);
                        const f32x2 o = ((g * up) * rs2) * r;
                        wv[2 * n + (j >> 1)] = cvt_pk_bf16(o.x, o.y); }
                u32x4 w; w.x = wv[0]; w.y = wv[1]; w.z = wv[2]; w.w = wv[3];
                *(u32x4*)(O + (size_t)row * ldc + col0) = w; }
    }
};
template <bool RS> struct EpiScaleBf16 {
    static constexpr bool PERM = true, AFTER_DRAIN = false, NEED_RS = RS;
    bf16_t* O; int ldc;
    __device__ __forceinline__ void operator()(const f32x4 (&acc)[2][2][4][2], const float (&rsv)[2][4], const Unit& u, int wr, int wc, int fr, int fq) const {
        const int row0 = u.pm * BM + wr * 64 + fr, col0 = u.pn * BM + wc * 32 + 8 * fq;
#pragma unroll
        for (int ai = 0; ai < 2; ++ai)
#pragma unroll
            for (int m = 0; m < 4; ++m) { const int row = row0 + ai * HALF + m * 16; const float rs = RS ? rsv[ai][m] : 1.0f;
#pragma unroll
                for (int bj = 0; bj < 2; ++bj) if ((u.sub >> (2 * ai + bj)) & 1) { const f32x4 v0 = acc[ai][bj][m][0] * rs, v1 = acc[ai][bj][m][1] * rs;
                    u32x4 w; w.x = cvt_pk_bf16(v0[0], v0[1]); w.y = cvt_pk_bf16(v0[2], v0[3]); w.z = cvt_pk_bf16(v1[0], v1[1]); w.w = cvt_pk_bf16(v1[2], v1[3]);
                    *(u32x4*)(O + (size_t)row * ldc + col0 + bj * HALF) = w; } }
    }
};
template <int MODE> struct EpiResid {
    static constexpr bool PERM = true, AFTER_DRAIN = false, NEED_RS = (MODE == 1);
    bf16_t* XB; const bf16_t* XR; float scale; const bf16_t* proj;
    __device__ __forceinline__ void operator()(const f32x4 (&acc)[2][2][4][2], const float (&rsv)[2][4], const Unit& u, int wr, int wc, int fr, int fq) const {
        const int row0 = u.pm * BM + wr * 64 + fr, col0 = u.pn * BM + wc * 32 + 8 * fq;
#pragma unroll
        for (int ai = 0; ai < 2; ++ai)
#pragma unroll
            for (int m = 0; m < 4; ++m) { const int row = row0 + ai * HALF + m * 16; const float rs = (MODE == 1) ? rsv[ai][m] : 1.0f;
#pragma unroll
                for (int bj = 0; bj < 2; ++bj) if ((u.sub >> (2 * ai + bj)) & 1) { const size_t off = (size_t)row * 1024 + col0 + bj * HALF;
                    const u32x4 rw = *(const u32x4*)(XR + off);
                    f32x4 x0 = {__uint_as_float(rw.x << 16), __uint_as_float(rw.x & 0xffff0000u), __uint_as_float(rw.y << 16), __uint_as_float(rw.y & 0xffff0000u)};
                    f32x4 x1 = {__uint_as_float(rw.z << 16), __uint_as_float(rw.z & 0xffff0000u), __uint_as_float(rw.w << 16), __uint_as_float(rw.w & 0xffff0000u)};
                    if (MODE == 0) { x0 += acc[ai][bj][m][0] * scale; x1 += acc[ai][bj][m][1] * scale; }
                    else { const u32x4 pw = *(const u32x4*)(proj + off);
                        const f32x4 a0 = acc[ai][bj][m][0] * rs, a1 = acc[ai][bj][m][1] * rs;
                        x0[0] += sigmoid_f(a0[0]) * __uint_as_float(pw.x << 16); x0[1] += sigmoid_f(a0[1]) * __uint_as_float(pw.x & 0xffff0000u);
                        x0[2] += sigmoid_f(a0[2]) * __uint_as_float(pw.y << 16); x0[3] += sigmoid_f(a0[3]) * __uint_as_float(pw.y & 0xffff0000u);
                        x1[0] += sigmoid_f(a1[0]) * __uint_as_float(pw.z << 16); x1[1] += sigmoid_f(a1[1]) * __uint_as_float(pw.z & 0xffff0000u);
                        x1[2] += sigmoid_f(a1[2]) * __uint_as_float(pw.w << 16); x1[3] += sigmoid_f(a1[3]) * __uint_as_float(pw.w & 0xffff0000u); }
                    u32x4 w; w.x = cvt_pk_bf16(x0[0], x0[1]); w.y = cvt_pk_bf16(x0[2], x0[3]); w.z = cvt_pk_bf16(x1[0], x1[1]); w.w = cvt_pk_bf16(x1[2], x1[3]);
                    *(u32x4*)(XB + off) = w; }
                if ((m & 1) == 1) asm volatile("" ::: "memory"); }
    }
};

struct EpiNull { static constexpr bool PERM = true, AFTER_DRAIN = false, NEED_RS = false;
    __device__ __forceinline__ void operator()(const f32x4 (&acc)[2][2][4][2], const float (&rsv)[2][4], const Unit& u, int wr, int wc, int fr, int fq) const {
        float s = 0.f;
#pragma unroll
        for (int a = 0; a < 2; ++a) for (int b = 0; b < 2; ++b) for (int m = 0; m < 4; ++m) for (int n = 0; n < 2; ++n) s += acc[a][b][m][n][0] + acc[a][b][m][n][1] + acc[a][b][m][n][2] + acc[a][b][m][n][3];
        asm volatile("" :: "v"(s)); } };
template <class Epi, class Sched, bool ALIGN_EPI = false, bool SP2 = false>
__device__ __forceinline__ void gemm_phase(PG8_LAS unsigned char* lds, const Gemm g, const Sched& S, const Epi& E) {
    int tid_ = threadIdx.x; asm volatile("" : "+v"(tid_));
    const int tid = tid_, wid = __builtin_amdgcn_readfirstlane(tid >> 6), lane = tid & 63, wr = wid >> 2, wc = wid & 3, fr = lane & 15, fq = lane >> 4;
    int K_ = g.K; asm volatile("" : "+s"(K_));
    const int K = K_, nt = K / BK;
    unsigned voffA[2], voffB[2];
#pragma unroll
    for (int i = 0; i < 2; ++i) { int R, C; stage_rc(tid * 16 + i * 8192, R, C); const int Rb = Epi::PERM ? ((R & ~31) + perm32(R & 31)) : R;
        voffA[i] = (unsigned)(R * K + C) * 2u; voffB[i] = (unsigned)(Rb * K + C) * 2u; }
    const size_t kstep = (size_t)(BK * 2);
    const size_t hstep = (size_t)HALF * K * 2;
    const size_t tstep = 2 * hstep;
    const unsigned ldsw = (unsigned)wid * 1024u;
    const int aoff = lds_byte(wr * 64 + fr, fq * 8), boff = lds_byte(wc * 32 + fr, fq * 8);
#define PG8_SA(b, h) (((b) * 2 + (h)) * HTB)
#define PG8_SB(b, h) ((4 + (b) * 2 + (h)) * HTB)
#define PG8_STAGE(bufoff, gbase, voff) do { _Pragma("unroll") for (int _i = 0; _i < 2; ++_i) \
        __builtin_amdgcn_global_load_lds((const unsigned*)((const char*)(gbase) + (voff)[_i]), (PG8_LAS unsigned*)(lds + (bufoff) + ldsw + _i * 8192), 16, 0, 0); } while (0)
#define PG8_LDA(dst, b, h) do { _Pragma("unroll") for (int m = 0; m < 4; ++m) _Pragma("unroll") for (int k = 0; k < 2; ++k) dst[m][k] = *(const PG8_LAS bf16x8*)(lds + PG8_SA(b, h) + aoff + m * 2048 + k * 1024); } while (0)
#define PG8_LDB(dst, b, h) do { _Pragma("unroll") for (int n = 0; n < 2; ++n) _Pragma("unroll") for (int k = 0; k < 2; ++k) dst[n][k] = *(const PG8_LAS bf16x8*)(lds + PG8_SB(b, h) + boff + n * 2048 + k * 1024); } while (0)
#define PG8_MMA(ai, bj, At, Bt) do { __builtin_amdgcn_s_setprio(1); _Pragma("unroll") for (int m = 0; m < 4; ++m) _Pragma("unroll") for (int n = 0; n < 2; ++n) _Pragma("unroll") for (int k = 0; k < 2; ++k) \
        acc[ai][bj][m][n] = __builtin_amdgcn_mfma_f32_16x16x32_bf16(Bt[n][k], At[m][k], acc[ai][bj][m][n], 0, 0, 0); __builtin_amdgcn_s_setprio(0); } while (0)
#define PG8_SSQ(ai, kt) do { if constexpr (Epi::NEED_RS) { if (wc == ((kt) & 3)) { _Pragma("unroll") for (int k = 0; k < 2; ++k) _Pragma("unroll") for (int i_ = 0; i_ < 4; ++i_) _Pragma("unroll") for (int m = 0; m < 4; ++m) ssq[ai][m] = ssq2(At[m][k], i_, ssq[ai][m]); } } } while (0)
#define PG8_WAIT_V(n) asm volatile("s_waitcnt vmcnt(" #n ")" ::: "memory")
#define PG8_WAIT_L(n) asm volatile("s_waitcnt lgkmcnt(" #n ")" ::: "memory")
#define PG8_BAR __builtin_amdgcn_s_barrier()
#define PG8_SCHED __builtin_amdgcn_sched_barrier(0)
    Unit cur, nxt; int ui = 0;
    if (!S.next(0, cur)) return;
    f32x4 acc[2][2][4][2];
#pragma unroll
    for (int a = 0; a < 2; ++a)
#pragma unroll
        for (int b = 0; b < 2; ++b)
#pragma unroll
            for (int m = 0; m < 4; ++m)
#pragma unroll
                for (int n = 0; n < 2; ++n) acc[a][b][m][n] = (f32x4){0.f, 0.f, 0.f, 0.f};
    bf16x8 At[4][2], B0[2][2], B1[2][2];
    float ssq[2][4] = {{0.f, 0.f, 0.f, 0.f}, {0.f, 0.f, 0.f, 0.f}};
    static_assert(SP2 || !Epi::NEED_RS, "row statistics are gathered in the SP2 loop only");
    const char* cA = (const char*)g.A + (size_t)cur.pm * tstep; const char* cB = (const char*)g.Bt + (size_t)cur.pn * tstep;
    S.a_ready(cur);
    if constexpr (SP2) {
        PG8_STAGE(PG8_SB(0, 0), cB, voffB); PG8_STAGE(PG8_SB(0, 1), cB + hstep, voffB); PG8_STAGE(PG8_SA(0, 0), cA, voffA); PG8_STAGE(PG8_SA(0, 1), cA + hstep, voffA);
        if (wr == 1) PG8_BAR;
        PG8_WAIT_V(2); PG8_BAR;
        PG8_STAGE(PG8_SB(1, 0), cB + kstep, voffB); PG8_STAGE(PG8_SA(1, 0), cA + kstep, voffA); PG8_STAGE(PG8_SB(1, 1), cB + hstep + kstep, voffB);
        PG8_WAIT_V(6); PG8_BAR;
    } else {
        PG8_STAGE(PG8_SB(0, 0), cB, voffB); PG8_STAGE(PG8_SA(0, 0), cA, voffA); PG8_STAGE(PG8_SB(0, 1), cB + hstep, voffB); PG8_STAGE(PG8_SA(0, 1), cA + hstep, voffA);
        if (wr == 1) PG8_BAR;
        PG8_WAIT_V(4); PG8_BAR;
        PG8_STAGE(PG8_SB(1, 0), cB + kstep, voffB); PG8_STAGE(PG8_SA(1, 0), cA + kstep, voffA); PG8_STAGE(PG8_SB(1, 1), cB + hstep + kstep, voffB);
        PG8_WAIT_V(6); PG8_BAR;
    }
    for (;;) {
        const int mk = __builtin_amdgcn_readfirstlane(cur.sub);
        const bool has_next = S.next(ui + 1, nxt);
        const char* nA = has_next ? (const char*)g.A + (size_t)nxt.pm * tstep : cA; const char* nB = has_next ? (const char*)g.Bt + (size_t)nxt.pn * tstep : cB;
        for (int t = 0; t < nt; t += 2) {
            const bool last = (t == nt - 2);
            const char* a1 = cA + (size_t)(t + 1) * kstep;
            const char* a2 = last ? nA : cA + (size_t)(t + 2) * kstep; const char* b2 = last ? nB : cB + (size_t)(t + 2) * kstep;
            const char* a3 = a2 + kstep; const char* b3 = b2 + kstep;
            if (last && has_next) S.a_ready(nxt);
            if constexpr (SP2) {
            PG8_LDB(B0, 0, 0); PG8_LDB(B1, 0, 1); PG8_SCHED; PG8_LDA(At, 0, 0); PG8_STAGE(PG8_SA(1, 1), a1 + hstep, voffA);
            PG8_WAIT_V(8); PG8_WAIT_L(0); PG8_BAR; if (mk & 1) PG8_MMA(0, 0, At, B0); PG8_SSQ(0, t); if (mk & 2) PG8_MMA(0, 1, At, B1); PG8_BAR; PG8_SCHED;
            PG8_LDA(At, 0, 1); PG8_STAGE(PG8_SB(0, 0), b2, voffB); PG8_STAGE(PG8_SB(0, 1), b2 + hstep, voffB); PG8_STAGE(PG8_SA(0, 0), a2, voffA);
            PG8_WAIT_V(8); PG8_WAIT_L(0); PG8_BAR; if (mk & 4) PG8_MMA(1, 0, At, B0); PG8_SSQ(1, t); if (mk & 8) PG8_MMA(1, 1, At, B1); PG8_BAR; PG8_SCHED;
            PG8_LDB(B0, 1, 0); PG8_LDB(B1, 1, 1); PG8_SCHED; PG8_LDA(At, 1, 0); PG8_STAGE(PG8_SA(0, 1), a2 + hstep, voffA);
            PG8_WAIT_V(8); PG8_WAIT_L(0); PG8_BAR; if (mk & 1) PG8_MMA(0, 0, At, B0); PG8_SSQ(0, t + 1); if (mk & 2) PG8_MMA(0, 1, At, B1); PG8_BAR; PG8_SCHED;
            PG8_LDA(At, 1, 1); PG8_STAGE(PG8_SB(1, 0), b3, voffB); PG8_STAGE(PG8_SB(1, 1), b3 + hstep, voffB); PG8_STAGE(PG8_SA(1, 0), a3, voffA);
            PG8_WAIT_V(8); PG8_WAIT_L(0); PG8_BAR; if (mk & 4) PG8_MMA(1, 0, At, B0); PG8_SSQ(1, t + 1); if (mk & 8) PG8_MMA(1, 1, At, B1); PG8_BAR; PG8_SCHED;
            } else {
            PG8_LDB(B0, 0, 0); PG8_SCHED; PG8_LDA(At, 0, 0); PG8_STAGE(PG8_SA(1, 1), a1 + hstep, voffA);
            PG8_WAIT_L(8); PG8_BAR; PG8_WAIT_L(0); PG8_MMA(0, 0, At, B0); PG8_BAR; PG8_SCHED;
            PG8_LDB(B1, 0, 1); PG8_STAGE(PG8_SB(0, 0), b2, voffB);
            PG8_BAR; PG8_WAIT_L(0); PG8_MMA(0, 1, At, B1); PG8_BAR;
            PG8_LDA(At, 0, 1); PG8_STAGE(PG8_SA(0, 0), a2, voffA);
            PG8_BAR; PG8_WAIT_L(0); PG8_MMA(1, 0, At, B0); PG8_BAR; PG8_SCHED;
            PG8_STAGE(PG8_SB(0, 1), b2 + hstep, voffB);
            PG8_WAIT_V(6); PG8_BAR; PG8_MMA(1, 1, At, B1); PG8_BAR;
            PG8_LDB(B0, 1, 0); PG8_SCHED; PG8_LDA(At, 1, 0); PG8_STAGE(PG8_SA(0, 1), a2 + hstep, voffA);
            PG8_WAIT_L(8); PG8_BAR; PG8_WAIT_L(0); PG8_MMA(0, 0, At, B0); PG8_BAR; PG8_SCHED;
            PG8_LDB(B1, 1, 1); PG8_STAGE(PG8_SB(1, 0), b3, voffB);
            PG8_BAR; PG8_WAIT_L(0); PG8_MMA(0, 1, At, B1); PG8_BAR;
            PG8_LDA(At, 1, 1); PG8_STAGE(PG8_SA(1, 0), a3, voffA);
            PG8_BAR; PG8_WAIT_L(0); PG8_MMA(1, 0, At, B0); PG8_BAR; PG8_SCHED;
            PG8_STAGE(PG8_SB(1, 1), b3 + hstep, voffB);
            PG8_WAIT_V(6); PG8_BAR; PG8_MMA(1, 1, At, B1); PG8_BAR;
            }
        }
        if constexpr (ALIGN_EPI) { if (wr == 0) PG8_BAR; }
        { float rsv[2][4];
            if constexpr (Epi::NEED_RS) {
                static_assert(ALIGN_EPI, "the row-statistics exchange needs both halves at the same barrier");
                PG8_LAS float* rst = (PG8_LAS float*)(lds + STAGE_BYTES + 1024);
#pragma unroll
                for (int a = 0; a < 2; ++a)
#pragma unroll
                    for (int m = 0; m < 4; ++m) { float q = ssq[a][m]; q += __shfl_xor(q, 16); q += __shfl_xor(q, 32); if (fq == 0) rst[wc * 256 + a * HALF + wr * 64 + m * 16 + fr] = q; ssq[a][m] = 0.f; }
                PG8_WAIT_L(0); PG8_BAR; asm volatile("" ::: "memory");
#pragma unroll
                for (int a = 0; a < 2; ++a)
#pragma unroll
                    for (int m = 0; m < 4; ++m) { const int r_ = a * HALF + wr * 64 + m * 16 + fr; const float q = (rst[r_] + rst[256 + r_]) + (rst[512 + r_] + rst[768 + r_]);
                        rsv[a][m] = __builtin_amdgcn_rsqf(q * (1.0f / 1024.0f) + RMS_EPS); }
            } else {
#pragma unroll
                for (int a = 0; a < 2; ++a)
#pragma unroll
                    for (int m = 0; m < 4; ++m) rsv[a][m] = 1.0f;
            }
            E(acc, rsv, cur, wr, wc, fr, fq); S.done(cur); }
        if (!has_next) break;
#pragma unroll
        for (int a = 0; a < 2; ++a)
#pragma unroll
            for (int b = 0; b < 2; ++b)
#pragma unroll
                for (int m = 0; m < 4; ++m)
#pragma unroll
                    for (int n = 0; n < 2; ++n) acc[a][b][m][n] = (f32x4){0.f, 0.f, 0.f, 0.f};
        cur = nxt; cA = nA; cB = nB; ++ui;
        if constexpr (ALIGN_EPI) { if (wr == 1) PG8_BAR; }
    }
    PG8_WAIT_V(0);
    if constexpr (!ALIGN_EPI) { if (wr == 0) PG8_BAR; }
    PG8_BAR;
#undef PG8_SA
#undef PG8_SB
#undef PG8_STAGE
#undef PG8_LDA
#undef PG8_LDB
#undef PG8_MMA
#undef PG8_SSQ
#undef PG8_WAIT_V
#undef PG8_WAIT_L
#undef PG8_BAR
#undef PG8_SCHED
}
}
constexpr int NWAVES = 8;
constexpr int D = 1024, FF = 2816, NGU = 2 * FF, MIXW = 2048, DPLE = 256, DEPTH = 2;
constexpr int BATCH = 8, SEQ = 2048, DECB = 128, DECS = 8;
constexpr int MP = BATCH * SEQ, MS = DECB * DECS, M = MP + MS;
constexpr int NIN = 33;
constexpr size_t MiB = 1u << 20;
constexpr size_t WS_CTL = 0, CTL_ZERO_BYTES = 64 * 1024;
constexpr size_t WS_W = 1 * MiB;
constexpr size_t W_GU = (size_t)NGU * D * 2, W_DN = (size_t)D * FF * 2, W_MI = (size_t)MIXW * D * 2, W_MO = (size_t)D * D * 2, W_PG = (size_t)D * D * 2, W_PP = (size_t)D * DPLE * 2;
constexpr size_t WO_GU1 = 0, WO_D1 = WO_GU1 + W_GU, WO_MI = WO_D1 + W_DN, WO_MO = WO_MI + W_MI, WO_GU2 = WO_MO + W_MO, WO_D2 = WO_GU2 + W_GU, WO_PG = WO_D2 + W_DN, WO_PP = WO_PG + W_PG, W_LAYER = WO_PP + W_PP;
constexpr size_t WS_BUFA = WS_W + DEPTH * W_LAYER;
constexpr size_t BUF_BYTES = (size_t)M * D * 2;
constexpr size_t WS_BUFB = WS_BUFA + BUF_BYTES;
constexpr size_t WS_PB = WS_BUFB + BUF_BYTES;
constexpr size_t WS_ACT = WS_PB + (size_t)DEPTH * M * DPLE * 2;
constexpr size_t WS_END = WS_ACT + (size_t)M * FF * 2;
static_assert(WS_W % 256 == 0 && W_LAYER % 256 == 0 && WS_BUFA % 256 == 0 && WS_PB % 256 == 0 && WS_ACT % 256 == 0, "alignment");
constexpr int CW_BAR = 1024;
constexpr int RING_OFF = 0, RING_BYTES = 131072;
constexpr int LDSCTL_OFF = RING_BYTES, MISC_OFF = LDSCTL_OFF + 320;
constexpr int LDS_BYTES = 147456;
#define GAS __attribute__((address_space(1)))
#define LAS __attribute__((address_space(3)))
typedef unsigned short bf16;
typedef unsigned v4u __attribute__((ext_vector_type(4)));
typedef float f32x4 __attribute__((ext_vector_type(4)));
typedef short bf16x8 __attribute__((ext_vector_type(8)));
typedef GAS unsigned gu32;
typedef GAS unsigned long long gu64;
#define RLX_AGENT __ATOMIC_RELAXED, __HIP_MEMORY_SCOPE_AGENT
#define LDS_WAIT() asm volatile("s_waitcnt lgkmcnt(0)" ::: "memory")
#define VM_WAIT() asm volatile("s_waitcnt vmcnt(0)" ::: "memory")
__device__ __forceinline__ unsigned long long rt() { return __builtin_amdgcn_s_memrealtime(); }
__device__ __forceinline__ unsigned pk2(float lo, float hi) { unsigned r; asm("v_cvt_pk_bf16_f32 %0, %1, %2" : "=v"(r) : "v"(lo), "v"(hi)); return r; }
__device__ __forceinline__ unsigned f2bf(float f) { return pk2(f, f) & 0xffffu; }
#define XB_TMO      128
#define XB_XCNT(j)  (256  + 64 * (j))
#define XB_XSUB(j)  (1280 + 64 * (j))
#define XB_XGEN(j)  (2304 + 64 * (j))
#define XB_TOP      3328
#define XB_TOPGEN   3392
#define XCD_BAR_WORDS 3456
#define XB_SPIN_CAP (1u << 18)

__device__ __forceinline__ unsigned xb_ld(unsigned* p)              { return __hip_atomic_load(p, __ATOMIC_RELAXED, __HIP_MEMORY_SCOPE_AGENT); }
__device__ __forceinline__ unsigned xb_add(unsigned* p, unsigned v) { return __hip_atomic_fetch_add(p, v, __ATOMIC_RELAXED, __HIP_MEMORY_SCOPE_AGENT); }
__device__ __forceinline__ unsigned xb_xcc_id() { return (unsigned)__builtin_amdgcn_s_getreg((3 << 11) | 20) & 0xFu; }
#define XB_SPIN(cond, bar) do { unsigned _sp = 0; while (cond) { __builtin_amdgcn_s_sleep(1); \
    if ((++_sp & 255u) == 0u) { if (xb_ld(&(bar)[XB_TMO])) break; if (_sp > XB_SPIN_CAP) { atomicAdd(&(bar)[XB_TMO], 1u); break; } } } } while (0)

struct XcdBarrier {
    unsigned* bar; unsigned x;
    volatile LAS unsigned* st;
};

__device__ __forceinline__ XcdBarrier xcd_barrier_post(unsigned* bar, volatile LAS unsigned* st) {
    XcdBarrier b; b.bar = bar; b.x = xb_xcc_id(); b.st = st;
    if (threadIdx.x == 0) st[4] = xb_add(&bar[XB_XCNT(b.x)], 1u);
    return b;
}
__device__ __forceinline__ void xcd_barrier_complete(unsigned* bar, unsigned x, unsigned& nloc, unsigned& nx) {
    const unsigned G = gridDim.x * gridDim.y * gridDim.z;
    unsigned sum, cnt, mine, sp = 0u;
    for (;;) {
        sum = 0u; cnt = 0u; mine = 0u;
#pragma nounroll
        for (unsigned j = 0; j < 16; ++j) { const unsigned c = xb_ld(&bar[XB_XCNT(j)]); sum += c; cnt += (c > 0u) ? 1u : 0u; mine = (j == x) ? c : mine; }
        if (sum == G) break;
        __builtin_amdgcn_s_sleep(1);
        if ((++sp & 255u) == 0u) { if (xb_ld(&bar[XB_TMO])) break; if (sp > XB_SPIN_CAP) { atomicAdd(&bar[XB_TMO], 1u); break; } }
    }
    nloc = mine > 0u ? mine : 1u; nx = cnt > 0u ? cnt : 1u;
}

__device__ __forceinline__ void xcd_barrier(const XcdBarrier& b) {
    asm volatile("s_waitcnt vmcnt(0)" ::: "memory");
    __syncthreads();
    if (threadIdx.x == 0) {
        unsigned* bar = b.bar; const unsigned bx_ = xb_xcc_id();
        __builtin_amdgcn_s_waitcnt(0);
        unsigned nloc = b.st[0], nx = b.st[1];
        if (nloc == 0u) { xcd_barrier_complete(bar, bx_, nloc, nx); b.st[0] = nloc; b.st[1] = nx; }
        asm volatile("buffer_inv sc1" ::: "memory");
        const unsigned old = xb_add(&bar[XB_XSUB(bx_)], 1u);
        const unsigned gen = old / nloc;
        if (old + 1u == (gen + 1u) * nloc) {
            __builtin_amdgcn_fence(__ATOMIC_RELEASE, "agent");
            asm volatile("s_waitcnt vmcnt(0)" ::: "memory");
            const unsigned og = xb_add(&bar[XB_TOP], 1u);
            const unsigned tg = og / nx;
            if (og + 1u == (tg + 1u) * nx) xb_add(&bar[XB_TOPGEN], 1u);
            else XB_SPIN(xb_ld(&bar[XB_TOPGEN]) == tg, bar);
            asm volatile("" ::: "memory");
            xb_add(&bar[XB_XGEN(bx_)], 1u);
            asm volatile("s_waitcnt vmcnt(0)" ::: "memory");
        } else {
            XB_SPIN(xb_ld(&bar[XB_XGEN(bx_)]) == gen, bar);
            asm volatile("" ::: "memory");
            asm volatile("s_waitcnt vmcnt(0)" ::: "memory");
        }
    }
    __syncthreads();
}

__device__ __forceinline__ int opaque_s(int v) { asm volatile("" : "+s"(v)); return v; }
struct Args { const float* in[NIN]; float* out; unsigned char* ws; };
struct Frame {
    LAS unsigned char* lds;
    int tid, lane, wave, vcu, G;
};
template <int CTRL> __device__ __forceinline__ float dpp_add(float v) {
    const int vi = __builtin_bit_cast(int, v);
    return v + __builtin_bit_cast(float, __builtin_amdgcn_update_dpp(vi, vi, CTRL, 0xF, 0xF, false));
}
__device__ __forceinline__ float wave_sum(float v) {
    v = dpp_add<0xB1>(v); v = dpp_add<0x4E>(v); v = dpp_add<0x141>(v); v = dpp_add<0x140>(v);
    v = dpp_add<0x142>(v);
    v = dpp_add<0x143>(v);
    return __builtin_bit_cast(float, __builtin_amdgcn_readlane(__builtin_bit_cast(int, v), 63));
}
#define WS4_STEP(ctl) "v_add_f32_dpp %0, %0, %0 " ctl " row_mask:0xf bank_mask:0xf\n\tv_add_f32_dpp %1, %1, %1 " ctl " row_mask:0xf bank_mask:0xf\n\tv_add_f32_dpp %2, %2, %2 " ctl " row_mask:0xf bank_mask:0xf\n\tv_add_f32_dpp %3, %3, %3 " ctl " row_mask:0xf bank_mask:0xf\n\t"
__device__ __forceinline__ void wave_sum4(float& a, float& b, float& c, float& d) {
    asm volatile("s_nop 1\n\t" WS4_STEP("quad_perm:[1,0,3,2]") WS4_STEP("quad_perm:[2,3,0,1]") WS4_STEP("row_half_mirror") WS4_STEP("row_mirror") WS4_STEP("row_bcast:15") WS4_STEP("row_bcast:31") "s_nop 1"
                 : "+v"(a), "+v"(b), "+v"(c), "+v"(d));
    a = __builtin_bit_cast(float, __builtin_amdgcn_readlane(__builtin_bit_cast(int, a), 63)); b = __builtin_bit_cast(float, __builtin_amdgcn_readlane(__builtin_bit_cast(int, b), 63));
    c = __builtin_bit_cast(float, __builtin_amdgcn_readlane(__builtin_bit_cast(int, c), 63)); d = __builtin_bit_cast(float, __builtin_amdgcn_readlane(__builtin_bit_cast(int, d), 63));
}
__device__ __forceinline__ void ln8_stats(const float (&v)[8], float (&mean)[8], float (&rstd)[8], float eps) {
    float s[8];
#pragma unroll
    for (int r = 0; r < 8; ++r) s[r] = v[r];
    wave_sum4(s[0], s[1], s[2], s[3]); wave_sum4(s[4], s[5], s[6], s[7]);
#pragma unroll
    for (int r = 0; r < 8; ++r) { mean[r] = s[r] * (1.f / 64.f); const float dv = v[r] - mean[r]; s[r] = dv * dv; }
    wave_sum4(s[0], s[1], s[2], s[3]); wave_sum4(s[4], s[5], s[6], s[7]);
#pragma unroll
    for (int r = 0; r < 8; ++r) rstd[r] = __builtin_amdgcn_rsqf(s[r] * (1.f / 64.f) + eps);
}
__device__ __forceinline__ float bf2f(bf16 v) { return __uint_as_float((unsigned)v << 16); }
__device__ __forceinline__ float gelu_tanh(float v) {
    const float t = 1.5957691216057308f * (v + 0.044715f * v * v * v);
    return v * __builtin_amdgcn_rcpf(1.0f + __builtin_amdgcn_exp2f(t * -1.4426950408889634f));
}
__device__ __forceinline__ void p0_transpose_item(const float* W, int K, int N, bf16* WT, const float* gain, int mode, LAS float* scr, int item, int lane) {
    const int nblk = N / 64, kb = item / nblk, nb = item % nblk, k0 = 32 * kb, n0 = 64 * nb;
    const int c4 = (lane & 15) * 4, kq = lane >> 4;
    f32x4 v[8];
#pragma unroll
    for (int i = 0; i < 8; ++i) v[i] = __builtin_nontemporal_load((const f32x4*)(W + (size_t)(k0 + 4 * i + kq) * N + n0 + c4));
#pragma unroll
    for (int i = 0; i < 8; ++i) { const int kk = 4 * i + kq; const float g = gain ? gain[k0 + kk] : 1.0f; LAS float* s = scr + kk * 65 + c4;
        s[0] = v[i].x * g; s[1] = v[i].y * g; s[2] = v[i].z * g; s[3] = v[i].w * g; }
    LDS_WAIT(); asm volatile("" ::: "memory");
    const int c = lane & 3;
    const int rbase = (mode == 0) ? n0 : (256 * (n0 >> 7) + (n0 & 127) + (mode == 2 ? 128 : 0));
#pragma unroll
    for (int j = 0; j < 4; ++j) { const int n = (lane >> 2) + 16 * j; const LAS float* s = scr + (8 * c) * 65 + n;
        v4u o; o.x = pk2(s[0 * 65], s[1 * 65]); o.y = pk2(s[2 * 65], s[3 * 65]); o.z = pk2(s[4 * 65], s[5 * 65]); o.w = pk2(s[6 * 65], s[7 * 65]);
        *(GAS v4u*)(WT + (size_t)(rbase + n) * K + k0 + 8 * c) = o; }
    LDS_WAIT(); asm volatile("" ::: "memory");
}
__device__ __forceinline__ void p0_convert(Frame& F, const Args& args, int it0, int it1, int gw, int NGW) {
    LAS float* scr = (LAS float*)(F.lds + RING_OFF + F.wave * 16384);
    unsigned char* ws = args.ws;
    constexpr int I_GU = (D / 32) * (FF / 64), I_DN = (FF / 32) * (D / 64), I_MI = (D / 32) * (MIXW / 64), I_SQ = (D / 32) * (D / 64), I_PP = (DPLE / 32) * (D / 64);
    constexpr int I_LAYER = 6 * I_GU + I_MI + 2 * I_SQ + I_PP;
    static_assert(I_DN == I_GU, "item counts");
    for (int it = it0 + gw; it < it1; it += NGW) {
        const int li = it / I_LAYER; int r = it % I_LAYER;
        unsigned char* wl = ws + WS_W + (size_t)li * W_LAYER;
        if (r < I_GU) { p0_transpose_item(args.in[opaque_s(8)] + (size_t)li * D * FF, D, FF, (bf16*)(wl + WO_GU1), args.in[opaque_s(7)] + li * D, 1, scr, r, F.lane); continue; } r -= I_GU;
        if (r < I_GU) { p0_transpose_item(args.in[opaque_s(9)] + (size_t)li * D * FF, D, FF, (bf16*)(wl + WO_GU1), args.in[opaque_s(7)] + li * D, 2, scr, r, F.lane); continue; } r -= I_GU;
        if (r < I_GU) { p0_transpose_item(args.in[opaque_s(10)] + (size_t)li * D * FF, FF, D, (bf16*)(wl + WO_D1), nullptr, 0, scr, r, F.lane); continue; } r -= I_GU;
        if (r < I_GU) { p0_transpose_item(args.in[opaque_s(26)] + (size_t)li * D * FF, D, FF, (bf16*)(wl + WO_GU2), args.in[opaque_s(25)] + li * D, 1, scr, r, F.lane); continue; } r -= I_GU;
        if (r < I_GU) { p0_transpose_item(args.in[opaque_s(27)] + (size_t)li * D * FF, D, FF, (bf16*)(wl + WO_GU2), args.in[opaque_s(25)] + li * D, 2, scr, r, F.lane); continue; } r -= I_GU;
        if (r < I_GU) { p0_transpose_item(args.in[opaque_s(28)] + (size_t)li * D * FF, FF, D, (bf16*)(wl + WO_D2), nullptr, 0, scr, r, F.lane); continue; } r -= I_GU;
        if (r < I_MI) { p0_transpose_item(args.in[opaque_s(12)] + (size_t)li * D * MIXW, D, MIXW, (bf16*)(wl + WO_MI), args.in[opaque_s(11)] + li * D, 0, scr, r, F.lane); continue; } r -= I_MI;
        if (r < I_SQ) { p0_transpose_item(args.in[opaque_s(24)] + (size_t)li * D * D, D, D, (bf16*)(wl + WO_MO), nullptr, 0, scr, r, F.lane); continue; } r -= I_SQ;
        if (r < I_SQ) { p0_transpose_item(args.in[opaque_s(30)] + (size_t)li * D * D, D, D, (bf16*)(wl + WO_PG), args.in[opaque_s(29)] + li * D, 0, scr, r, F.lane); continue; } r -= I_SQ;
        p0_transpose_item(args.in[opaque_s(31)] + (size_t)li * DPLE * D, DPLE, D, (bf16*)(wl + WO_PP), nullptr, 0, scr, r, F.lane);
    }
}
__device__ __forceinline__ void p0_pb(Frame& F, const Args& args, int q0, int q1, int gw, int NGW) {
    bf16* PB = (bf16*)(args.ws + WS_PB);
    const float* pp = args.in[opaque_s(2)]; const float* psm = args.in[opaque_s(3)];
    for (int q = q0 + gw; q < q1; q += NGW) {
        const int li = q / M, m = q % M;
        const float* src = (m < MP) ? pp + ((size_t)li * MP + m) * DPLE : psm + ((size_t)li * MS + (m - MP)) * DPLE;
        const f32x4 v = ((const GAS f32x4*)src)[F.lane];
        ((GAS unsigned long long*)(PB + (size_t)q * DPLE))[F.lane] = (unsigned long long)pk2(v.x, v.y) | ((unsigned long long)pk2(v.z, v.w) << 32);
    }
}
constexpr int P0_I_LAYER = 6 * (D / 32) * (FF / 64) + (D / 32) * (MIXW / 64) + 2 * (D / 32) * (D / 64) + (DPLE / 32) * (D / 64);
__device__ __forceinline__ void p0_prologue(Frame& F, const Args& args) {
    const int gw = F.vcu * NWAVES + F.wave, NGW = F.G * NWAVES;
    unsigned char* ws = args.ws;
    p0_convert(F, args, 0, P0_I_LAYER, gw, NGW);
    float* X = args.out; bf16* XB = (bf16*)(ws + WS_BUFA);
    for (int m = gw; m < M; m += NGW) {
        const float* src = (m < MP) ? args.in[opaque_s(0)] + (size_t)m * D : args.in[opaque_s(1)] + (size_t)(m - MP) * D;
        const GAS f32x4* xr = (const GAS f32x4*)src + F.lane; GAS f32x4* xo = (GAS f32x4*)(X + (size_t)m * D) + F.lane;
        GAS unsigned long long* o8 = (GAS unsigned long long*)(XB + (size_t)m * D) + F.lane;
#pragma unroll
        for (int j = 0; j < 4; ++j) { const f32x4 v = xr[64 * j];
            o8[64 * j] = (unsigned long long)pk2(v.x, v.y) | ((unsigned long long)pk2(v.z, v.w) << 32); }
    }
    p0_pb(F, args, 0, M, gw, NGW);
}
__device__ __forceinline__ void final_norm(Frame& F, const Args& args, const bf16* XBF) {
    const int gw = F.vcu * NWAVES + F.wave, NGW = F.G * NWAVES;
    float* Y = args.out; const float* g = args.in[opaque_s(32)];
    f32x4 gv[4];
#pragma unroll
    for (int j = 0; j < 4; ++j) gv[j] = ((const GAS f32x4*)g)[4 * F.lane + j];
    for (int m = gw; m < M; m += NGW) {
        const GAS v4u* xr = (const GAS v4u*)(XBF + (size_t)m * D) + 2 * F.lane;
        const v4u r0 = xr[0], r1 = xr[1];
        f32x4 v[4];
        v[0] = (f32x4){__uint_as_float(r0.x << 16), __uint_as_float(r0.x & 0xffff0000u), __uint_as_float(r0.y << 16), __uint_as_float(r0.y & 0xffff0000u)};
        v[1] = (f32x4){__uint_as_float(r0.z << 16), __uint_as_float(r0.z & 0xffff0000u), __uint_as_float(r0.w << 16), __uint_as_float(r0.w & 0xffff0000u)};
        v[2] = (f32x4){__uint_as_float(r1.x << 16), __uint_as_float(r1.x & 0xffff0000u), __uint_as_float(r1.y << 16), __uint_as_float(r1.y & 0xffff0000u)};
        v[3] = (f32x4){__uint_as_float(r1.z << 16), __uint_as_float(r1.z & 0xffff0000u), __uint_as_float(r1.w << 16), __uint_as_float(r1.w & 0xffff0000u)};
        float s_ = 0.f;
#pragma unroll
        for (int j = 0; j < 4; ++j) s_ += (v[j].x * v[j].x + v[j].y * v[j].y) + (v[j].z * v[j].z + v[j].w * v[j].w);
        const float rs = __builtin_amdgcn_rsqf(wave_sum(s_) * (1.0f / D) + pg8::RMS_EPS);
        GAS f32x4* yo = (GAS f32x4*)(Y + (size_t)m * D) + 4 * F.lane;
#pragma unroll
        for (int j = 0; j < 4; ++j) yo[j] = v[j] * rs * gv[j];
    }
}
constexpr size_t O_Y = 0, O_CA_P = (size_t)M * D, O_CA_S = O_CA_P + (size_t)DEPTH * BATCH * 30 * 256, O_PL_P = O_CA_S + (size_t)DEPTH * DECB * 30 * 256,
                 O_PL_S = O_PL_P + (size_t)DEPTH * BATCH * 15 * 256, O_SC_P = O_PL_S + (size_t)DEPTH * DECB * 15 * 256, O_SC_S = O_SC_P + (size_t)DEPTH * BATCH * 2 * 256,
                 O_CV_S = O_SC_S + (size_t)DEPTH * DECB * 2 * 256, O_END = O_CV_S + (size_t)DEPTH * DECB * DECS * 256;
constexpr float LN_EPS = 1e-6f;
constexpr int VNT_OFF = 0, VNT_PITCH = 272, WPT_OFF = 64 * VNT_PITCH, WPT_PITCH = 144, DT_OFF = WPT_OFF + 64 * WPT_PITCH, DT_PITCH = 144;
struct MixP { const bf16* Z; bf16* MIX; const float *caw, *cab, *nag, *nab, *pw, *ps, *sng, *snb, *sw, *sb, *scw; float* out; int li; const float *st_a, *st_p, *st_s; };
#define OPAQUE_S(p) asm volatile("" : "+s"(p))
template <class T> __device__ __forceinline__ T* uni_ptr(T* p) {
    const unsigned long long v = (unsigned long long)p; const unsigned lo = __builtin_amdgcn_readfirstlane((unsigned)v), hi = __builtin_amdgcn_readfirstlane((unsigned)(v >> 32));
    return (T*)(((unsigned long long)hi << 32) | lo); }
__device__ __forceinline__ bf16 f2bf16(float f) { return (bf16)f2bf(f); }
__device__ __forceinline__ float pool_sel(int h, float s2, float s4, float s8, float s16) { return h == 0 ? s2 : (h == 1 ? s4 : (h == 2 ? s8 : s16)); }

__device__ __forceinline__ void mix_prompt_unit(Frame& F, const MixP& P, int b, int c, int h) {
    const int w = F.wave, lane = F.lane, ch = h * 64 + lane, fr = lane & 15, fq = lane >> 4;
    const int tb = __builtin_amdgcn_readfirstlane(128 * c + 16 * w);
    const bf16* Zs = uni_ptr(P.Z + (size_t)b * SEQ * MIXW);
    bf16* Ms = uni_ptr(P.MIX + (size_t)b * SEQ * D);
    const int li = P.li;
    { const int n = F.tid & 63, kg = F.tid >> 6; const float* src = P.pw + (size_t)h * 4096 + (size_t)(8 * kg) * 64 + n;
      v4u o; o.x = pk2(src[0], src[64]); o.y = pk2(src[128], src[192]); o.z = pk2(src[256], src[320]); o.w = pk2(src[384], src[448]);
      *(LAS v4u*)(F.lds + WPT_OFF + n * WPT_PITCH + kg * 16) = o; }
    {
        float wA[31];
        { const float* wp = P.caw;
#pragma unroll
        for (int k = 0; k < 31; ++k) { wA[k] = wp[ch]; wp += 256; OPAQUE_S(wp); } }
        float ext[46];
        { const bf16* zp = uni_ptr(Zs + ((ptrdiff_t)(tb - 30) * MIXW));
#pragma unroll
        for (int j = 0; j < 46; ++j) { const bool ok = (tb - 30 + j) >= 0; const bf16* zq = ok ? zp : Zs; const float msk = ok ? 1.f : 0.f;
            const float av = bf2f(zq[ch]), ag = bf2f(zq[256 + ch]); ext[j] = av * pg8::sigmoid_f(ag) * msk; zp += MIXW; OPAQUE_S(zp); } }
        const float bias = P.cab[ch], g = P.nag[ch], nb = P.nab[ch];
        bf16* mp = uni_ptr(Ms + (size_t)tb * D);
        float* sp = uni_ptr(P.out + O_CA_P + ((ptrdiff_t)(li * BATCH + b) * 30 + (tb - (SEQ - 30))) * 256);
#pragma unroll
        for (int r = 0; r < 16; ++r) { float cv = bias;
#pragma unroll
            for (int k = 0; k < 31; ++k) cv += wA[k] * ext[r + k];
            const float mean = wave_sum(cv) * (1.f / 64.f), dv = cv - mean, var = wave_sum(dv * dv) * (1.f / 64.f);
            const float y = dv * __builtin_amdgcn_rsqf(var + LN_EPS) * g + nb;
            mp[ch] = f2bf16(pg8::silu_f(y)); mp += D; OPAQUE_S(mp);
            if (c == 15 && tb + r >= SEQ - 30) sp[ch] = ext[r + 30];
            sp += 256; OPAQUE_S(sp); }
    }
    {
        float ze[31];
        { const bf16* zp = uni_ptr(Zs + ((ptrdiff_t)(tb - 15) * MIXW));
#pragma unroll
        for (int j = 0; j < 31; ++j) { const bool ok = (tb - 15 + j) >= 0; const bf16* zq = ok ? zp : Zs; ze[j] = bf2f(zq[512 + ch]) * (ok ? 1.f : 0.f); zp += MIXW; OPAQUE_S(zp); } }
        float* sp = uni_ptr(P.out + O_PL_P + ((ptrdiff_t)(li * BATCH + b) * 15 + (tb - (SEQ - 15))) * 256);
        LAS unsigned char* dT = F.lds + DT_OFF + w * 16 * DT_PITCH;
        const int win = 2 << h;
#pragma unroll
        for (int r = 0; r < 16; ++r) { const float zc = ze[r + 15];
            const float s2 = zc + ze[r + 14], s4 = s2 + (ze[r + 13] + ze[r + 12]), s8 = s4 + ((ze[r + 11] + ze[r + 10]) + (ze[r + 9] + ze[r + 8]));
            const float s16 = s8 + (((ze[r + 7] + ze[r + 6]) + (ze[r + 5] + ze[r + 4])) + ((ze[r + 3] + ze[r + 2]) + (ze[r + 1] + ze[r])));
            const int t = tb + r; const float cnt = (float)((t + 1 < win) ? t + 1 : win);
            const float d = pool_sel(h, s2, s4, s8, s16) / cnt - zc;
            *(LAS bf16*)(dT + r * DT_PITCH + lane * 2) = f2bf16(d);
            if (c == 15 && t >= SEQ - 15) sp[ch] = zc;
            sp += 256; OPAQUE_S(sp); }
    }
    __syncthreads();
    {
        const LAS unsigned char* dT = F.lds + DT_OFF + w * 16 * DT_PITCH;
        const bf16x8 b0 = *(const LAS bf16x8*)(dT + fr * DT_PITCH + (fq * 8) * 2), b1 = *(const LAS bf16x8*)(dT + fr * DT_PITCH + (32 + fq * 8) * 2);
#pragma unroll
        for (int nt = 0; nt < 4; ++nt) {
            const LAS unsigned char* wp = F.lds + WPT_OFF + (16 * nt + fr) * WPT_PITCH;
            const bf16x8 a0 = *(const LAS bf16x8*)(wp + (fq * 8) * 2), a1 = *(const LAS bf16x8*)(wp + (32 + fq * 8) * 2);
            f32x4 acc = {0.f, 0.f, 0.f, 0.f};
            acc = __builtin_amdgcn_mfma_f32_16x16x32_bf16(a0, b0, acc, 0, 0, 0);
            acc = __builtin_amdgcn_mfma_f32_16x16x32_bf16(a1, b1, acc, 0, 0, 0);
            const int n = 16 * nt + 4 * fq; const f32x4 sc = *(const f32x4*)(P.ps + h * 64 + n);
            const unsigned lo = pk2(acc[0] * sc[0], acc[1] * sc[1]), hi = pk2(acc[2] * sc[2], acc[3] * sc[3]);
            *(GAS unsigned long long*)(Ms + (size_t)(tb + fr) * D + 256 + h * 64 + n) = (unsigned long long)lo | ((unsigned long long)hi << 32);
        }
    }
    {
        const float g = P.sng[ch], nb = P.snb[ch];
        unsigned pk[8];
        const bf16* zp = uni_ptr(Zs + (size_t)tb * MIXW);
#pragma unroll
        for (int r = 0; r < 16; r += 2) { float vn[2];
#pragma unroll
            for (int q = 0; q < 2; ++q) { const float v = gelu_tanh(bf2f(zp[1024 + ch])); zp += MIXW; OPAQUE_S(zp);
                const float mean = wave_sum(v) * (1.f / 64.f), dv = v - mean, var = wave_sum(dv * dv) * (1.f / 64.f);
                vn[q] = dv * __builtin_amdgcn_rsqf(var + LN_EPS) * g + nb; }
            pk[r >> 1] = pk2(vn[0], vn[1]); }
        LAS unsigned char* vt = F.lds + VNT_OFF + lane * VNT_PITCH + (16 * w) * 2;
        *(LAS v4u*)(vt) = (v4u){pk[0], pk[1], pk[2], pk[3]}; *(LAS v4u*)(vt + 16) = (v4u){pk[4], pk[5], pk[6], pk[7]};
    }
    __syncthreads();
    {
        const int nks = (w >> 1) + 1, tl = 16 * w + fr;
        const float* wrow = P.sw + ((size_t)h * 128 + tl) * 128;
        bf16x8 bw[4];
#pragma unroll
        for (int ks = 0; ks < 4; ++ks) { bf16x8 t = {0, 0, 0, 0, 0, 0, 0, 0};
            if (ks < nks) { const int s0 = 32 * ks + 8 * fq; const f32x4 a = *(const f32x4*)(wrow + s0), bq = *(const f32x4*)(wrow + s0 + 4);
                float e[8] = {a[0], a[1], a[2], a[3], bq[0], bq[1], bq[2], bq[3]};
#pragma unroll
                for (int j = 0; j < 8; ++j) t[j] = (short)f2bf((s0 + j <= tl) ? e[j] : 0.f); }
            bw[ks] = t; }
        const float bsv = P.sb[h * 128 + tl];
#pragma unroll
        for (int ct = 0; ct < 4; ++ct) {
            const LAS unsigned char* vp = F.lds + VNT_OFF + (16 * ct + fr) * VNT_PITCH + (8 * fq) * 2;
            f32x4 acc = {0.f, 0.f, 0.f, 0.f};
#pragma unroll
            for (int ks = 0; ks < 4; ++ks) if (ks < nks) acc = __builtin_amdgcn_mfma_f32_16x16x32_bf16(*(const LAS bf16x8*)(vp + 64 * ks), bw[ks], acc, 0, 0, 0);
            const int cc = h * 64 + 16 * ct + 4 * fq; const size_t ro = (size_t)(tb + fr);
            const unsigned long long uw = *(const GAS unsigned long long*)(Zs + ro * MIXW + 768 + cc);
            const float u0 = gelu_tanh(__uint_as_float((unsigned)uw << 16)), u1 = gelu_tanh(__uint_as_float((unsigned)uw & 0xffff0000u));
            const float u2 = gelu_tanh(__uint_as_float((unsigned)(uw >> 32) << 16)), u3 = gelu_tanh(__uint_as_float((unsigned)(uw >> 32) & 0xffff0000u));
            const unsigned lo = pk2(u0 * (acc[0] + bsv), u1 * (acc[1] + bsv)), hi = pk2(u2 * (acc[2] + bsv), u3 * (acc[3] + bsv));
            *(GAS unsigned long long*)(Ms + ro * D + 512 + cc) = (unsigned long long)lo | ((unsigned long long)hi << 32);
        }
    }
    {
        float q[18], bg[16];
        { const bf16* zp = uni_ptr(Zs + ((ptrdiff_t)(tb - 2) * MIXW));
#pragma unroll
        for (int j = 0; j < 18; ++j) { const bool ok = (tb - 2 + j) >= 0; const bf16* zq = ok ? zp : Zs; q[j] = bf2f(zq[1536 + ch]) * bf2f(zq[1792 + ch]) * (ok ? 1.f : 0.f);
            if (j >= 2) bg[j - 2] = bf2f(zq[1280 + ch]);
            zp += MIXW; OPAQUE_S(zp); } }
        const float w0 = P.scw[ch], w1 = P.scw[256 + ch], w2 = P.scw[512 + ch];
        bf16* mp = uni_ptr(Ms + (size_t)tb * D);
        float* sp = uni_ptr(P.out + O_SC_P + ((ptrdiff_t)(li * BATCH + b) * 2 + (tb - (SEQ - 2))) * 256);
#pragma unroll
        for (int r = 0; r < 16; ++r) { const int t = tb + r; const float y = w0 * q[r] + w1 * q[r + 1] + w2 * q[r + 2];
            mp[768 + ch] = f2bf16(bg[r] * y); mp += D; OPAQUE_S(mp);
            if (c == 15 && t >= SEQ - 2) sp[ch] = q[r + 2];
            sp += 256; OPAQUE_S(sp); }
    }
    __syncthreads();
}
constexpr int SB01_OFF = 0, SB2_OFF = 24064, SB345_OFF = 34176, SB67_OFF = 58752, VNT2_OFF = 75648, WPT2_OFF = 93056, DT2_OFF = 102272;
__device__ __forceinline__ void mix_prompt_unit2(Frame& F, const MixP& P, int b, int c, int h) {
    const int w = F.wave, lane = F.lane, tid = F.tid, ch = h * 64 + lane, fr = lane & 15, fq = lane >> 4, li = P.li;
    const bf16* Zs = uni_ptr(P.Z + (size_t)b * SEQ * MIXW);
    bf16* Ms = uni_ptr(P.MIX + (size_t)b * SEQ * D);
    LAS unsigned char* L = F.lds;
    const v4u zero4 = {0u, 0u, 0u, 0u};
    { const int n = tid & 63, kg = tid >> 6; const float* src = P.pw + (size_t)h * 4096 + (size_t)(8 * kg) * 64 + n;
      v4u o; o.x = pk2(src[0], src[64]); o.y = pk2(src[128], src[192]); o.z = pk2(src[256], src[320]); o.w = pk2(src[384], src[448]);
      *(LAS v4u*)(L + WPT2_OFF + n * WPT_PITCH + kg * 16) = o; }
    float wA[31];
    { const float* wp = P.caw;
#pragma unroll
    for (int k = 0; k < 31; ++k) { wA[k] = wp[ch]; wp += 256; OPAQUE_S(wp); } }
    for (int hh = 0; hh < 2; ++hh) {
        const int tlo = __builtin_amdgcn_readfirstlane(128 * c + 64 * hh);
        {
            const bf16* zc0 = Zs + h * 64;
            v4u va[3], vb[2], vc[3], vd[3];
#pragma unroll
            for (int k = 0; k < 3; ++k) { const int i = tid + 512 * k; const int r = i >> 4, sl = (i >> 3) & 1, kk = i & 7, tt = tlo - 30 + r;
                va[k] = (i < 1504 && tt >= 0) ? *(const GAS v4u*)(zc0 + (size_t)tt * MIXW + sl * 256 + kk * 8) : zero4; }
#pragma unroll
            for (int k = 0; k < 2; ++k) { const int i = tid + 512 * k; const int r = i >> 3, kk = i & 7, tt = tlo - 15 + r;
                vb[k] = (i < 632 && tt >= 0) ? *(const GAS v4u*)(zc0 + (size_t)tt * MIXW + 512 + kk * 8) : zero4; }
#pragma unroll
            for (int k = 0; k < 3; ++k) { const int i = tid + 512 * k; const int r = i / 24, rem = i - r * 24, sl = rem >> 3, kk = rem & 7, tt = tlo + r;
                vc[k] = *(const GAS v4u*)(zc0 + (size_t)tt * MIXW + (3 + sl) * 256 + kk * 8); }
#pragma unroll
            for (int k = 0; k < 3; ++k) { const int i = tid + 512 * k; const int r = i >> 4, sl = (i >> 3) & 1, kk = i & 7, tt = tlo - 2 + r;
                vd[k] = (i < 1056 && tt >= 0) ? *(const GAS v4u*)(zc0 + (size_t)tt * MIXW + (6 + sl) * 256 + kk * 8) : zero4; }
#pragma unroll
            for (int k = 0; k < 3; ++k) { const int i = tid + 512 * k; if (i < 1504) *(LAS v4u*)(L + SB01_OFF + (i >> 4) * 256 + ((i >> 3) & 1) * 128 + (i & 7) * 16) = va[k]; }
#pragma unroll
            for (int k = 0; k < 2; ++k) { const int i = tid + 512 * k; if (i < 632) *(LAS v4u*)(L + SB2_OFF + (i >> 3) * 128 + (i & 7) * 16) = vb[k]; }
#pragma unroll
            for (int k = 0; k < 3; ++k) { const int i = tid + 512 * k; const int r = i / 24, rem = i - r * 24; *(LAS v4u*)(L + SB345_OFF + r * 384 + (rem >> 3) * 128 + (rem & 7) * 16) = vc[k]; }
#pragma unroll
            for (int k = 0; k < 3; ++k) { const int i = tid + 512 * k; if (i < 1056) *(LAS v4u*)(L + SB67_OFF + (i >> 4) * 256 + ((i >> 3) & 1) * 128 + (i & 7) * 16) = vd[k]; }
        }
        __syncthreads();
        {
            float ha[12], qv[9];
#pragma unroll
            for (int k = 0; k < 12; ++k) { const int i = tid + 512 * k; const int r = i >> 6, cc = i & 63; ha[k] = 0.f;
                if (i < 94 * 64) { const LAS bf16* p = (const LAS bf16*)(L + SB01_OFF + r * 256 + cc * 2); ha[k] = bf2f(p[0]) * pg8::sigmoid_f(bf2f(p[64])); } }
#pragma unroll
            for (int k = 0; k < 9; ++k) { const int i = tid + 512 * k; const int r = i >> 6, cc = i & 63; qv[k] = 0.f;
                if (i < 66 * 64) { const LAS bf16* p = (const LAS bf16*)(L + SB67_OFF + r * 256 + cc * 2); qv[k] = bf2f(p[0]) * bf2f(p[64]); } }
            __syncthreads();
#pragma unroll
            for (int k = 0; k < 12; ++k) { const int i = tid + 512 * k; if (i < 94 * 64) *(LAS float*)(L + SB01_OFF + (i >> 6) * 256 + (i & 63) * 4) = ha[k]; }
#pragma unroll
            for (int k = 0; k < 9; ++k) { const int i = tid + 512 * k; if (i < 66 * 64) *(LAS float*)(L + SB67_OFF + (i >> 6) * 256 + (i & 63) * 4) = qv[k]; }
        }
        __syncthreads();
        const int tb = __builtin_amdgcn_readfirstlane(tlo + 8 * w);
        {
            float ext[38];
#pragma unroll
            for (int e = 0; e < 38; ++e) ext[e] = *(const LAS float*)(L + SB01_OFF + (8 * w + e) * 256 + lane * 4);
            const float bias = P.cab[ch], g = P.nag[ch], nb = P.nab[ch];
            bf16* mp = uni_ptr(Ms + (size_t)tb * D);
            float cv[8], mean[8], rstd[8];
#pragma unroll
            for (int r = 0; r < 8; ++r) { float a = bias;
#pragma unroll
                for (int k = 0; k < 31; ++k) a += wA[k] * ext[r + k];
                cv[r] = a; }
            ln8_stats(cv, mean, rstd, LN_EPS);
#pragma unroll
            for (int r = 0; r < 8; ++r) { const float y = (cv[r] - mean[r]) * rstd[r] * g + nb;
                mp[ch] = f2bf16(pg8::silu_f(y)); mp += D; OPAQUE_S(mp); }
            if (c == 15 && hh == 1) {
                float* sp = uni_ptr(P.out + O_CA_P + ((ptrdiff_t)(li * BATCH + b) * 30 + (tb - (SEQ - 30))) * 256);
#pragma unroll
                for (int r = 0; r < 8; ++r) { if (tb + r >= SEQ - 30) sp[ch] = ext[r + 30]; sp += 256; OPAQUE_S(sp); } }
        }
        {
            float ze[23];
#pragma unroll
            for (int e = 0; e < 23; ++e) ze[e] = bf2f(*(const LAS bf16*)(L + SB2_OFF + (8 * w + e) * 128 + lane * 2));
            const int win = 2 << h;
            float ws_[8];
            if (h == 0) {
#pragma unroll
                for (int r = 0; r < 8; ++r) ws_[r] = ze[r + 15] + ze[r + 14];
            } else if (h == 1) {
#pragma unroll
                for (int r = 0; r < 8; ++r) ws_[r] = (ze[r + 15] + ze[r + 14]) + (ze[r + 13] + ze[r + 12]);
            } else if (h == 2) {
#pragma unroll
                for (int r = 0; r < 8; ++r) ws_[r] = ((ze[r + 15] + ze[r + 14]) + (ze[r + 13] + ze[r + 12])) + ((ze[r + 11] + ze[r + 10]) + (ze[r + 9] + ze[r + 8]));
            } else {
#pragma unroll
                for (int r = 0; r < 8; ++r) ws_[r] = (((ze[r + 15] + ze[r + 14]) + (ze[r + 13] + ze[r + 12])) + ((ze[r + 11] + ze[r + 10]) + (ze[r + 9] + ze[r + 8])))
                                                   + (((ze[r + 7] + ze[r + 6]) + (ze[r + 5] + ze[r + 4])) + ((ze[r + 3] + ze[r + 2]) + (ze[r + 1] + ze[r])));
            }
#pragma unroll
            for (int r = 0; r < 8; ++r) { const int t = tb + r; const float cnt = (float)((t + 1 < win) ? t + 1 : win);
                *(LAS bf16*)(L + DT2_OFF + (8 * w + r) * DT_PITCH + lane * 2) = f2bf16(ws_[r] * __builtin_amdgcn_rcpf(cnt) - ze[r + 15]);
                }
            if (c == 15 && hh == 1) {
                float* sp = uni_ptr(P.out + O_PL_P + ((ptrdiff_t)(li * BATCH + b) * 15 + (tb - (SEQ - 15))) * 256);
#pragma unroll
                for (int r = 0; r < 8; ++r) { if (tb + r >= SEQ - 15) sp[ch] = ze[r + 15]; sp += 256; OPAQUE_S(sp); } }
        }
        {
            const float g = P.sng[ch], nb = P.snb[ch];
            unsigned pk[4]; float vv[8], mean[8], rstd[8];
#pragma unroll
            for (int r = 0; r < 8; ++r) vv[r] = gelu_tanh(bf2f(*(const LAS bf16*)(L + SB345_OFF + (8 * w + r) * 384 + 128 + lane * 2)));
            ln8_stats(vv, mean, rstd, LN_EPS);
#pragma unroll
            for (int r = 0; r < 8; r += 2) pk[r >> 1] = pk2((vv[r] - mean[r]) * rstd[r] * g + nb, (vv[r + 1] - mean[r + 1]) * rstd[r + 1] * g + nb);
            *(LAS v4u*)(L + VNT2_OFF + lane * VNT_PITCH + (64 * hh + 8 * w) * 2) = (v4u){pk[0], pk[1], pk[2], pk[3]};
        }
        {
            float q[10];
#pragma unroll
            for (int e = 0; e < 10; ++e) q[e] = *(const LAS float*)(L + SB67_OFF + (8 * w + e) * 256 + lane * 4);
            const float w0 = P.scw[ch], w1 = P.scw[256 + ch], w2 = P.scw[512 + ch];
            bf16* mp = uni_ptr(Ms + (size_t)tb * D);
#pragma unroll
            for (int r = 0; r < 8; ++r) { const float bg = bf2f(*(const LAS bf16*)(L + SB345_OFF + (8 * w + r) * 384 + 256 + lane * 2));
                mp[768 + ch] = f2bf16(bg * (w0 * q[r] + w1 * q[r + 1] + w2 * q[r + 2])); mp += D; OPAQUE_S(mp); }
            if (c == 15 && hh == 1) {
                float* sp = uni_ptr(P.out + O_SC_P + ((ptrdiff_t)(li * BATCH + b) * 2 + (tb - (SEQ - 2))) * 256);
#pragma unroll
                for (int r = 0; r < 8; ++r) { if (tb + r >= SEQ - 2) sp[ch] = q[r + 2]; sp += 256; OPAQUE_S(sp); } }
        }
        __syncthreads();
        const int rt = w >> 1, t0 = 64 * hh + 16 * rt;
        {
            const LAS unsigned char* dT = L + DT2_OFF + (16 * rt + fr) * DT_PITCH;
            const bf16x8 b0 = *(const LAS bf16x8*)(dT + (fq * 8) * 2), b1 = *(const LAS bf16x8*)(dT + (32 + fq * 8) * 2);
#pragma unroll
            for (int nn = 0; nn < 2; ++nn) { const int nt = 2 * (w & 1) + nn;
                const LAS unsigned char* wp = L + WPT2_OFF + (16 * nt + fr) * WPT_PITCH;
                const bf16x8 a0 = *(const LAS bf16x8*)(wp + (fq * 8) * 2), a1 = *(const LAS bf16x8*)(wp + (32 + fq * 8) * 2);
                f32x4 acc = {0.f, 0.f, 0.f, 0.f};
                acc = __builtin_amdgcn_mfma_f32_16x16x32_bf16(a0, b0, acc, 0, 0, 0);
                acc = __builtin_amdgcn_mfma_f32_16x16x32_bf16(a1, b1, acc, 0, 0, 0);
                const int n = 16 * nt + 4 * fq; const f32x4 sc = *(const f32x4*)(P.ps + h * 64 + n);
                const unsigned lo = pk2(acc[0] * sc[0], acc[1] * sc[1]), hi = pk2(acc[2] * sc[2], acc[3] * sc[3]);
                *(GAS unsigned long long*)(Ms + (size_t)(tlo + 16 * rt + fr) * D + 256 + h * 64 + n) = (unsigned long long)lo | ((unsigned long long)hi << 32); }
        }
        {
            const int nks = (t0 >> 5) + 1, tl = t0 + fr;
            const float* wrow = P.sw + ((size_t)h * 128 + tl) * 128;
            bf16x8 bw[4];
#pragma unroll
            for (int ks = 0; ks < 4; ++ks) { bf16x8 t = {0, 0, 0, 0, 0, 0, 0, 0};
                if (ks < nks) { const int s0 = 32 * ks + 8 * fq; const f32x4 a = *(const f32x4*)(wrow + s0), bq = *(const f32x4*)(wrow + s0 + 4);
                    float e[8] = {a[0], a[1], a[2], a[3], bq[0], bq[1], bq[2], bq[3]};
#pragma unroll
                    for (int j = 0; j < 8; ++j) e[j] = (s0 + j <= tl) ? e[j] : 0.f;
                    const v4u tw = {pk2(e[0], e[1]), pk2(e[2], e[3]), pk2(e[4], e[5]), pk2(e[6], e[7])}; t = __builtin_bit_cast(bf16x8, tw); }
                bw[ks] = t; }
            const float bsv = P.sb[h * 128 + tl];
#pragma unroll
            for (int cn = 0; cn < 2; ++cn) { const int ct = 2 * (w & 1) + cn;
                const LAS unsigned char* vp = L + VNT2_OFF + (16 * ct + fr) * VNT_PITCH + (8 * fq) * 2;
                f32x4 acc = {0.f, 0.f, 0.f, 0.f};
#pragma unroll
                for (int ks = 0; ks < 4; ++ks) if (ks < nks) acc = __builtin_amdgcn_mfma_f32_16x16x32_bf16(*(const LAS bf16x8*)(vp + 64 * ks), bw[ks], acc, 0, 0, 0);
                const int cc = 16 * ct + 4 * fq;
                const unsigned long long uw = *(const LAS unsigned long long*)(L + SB345_OFF + (16 * rt + fr) * 384 + cc * 2);
                const float u0 = gelu_tanh(__uint_as_float((unsigned)uw << 16)), u1 = gelu_tanh(__uint_as_float((unsigned)uw & 0xffff0000u));
                const float u2 = gelu_tanh(__uint_as_float((unsigned)(uw >> 32) << 16)), u3 = gelu_tanh(__uint_as_float((unsigned)(uw >> 32) & 0xffff0000u));
                const unsigned lo = pk2(u0 * (acc[0] + bsv), u1 * (acc[1] + bsv)), hi = pk2(u2 * (acc[2] + bsv), u3 * (acc[3] + bsv));
                *(GAS unsigned long long*)(Ms + (size_t)(tlo + 16 * rt + fr) * D + 512 + h * 64 + cc) = (unsigned long long)lo | ((unsigned long long)hi << 32); }
        }
        __syncthreads();
    }
}
__device__ __forceinline__ void mix_sample_wave(Frame& F, const MixP& P, int b, int h) {
    const int lane = F.lane, ch = h * 64 + lane, li = P.li;
    b = __builtin_amdgcn_readfirstlane(b); h = __builtin_amdgcn_readfirstlane(h);
    const bf16* Zr = uni_ptr(P.Z + (size_t)(MP + b * DECS) * MIXW); bf16* Mr = uni_ptr(P.MIX + (size_t)(MP + b * DECS) * D);
    const size_t sb_ = (size_t)li * DECB + b;
    {
        float wA[31];
        { const float* wp = P.caw;
#pragma unroll
        for (int k = 0; k < 31; ++k) { wA[k] = wp[ch]; wp += 256; OPAQUE_S(wp); } }
        float ext[38];
        { const float* sp = P.st_a + sb_ * 30 * 256; float* so = P.out + O_CA_S + sb_ * 30 * 256;
#pragma unroll
        for (int j = 0; j < 30; ++j) { ext[j] = sp[ch]; sp += 256; OPAQUE_S(sp); }
        const bf16* zp = Zr;
#pragma unroll
        for (int t = 0; t < 8; ++t) { ext[30 + t] = bf2f(zp[ch]) * pg8::sigmoid_f(bf2f(zp[256 + ch])); zp += MIXW; OPAQUE_S(zp); }
#pragma unroll
        for (int j = 0; j < 30; ++j) { so[ch] = ext[j + 8]; so += 256; OPAQUE_S(so); } }
        const float bias = P.cab[ch], g = P.nag[ch], nb = P.nab[ch];
        bf16* mp = Mr; float cvs[8], mean8[8], rstd8[8];
#pragma unroll
        for (int t = 0; t < 8; ++t) { float a = bias;
#pragma unroll
            for (int k = 0; k < 31; ++k) a += wA[k] * ext[t + k];
            cvs[t] = a; }
        ln8_stats(cvs, mean8, rstd8, LN_EPS);
#pragma unroll
        for (int t = 0; t < 8; ++t) { mp[ch] = f2bf16(pg8::silu_f((cvs[t] - mean8[t]) * rstd8[t] * g + nb)); mp += D; OPAQUE_S(mp); }
    }
    {
        float ze[23];
        { const float* sp = P.st_p + sb_ * 15 * 256; float* so = P.out + O_PL_S + sb_ * 15 * 256;
#pragma unroll
        for (int j = 0; j < 15; ++j) { ze[j] = sp[ch]; sp += 256; OPAQUE_S(sp); }
        const bf16* zp = Zr;
#pragma unroll
        for (int t = 0; t < 8; ++t) { ze[15 + t] = bf2f(zp[512 + ch]); zp += MIXW; OPAQUE_S(zp); }
#pragma unroll
        for (int j = 0; j < 15; ++j) { so[ch] = ze[j + 8]; so += 256; OPAQUE_S(so); } }
        float d[8], y[8];
        const float inv = 1.0f / (float)(2 << h);
#pragma unroll
        for (int r = 0; r < 8; ++r) { const float zc = ze[r + 15];
            const float s2 = zc + ze[r + 14], s4 = s2 + (ze[r + 13] + ze[r + 12]), s8 = s4 + ((ze[r + 11] + ze[r + 10]) + (ze[r + 9] + ze[r + 8]));
            const float s16 = s8 + (((ze[r + 7] + ze[r + 6]) + (ze[r + 5] + ze[r + 4])) + ((ze[r + 3] + ze[r + 2]) + (ze[r + 1] + ze[r])));
            d[r] = pool_sel(h, s2, s4, s8, s16) * inv - zc; y[r] = 0.f; }
        const float* pwh = P.pw + (size_t)h * 4096;
#pragma unroll 8
        for (int k = 0; k < 64; ++k) { const float wv = pwh[lane]; pwh += 64;
#pragma unroll
            for (int r = 0; r < 8; ++r) y[r] += __shfl(d[r], k) * wv; }
        const float sc = P.ps[ch];
        bf16* mp = Mr;
#pragma unroll
        for (int r = 0; r < 8; ++r) { mp[256 + ch] = f2bf16(y[r] * sc); mp += D; OPAQUE_S(mp); }
    }
    {
        const float g = P.sng[ch], nb = P.snb[ch];
        float vn[8], ug[8];
        { const bf16* zp = Zr; float* so = P.out + O_CV_S + sb_ * DECS * 256;
#pragma unroll
        for (int t = 0; t < 8; ++t) { vn[t] = gelu_tanh(bf2f(zp[1024 + ch])); ug[t] = gelu_tanh(bf2f(zp[768 + ch])); zp += MIXW; OPAQUE_S(zp); }
        { float mean8[8], rstd8[8]; ln8_stats(vn, mean8, rstd8, LN_EPS);
#pragma unroll
        for (int t = 0; t < 8; ++t) { vn[t] = (vn[t] - mean8[t]) * rstd8[t] * g + nb; so[ch] = vn[t]; so += 256; OPAQUE_S(so); } } }
        bf16* mp = Mr; const float* swp = P.sw + (size_t)h * 128 * 128; const float* sbp = P.sb + h * 128;
#pragma unroll
        for (int t = 0; t < 8; ++t) { float s = sbp[t];
#pragma unroll
            for (int q = 0; q <= t; ++q) s += swp[q] * vn[q];
            swp += 128; OPAQUE_S(swp);
            mp[512 + ch] = f2bf16(ug[t] * s); mp += D; OPAQUE_S(mp); }
    }
    {
        float q[10], bg[8];
        q[0] = P.st_s[(sb_ * 2 + 0) * 256 + ch]; q[1] = P.st_s[(sb_ * 2 + 1) * 256 + ch];
        { const bf16* zp = Zr;
#pragma unroll
        for (int t = 0; t < 8; ++t) { q[2 + t] = bf2f(zp[1536 + ch]) * bf2f(zp[1792 + ch]); bg[t] = bf2f(zp[1280 + ch]); zp += MIXW; OPAQUE_S(zp); } }
        const float w0 = P.scw[ch], w1 = P.scw[256 + ch], w2 = P.scw[512 + ch];
        bf16* mp = Mr;
#pragma unroll
        for (int t = 0; t < 8; ++t) { mp[768 + ch] = f2bf16(bg[t] * (w0 * q[t] + w1 * q[t + 1] + w2 * q[t + 2])); mp += D; OPAQUE_S(mp); }
        P.out[O_SC_S + (sb_ * 2 + 0) * 256 + ch] = q[8]; P.out[O_SC_S + (sb_ * 2 + 1) * 256 + ch] = q[9];
    }
}
constexpr int MIX_PUNITS = BATCH * 16 * 4, MIX_SUNITS = DECB * 4 / NWAVES;
__device__ __forceinline__ void mix_phase(Frame& F, const MixP& P) {
    for (int u = blockIdx.x; u < MIX_PUNITS + MIX_SUNITS; u += F.G) {
        asm volatile("" : "+v"(F.tid), "+v"(F.lane), "+s"(F.wave) :: "memory");
        if (u < MIX_PUNITS) mix_prompt_unit2(F, P, u >> 6, (u >> 2) & 15, u & 3);
        else { const int wu = (u - MIX_PUNITS) * NWAVES + F.wave; mix_sample_wave(F, P, wu >> 2, wu & 3); }
    }
}
__device__ __forceinline__ void small_gemm_resid(Frame& F, const bf16* A, int lda, const bf16* Bt, int K, bf16* XB, float scale, int m0) {
    const int w = F.wave, lane = F.lane, tid = F.tid, fr = lane & 15, fq = lane >> 4, K8 = K >> 3;
    constexpr int PP = 68;
    LAS float* Pt = (LAS float*)(F.lds);
    for (int t = (int)blockIdx.x; t < 256; t += F.G) {
        const int ti = t >> 4, tj = t & 15;
        const bf16* a0 = A + (size_t)(m0 + 64 * ti + fr) * lda + w * K8 + 8 * fq;
        const bf16* b0 = Bt + (size_t)(64 * tj + fr) * lda + w * K8 + 8 * fq;
        f32x4 acc[4][4];
#pragma unroll
        for (int mi = 0; mi < 4; ++mi)
#pragma unroll
            for (int ni = 0; ni < 4; ++ni) acc[mi][ni] = (f32x4){0.f, 0.f, 0.f, 0.f};
#pragma unroll 2
        for (int k = 0; k < K8; k += 32) {
            bf16x8 af[4], bfr[4];
#pragma unroll
            for (int mi = 0; mi < 4; ++mi) af[mi] = *(const bf16x8*)(a0 + (size_t)(16 * mi) * lda + k);
#pragma unroll
            for (int ni = 0; ni < 4; ++ni) bfr[ni] = *(const bf16x8*)(b0 + (size_t)(16 * ni) * lda + k);
#pragma unroll
            for (int mi = 0; mi < 4; ++mi)
#pragma unroll
                for (int ni = 0; ni < 4; ++ni) acc[mi][ni] = __builtin_amdgcn_mfma_f32_16x16x32_bf16(af[mi], bfr[ni], acc[mi][ni], 0, 0, 0);
        }
        LAS float* mine = Pt + (w & 3) * 64 * PP + (4 * fq) * PP + fr;
        if (w >= 4) {
#pragma unroll
            for (int mi = 0; mi < 4; ++mi)
#pragma unroll
                for (int ni = 0; ni < 4; ++ni)
#pragma unroll
                    for (int rg = 0; rg < 4; ++rg) mine[(16 * mi + rg) * PP + 16 * ni] = acc[mi][ni][rg];
        }
        __syncthreads();
        if (w < 4) {
#pragma unroll
            for (int mi = 0; mi < 4; ++mi)
#pragma unroll
                for (int ni = 0; ni < 4; ++ni)
#pragma unroll
                    for (int rg = 0; rg < 4; ++rg) acc[mi][ni][rg] += mine[(16 * mi + rg) * PP + 16 * ni];
#pragma unroll
            for (int mi = 0; mi < 4; ++mi)
#pragma unroll
                for (int ni = 0; ni < 4; ++ni)
#pragma unroll
                    for (int rg = 0; rg < 4; ++rg) mine[(16 * mi + rg) * PP + 16 * ni] = acc[mi][ni][rg];
        }
        __syncthreads();
        { const int row = tid >> 3, c8 = (tid & 7) * 8;
          f32x4 s0 = {0.f, 0.f, 0.f, 0.f}, s1 = {0.f, 0.f, 0.f, 0.f};
#pragma unroll
          for (int q = 0; q < 4; ++q) { const LAS f32x4* p = (const LAS f32x4*)(Pt + (q * 64 + row) * PP + c8); s0 += p[0]; s1 += p[1]; }
          const size_t off = (size_t)(m0 + 64 * ti + row) * D + 64 * tj + c8;
          const v4u rw = *(const GAS v4u*)(XB + off);
          f32x4 x0 = {__uint_as_float(rw.x << 16), __uint_as_float(rw.x & 0xffff0000u), __uint_as_float(rw.y << 16), __uint_as_float(rw.y & 0xffff0000u)};
          f32x4 x1 = {__uint_as_float(rw.z << 16), __uint_as_float(rw.z & 0xffff0000u), __uint_as_float(rw.w << 16), __uint_as_float(rw.w & 0xffff0000u)};
          x0 += s0 * scale; x1 += s1 * scale;
          v4u o; o.x = pk2(x0[0], x0[1]); o.y = pk2(x0[2], x0[3]); o.z = pk2(x1[0], x1[1]); o.w = pk2(x1[2], x1[3]);
          *(GAS v4u*)(XB + off) = o; }
        __syncthreads();
    }
}
__global__ void __launch_bounds__(NWAVES * 64, 2) fwd_megakernel(Args args) {
    extern __shared__ __attribute__((aligned(16))) unsigned char lds[];
    Frame F;
    F.lds = (LAS unsigned char*)lds;
    F.tid = threadIdx.x; F.lane = F.tid & 63; F.wave = __builtin_amdgcn_readfirstlane(F.tid >> 6);
    F.G = gridDim.x; { const int bx = blockIdx.x; F.vcu = (F.G % 8 == 0) ? (bx % 8) * (F.G / 8) + bx / 8 : bx; }
    unsigned char* ws = args.ws;
    for (int u = F.tid; u < (LDS_BYTES - LDSCTL_OFF) / 4; u += NWAVES * 64) ((LAS unsigned*)(F.lds + LDSCTL_OFF))[u] = 0u;
    __syncthreads();
    XcdBarrier bar = xcd_barrier_post((unsigned*)(ws + WS_CTL) + CW_BAR, (volatile LAS unsigned*)(F.lds + MISC_OFF) + 8);
#define GRID_BAR() do { asm volatile("" : "+s"(bar.bar)); xcd_barrier(bar); asm volatile("" : "+v"(F.tid), "+v"(F.lane), "+s"(F.wave) :: "memory"); } while (0)
#if defined(NO_GEMM) || (defined(ONLY) && ONLY != 1)
#define RUN_GEMM1(...)
#else
#define RUN_GEMM1(...) __VA_ARGS__
#endif
#if defined(NO_GEMM) || (defined(ONLY) && ONLY != 2)
#define RUN_GEMM2(...)
#else
#define RUN_GEMM2(...) __VA_ARGS__
#endif
#if defined(NO_GEMM) || (defined(ONLY) && ONLY != 3)
#define RUN_GEMM3(...)
#else
#define RUN_GEMM3(...) __VA_ARGS__
#endif
#if defined(NO_GEMM) || (defined(ONLY) && ONLY != 4)
#define RUN_GEMM4(...)
#else
#define RUN_GEMM4(...) __VA_ARGS__
#endif
#if defined(NO_GEMM) || (defined(ONLY) && ONLY != 5)
#define RUN_GEMM5(...)
#else
#define RUN_GEMM5(...) __VA_ARGS__
#endif
#if defined(NO_GEMM) || (defined(ONLY) && ONLY != 6)
#define RUN_GEMM6(...)
#else
#define RUN_GEMM6(...) __VA_ARGS__
#endif
#if defined(NO_GEMM) || (defined(ONLY) && ONLY != 7)
#define RUN_GEMM7(...)
#else
#define RUN_GEMM7(...) __VA_ARGS__
#endif
#if defined(NO_GEMM) || (defined(ONLY) && ONLY != 8)
#define RUN_GEMM8(...)
#else
#define RUN_GEMM8(...) __VA_ARGS__
#endif

#ifndef NO_PRO
    p0_prologue(F, args);
#ifdef PROBE_PRO2
    p0_prologue(F, args);
#endif
#endif
    if (args.ws == nullptr) cg::this_grid().sync();
    GRID_BAR();

    float* X = args.out;
    pg8::bf16_t* ACT = (pg8::bf16_t*)(ws + WS_ACT);
    if (F.tid == 0) { unsigned ok = (F.G % 8 == 0) ? 1u : 0u; for (unsigned j = 0; j < 8; ++j) ok &= (xb_ld(&bar.bar[XB_XCNT(j)]) == (unsigned)(F.G / 8)) ? 1u : 0u;
        volatile LAS unsigned* stw = (volatile LAS unsigned*)(F.lds + MISC_OFF) + 8; const unsigned rk = stw[4];
        stw[5] = (ok && rk < (unsigned)(F.G / 8) && bar.x < 8u) ? 8u * rk + bar.x : (unsigned)blockIdx.x; }
    __syncthreads();
    const int G = F.G, cu = __builtin_amdgcn_readfirstlane((int)((volatile LAS unsigned*)(F.lds + MISC_OFF))[8 + 5]);
    for (int li = 0; li < DEPTH; ++li) {
        pg8::bf16_t* XB = (pg8::bf16_t*)(ws + ((li & 1) ? WS_BUFB : WS_BUFA));
        pg8::bf16_t* MX = (pg8::bf16_t*)(ws + ((li & 1) ? WS_BUFA : WS_BUFB));
        const unsigned char* wl = ws + WS_W + (size_t)li * W_LAYER;
        { pg8::Gemm g{XB, (const pg8::bf16_t*)(wl + WO_GU1), M, NGU, D}; pg8::StaticOrder S; S.init(M, NGU, G, opaque_s(cu));
          pg8::EpiSwiGLU E{ACT, FF}; RUN_GEMM1(pg8::gemm_phase<pg8::EpiSwiGLU, pg8::StaticOrder, true, true>(F.lds + RING_OFF, g, S, E);)
#ifdef PROBE_P1X2
          pg8::gemm_phase<pg8::EpiSwiGLU, pg8::StaticOrder, true, true>(F.lds + RING_OFF, g, S, E);
#endif
#ifdef PROBE_P1NULL
          { pg8::EpiNull E0; pg8::gemm_phase<pg8::EpiNull, pg8::StaticOrder, true, true>(F.lds + RING_OFF, g, S, E0); }
#endif
        }
        GRID_BAR();
        { pg8::Gemm g{ACT, (const pg8::bf16_t*)(wl + WO_D1), M, D, FF}; pg8::MixedOrder S; S.init(MP, 0, D, G, opaque_s(cu));
          pg8::EpiResid<0> E{XB, XB, 0.5f, nullptr}; RUN_GEMM2(pg8::gemm_phase<pg8::EpiResid<0>, pg8::MixedOrder, true, true>(F.lds + RING_OFF, g, S, E);) }
        small_gemm_resid(F, (const bf16*)ACT, FF, (const bf16*)(wl + WO_D1), FF, (bf16*)XB, 0.5f, MP);
        GRID_BAR();
        { pg8::Gemm g{XB, (const pg8::bf16_t*)(wl + WO_MI), M, MIXW, D}; pg8::MixedOrder S; S.init(MP, MS, MIXW, G, opaque_s(cu));
          pg8::EpiScaleBf16<true> E{ACT, MIXW}; RUN_GEMM3(pg8::gemm_phase<pg8::EpiScaleBf16<true>, pg8::MixedOrder, true, true>(F.lds + RING_OFF, g, S, E);) }
        if (li == 0 && DEPTH > 1) {
            const int nq = (MS / 256) * (MIXW / 256) * 4, half = (DEPTH - 1) * P0_I_LAYER * 2 / 5;
            if (G > nq) { if (cu >= nq) { p0_convert(F, args, P0_I_LAYER, P0_I_LAYER + half, (cu - nq) * NWAVES + F.wave, (G - nq) * NWAVES); p0_pb(F, args, M, DEPTH * M, (cu - nq) * NWAVES + F.wave, (G - nq) * NWAVES); } }
            else { p0_convert(F, args, P0_I_LAYER, P0_I_LAYER + half, cu * NWAVES + F.wave, G * NWAVES); p0_pb(F, args, M, DEPTH * M, cu * NWAVES + F.wave, G * NWAVES); }
        }
        GRID_BAR();
        { MixP P; P.Z = (const bf16*)ACT; P.MIX = (bf16*)MX; P.caw = args.in[opaque_s(13)] + (size_t)li * 31 * 256; P.cab = args.in[opaque_s(14)] + li * 256; P.nag = args.in[opaque_s(15)] + li * 256; P.nab = args.in[opaque_s(16)] + li * 256;
          P.pw = args.in[opaque_s(17)] + (size_t)li * 4 * 4096; P.ps = args.in[opaque_s(18)] + li * 256; P.sng = args.in[opaque_s(19)] + li * 256; P.snb = args.in[opaque_s(20)] + li * 256;
          P.sw = args.in[opaque_s(21)] + (size_t)li * 4 * 128 * 128; P.sb = args.in[opaque_s(22)] + li * 4 * 128; P.scw = args.in[opaque_s(23)] + li * 3 * 256; P.out = args.out; P.li = li;
          P.st_a = args.in[opaque_s(4)]; P.st_p = args.in[opaque_s(5)]; P.st_s = args.in[opaque_s(6)];
#ifndef NO_MIX
          mix_phase(F, P);
#ifdef PROBE_MIX2
          mix_phase(F, P);
#endif
#endif
        }
        GRID_BAR();
        { pg8::Gemm g{MX, (const pg8::bf16_t*)(wl + WO_MO), M, D, D}; pg8::MixedOrder S; S.init(MP, MS, D, G, opaque_s(cu));
          pg8::EpiResid<0> E{XB, XB, 1.0f, nullptr}; RUN_GEMM4(pg8::gemm_phase<pg8::EpiResid<0>, pg8::MixedOrder, true, true>(F.lds + RING_OFF, g, S, E);) }
        { const int nq = (MS / 256) * (D / 256) * 4; pg8::bf16_t* PROJ = (pg8::bf16_t*)args.out + (size_t)li * M * D;
          pg8::Gemm g{(const pg8::bf16_t*)(ws + WS_PB) + (size_t)li * M * DPLE, (const pg8::bf16_t*)(wl + WO_PP), M, D, DPLE};
          pg8::RangeOrder S{0, (M / 256) * (D / 256), G > nq ? G - nq : G, opaque_s(G > nq ? (cu >= nq ? cu - nq : -1) : cu)};
          pg8::EpiScaleBf16<false> E{PROJ, D}; pg8::gemm_phase<pg8::EpiScaleBf16<false>, pg8::RangeOrder, true, true>(F.lds + RING_OFF, g, S, E); }
        GRID_BAR();
        { pg8::Gemm g{XB, (const pg8::bf16_t*)(wl + WO_GU2), M, NGU, D}; pg8::StaticOrder S; S.init(M, NGU, G, opaque_s(cu));
          pg8::EpiSwiGLU E{ACT, FF}; RUN_GEMM5(pg8::gemm_phase<pg8::EpiSwiGLU, pg8::StaticOrder, true, true>(F.lds + RING_OFF, g, S, E);) }
        GRID_BAR();
        { pg8::Gemm g{ACT, (const pg8::bf16_t*)(wl + WO_D2), M, D, FF}; pg8::MixedOrder S; S.init(MP, 0, D, G, opaque_s(cu));
          pg8::EpiResid<0> E{XB, XB, 0.5f, nullptr}; RUN_GEMM6(pg8::gemm_phase<pg8::EpiResid<0>, pg8::MixedOrder, true, true>(F.lds + RING_OFF, g, S, E);) }
        small_gemm_resid(F, (const bf16*)ACT, FF, (const bf16*)(wl + WO_D2), FF, (bf16*)XB, 0.5f, MP);
        GRID_BAR();
        { pg8::Gemm g{XB, (const pg8::bf16_t*)(wl + WO_PG), M, D, D}; pg8::MixedOrder S; S.init(MP, MS, D, G, opaque_s(cu));
          pg8::EpiResid<1> E{MX, XB, 0.f, (const pg8::bf16_t*)args.out + (size_t)li * M * D}; RUN_GEMM8(pg8::gemm_phase<pg8::EpiResid<1>, pg8::MixedOrder, true, true>(F.lds + RING_OFF, g, S, E);) }
        if (li == 0 && DEPTH > 1) {
            const int nq = (MS / 256) * (D / 256) * 4, half = (DEPTH - 1) * P0_I_LAYER * 2 / 5;
            if (G > nq) { if (cu >= nq) p0_convert(F, args, P0_I_LAYER + half, DEPTH * P0_I_LAYER, (cu - nq) * NWAVES + F.wave, (G - nq) * NWAVES); }
            else p0_convert(F, args, P0_I_LAYER + half, DEPTH * P0_I_LAYER, cu * NWAVES + F.wave, G * NWAVES);
        }
        GRID_BAR();
    }
#ifndef NO_FIN
    final_norm(F, args, (const bf16*)(ws + ((DEPTH & 1) ? WS_BUFB : WS_BUFA)));
#endif
}

extern "C" void kernel_launch(void* const* d_in, const int* in_sizes, int n_in, void* d_out, int out_size, void* d_ws, size_t ws_size, hipStream_t stream) {
    static int grid = 0;
    if (grid == 0) {
        if (n_in != NIN || in_sizes[0] != MP * D || (size_t)out_size != O_END || ws_size < WS_END) {
            fprintf(stderr, "kernel_launch: unexpected shapes: n_in %d in0 %d out %d (want %zu) ws %zu (need %zu); nothing launched\n", n_in, n_in > 0 ? in_sizes[0] : -1, out_size, (size_t)O_END, ws_size, (size_t)WS_END); grid = -1; return; }
        int dev = 0, cus = 0, per_cu = 0;
        if (hipGetDevice(&dev) != hipSuccess || hipDeviceGetAttribute(&cus, hipDeviceAttributeMultiprocessorCount, dev) != hipSuccess) { grid = -1; return; }
        if (hipFuncSetAttribute((const void*)fwd_megakernel, hipFuncAttributeMaxDynamicSharedMemorySize, LDS_BYTES) != hipSuccess) { fprintf(stderr, "kernel_launch: hipFuncSetAttribute failed\n"); grid = -1; return; }
        if (hipOccupancyMaxActiveBlocksPerMultiprocessor(&per_cu, (const void*)fwd_megakernel, NWAVES * 64, LDS_BYTES) != hipSuccess || per_cu < 1) { fprintf(stderr, "kernel_launch: occupancy query says %d\n", per_cu); per_cu = 1; }
        (void)hipGetLastError();
        grid = cus;
    }
    if (grid < 0) return;
    if (hipMemsetAsync((char*)d_ws + WS_CTL, 0, CTL_ZERO_BYTES, stream) != hipSuccess) { fprintf(stderr, "kernel_launch: memset failed\n"); return; }
    Args a{};
    for (int i = 0; i < NIN; ++i) a.in[i] = (const float*)d_in[i];
    a.out = (float*)d_out; a.ws = (unsigned char*)d_ws;
    void* kargs[] = {&a};
    hipError_t e = hipLaunchCooperativeKernel((const void*)fwd_megakernel, dim3(grid), dim3(NWAVES * 64), kargs, LDS_BYTES, stream);
    if (e != hipSuccess) fprintf(stderr, "kernel_launch: cooperative launch failed: %s (grid %d)\n", hipGetErrorString(e), grid);
}
```
